# Optimizing an MI355X kernel written in HIP

```python
import math
import jax, jax.numpy as jnp
from jax import lax
import numpy as np

D_MODEL = 1024
BATCH = 32
SEQ = 2048
DEPTH = 4

N_MIXERS = 4
ALPHA = (2 * DEPTH) ** 0.25
BETA = (8 * DEPTH) ** -0.25
LN_EPS = 1e-5

ML_HEADS = 4
ML_DV = D_MODEL // ML_HEADS
ML_DK = ML_DV // 2
ML_CHUNK = 64
ML_IN = 2 * ML_HEADS * ML_DK + 2 * D_MODEL + 4 * ML_HEADS

GLA_HEADS = 4
GLA_DK = D_MODEL // 2 // GLA_HEADS
GLA_DV = D_MODEL // GLA_HEADS
GLA_RANK = 16
GLA_TAU = 16.0
GLA_CHUNK = 32
GLA_IN = 2 * GLA_HEADS * GLA_DK + 2 * D_MODEL + 2 * GLA_RANK

LRU_WIDTH = D_MODEL
LRU_BLOCKS = 4
LRU_BW = LRU_WIDTH // LRU_BLOCKS
CONV_WIDTH = 4
LRU_C = 8.0
LRU_IN = 2 * LRU_WIDTH

MLA_HEADS = 8
MLA_NOPE = 128
MLA_ROPE = 64
MLA_DV = 128
MLA_Q_RANK = 384
MLA_KV_RANK = 256
MLA_IN = MLA_Q_RANK + MLA_KV_RANK + MLA_ROPE
ROPE_THETA = 10000.0
Q_BLOCK = 128

N_EXPERTS = 16
EXPERT_FF = 1024
CAPACITY_FACTOR = 2

N_MLSTM = (DEPTH - 0 + N_MIXERS - 1) // N_MIXERS
N_GLA = (DEPTH - 1 + N_MIXERS - 1) // N_MIXERS
N_LRU = (DEPTH - 2 + N_MIXERS - 1) // N_MIXERS
N_MLA = (DEPTH - 3 + N_MIXERS - 1) // N_MIXERS

kernel_name = 'hybrid_mlstm_gla_rglru_mla_ecmoe_encoder'


def layer_norm(x, g, b):
    xf = x.astype(jnp.float32)
    mu = jnp.mean(xf, axis=-1, keepdims=True)
    var = jnp.mean(jnp.square(xf - mu), axis=-1, keepdims=True)
    return ((xf - mu) * lax.rsqrt(var + LN_EPS) * g + b).astype(x.dtype)


def rms_norm(x, g):
    xf = x.astype(jnp.float32)
    return (xf * lax.rsqrt(jnp.mean(jnp.square(xf), axis=-1, keepdims=True) + LN_EPS) * g).astype(x.dtype)


def head_norm(h, g):
    hf = h.astype(jnp.float32)
    mu = jnp.mean(hf, axis=-1, keepdims=True)
    var = jnp.mean(jnp.square(hf - mu), axis=-1, keepdims=True)
    hn = (hf - mu) * lax.rsqrt(var + LN_EPS)
    return hn.reshape(h.shape[0], h.shape[1], -1) * g.astype(jnp.float32)


def to_chunks(t, L):
    B, S = t.shape[0], t.shape[1]
    t = t.reshape((B, S // L, L) + t.shape[2:])
    return jnp.moveaxis(t, (1, 2), (0, 3))


def from_chunks(t):
    t = jnp.moveaxis(t, (0, 3), (1, 2))
    return t.reshape((t.shape[0], t.shape[1] * t.shape[2]) + t.shape[3:])


def flip_seq(t):
    return jnp.flip(t, axis=1)


def mlstm_chunked(q, k, v, ig, fg):
    B, S, H, DK = q.shape
    DV = v.shape[-1]
    L = ML_CHUNK
    mask = jnp.tril(jnp.ones((L, L), dtype=bool))

    def step(carry, inp):
        C, n, m = carry
        qb, kb, vb, ib, fb = inp
        b = jnp.cumsum(jax.nn.log_sigmoid(fb), axis=-1)
        g = b[..., -1]
        logD = jnp.where(mask, b[..., :, None] - b[..., None, :] + ib[..., None, :], -jnp.inf)
        inter = b + m[..., None]
        m_t = jnp.maximum(inter, jnp.max(logD, axis=-1))
        s = jnp.einsum('bhtd,bhsd->bhts', qb, kb) * jnp.exp(logD - m_t[..., None])
        w_inter = jnp.exp(inter - m_t)
        num = jnp.einsum('bhts,bhsv->bhtv', s, vb) + w_inter[..., None] * jnp.einsum('bhtd,bhdv->bhtv', qb, C)
        den = jnp.sum(s, axis=-1) + w_inter * jnp.einsum('bhtd,bhd->bht', qb, n)
        h = num / jnp.maximum(jnp.abs(den), jnp.exp(-m_t))[..., None]
        lw = g[..., None] - b + ib
        m_new = jnp.maximum(g + m, jnp.max(lw, axis=-1))
        ws = jnp.exp(lw - m_new[..., None])
        wc = jnp.exp(g + m - m_new)
        kw = kb * ws[..., None]
        C = wc[..., None, None] * C + jnp.einsum('bhsd,bhsv->bhdv', kw, vb)
        n = wc[..., None] * n + jnp.sum(kw, axis=-2)
        return (C, n, m_new), h

    init = (jnp.zeros((B, H, DK, DV), jnp.float32), jnp.zeros((B, H, DK), jnp.float32),
            jnp.zeros((B, H), jnp.float32))
    xs = (to_chunks(q, L), to_chunks(k, L), to_chunks(v, L), to_chunks(ig, L), to_chunks(fg, L))
    _, h = lax.scan(step, init, xs)
    return from_chunks(h)


def mlstm_mixer(x, w_in, gate_b, norm_g, w_out):
    B, S, _ = x.shape
    f32 = jnp.float32
    qk = ML_HEADS * ML_DK
    z = x @ w_in
    q, k, v, o, gates = jnp.split(z, [qk, 2 * qk, 2 * qk + D_MODEL, 2 * qk + 2 * D_MODEL], axis=-1)
    q = q.reshape(B, S, ML_HEADS, ML_DK).astype(f32) * (ML_DK ** -0.5)
    k = k.reshape(B, S, ML_HEADS, ML_DK).astype(f32)
    v = v.reshape(B, S, ML_HEADS, ML_DV).astype(f32)
    gates = gates.reshape(B, S, 2, 2, ML_HEADS).astype(f32) + gate_b.astype(f32)
    h_fwd = mlstm_chunked(q, k, v, gates[:, :, 0, 0], gates[:, :, 0, 1])
    h_bwd = flip_seq(mlstm_chunked(flip_seq(q), flip_seq(k), flip_seq(v),
                                   flip_seq(gates[:, :, 1, 0]), flip_seq(gates[:, :, 1, 1])))
    h = head_norm(h_fwd + h_bwd, norm_g).astype(x.dtype)
    return (jax.nn.sigmoid(o) * h) @ w_out


def gla_chunked(q, k, v, loga):
    B, S, H, DK = q.shape
    DV = v.shape[-1]
    L = GLA_CHUNK
    mask = jnp.tril(jnp.ones((L, L), dtype=bool))[:, :, None]

    def step(state, inp):
        qb, kb, vb, ab = inp
        b = jnp.cumsum(ab, axis=-2)
        dec = jnp.exp(jnp.where(mask, b[:, :, :, None, :] - b[:, :, None, :, :], -jnp.inf))
        A = jnp.einsum('bhtd,bhtsd,bhsd->bhts', qb, dec, kb)
        o = jnp.einsum('bhts,bhsv->bhtv', A, vb) + jnp.einsum('bhtd,bhdv->bhtv', qb * jnp.exp(b), state)
        g = b[:, :, -1, :]
        state = jnp.exp(g)[..., None] * state + jnp.einsum('bhsd,bhsv->bhdv', kb * jnp.exp(g[:, :, None, :] - b), vb)
        return state, o

    init = jnp.zeros((B, H, DK, DV), jnp.float32)
    xs = (to_chunks(q, L), to_chunks(k, L), to_chunks(v, L), to_chunks(loga, L))
    _, o = lax.scan(step, init, xs)
    return from_chunks(o)


def gla_mixer(x, w_in, gate_w, gate_b, norm_g, w_out):
    B, S, _ = x.shape
    f32 = jnp.float32
    qk = GLA_HEADS * GLA_DK
    z = x @ w_in
    q, k, v, r, glr = jnp.split(z, [qk, 2 * qk, 2 * qk + D_MODEL, 2 * qk + 2 * D_MODEL], axis=-1)
    q = q.reshape(B, S, GLA_HEADS, GLA_DK).astype(f32) * (GLA_DK ** -0.5)
    k = k.reshape(B, S, GLA_HEADS, GLA_DK).astype(f32)
    v = v.reshape(B, S, GLA_HEADS, GLA_DV).astype(f32)
    glr = glr.reshape(B, S, 2, GLA_RANK).astype(f32)
    loga = jax.nn.log_sigmoid(jnp.einsum('bsgr,grk->bsgk', glr, gate_w.astype(f32)) + gate_b.astype(f32)) / GLA_TAU
    loga = loga.reshape(B, S, 2, GLA_HEADS, GLA_DK)
    o_fwd = gla_chunked(q, k, v, loga[:, :, 0])
    o_bwd = flip_seq(gla_chunked(flip_seq(q), flip_seq(k), flip_seq(v), flip_seq(loga[:, :, 1])))
    o = head_norm(o_fwd + o_bwd, norm_g).astype(x.dtype)
    return (jax.nn.silu(r) * o) @ w_out


def rglru_direction(u, wa, ba, wx, bx, lam):
    B, S, W = u.shape
    ub = u.reshape(B, S, LRU_BLOCKS, LRU_BW)
    r = jax.nn.sigmoid(jnp.einsum('bsni,nij->bsnj', ub, wa).reshape(B, S, W) + ba)
    i = jax.nn.sigmoid(jnp.einsum('bsni,nij->bsnj', ub, wx).reshape(B, S, W) + bx)
    log_a = LRU_C * r * jax.nn.log_sigmoid(lam)
    a = jnp.exp(log_a)
    gated = jnp.sqrt(-jnp.expm1(2.0 * log_a)) * (i * u)

    def step(h, inp):
        a_t, g_t = inp
        h = a_t * h + g_t
        return h, h

    _, hs = lax.scan(step, jnp.zeros((B, W), jnp.float32), (jnp.swapaxes(a, 0, 1), jnp.swapaxes(gated, 0, 1)))
    return jnp.swapaxes(hs, 0, 1)


def rglru_mixer(x, w_in, conv_w, conv_b, gate_a_w, gate_a_b, gate_x_w, gate_x_b, lam, w_out):
    f32 = jnp.float32
    z = x @ w_in
    gate_branch, u = jnp.split(z, [LRU_WIDTH], axis=-1)
    u = lax.conv_general_dilated(u, conv_w[:, None, :].astype(u.dtype), window_strides=(1,),
                                 padding=[(CONV_WIDTH // 2, CONV_WIDTH - 1 - CONV_WIDTH // 2)],
                                 dimension_numbers=('NWC', 'WIO', 'NWC'),
                                 feature_group_count=LRU_WIDTH) + conv_b
    u = u.astype(f32)
    h_fwd = rglru_direction(u, gate_a_w[0].astype(f32), gate_a_b[0].astype(f32), gate_x_w[0].astype(f32),
                            gate_x_b[0].astype(f32), lam[0].astype(f32))
    h_bwd = flip_seq(rglru_direction(flip_seq(u), gate_a_w[1].astype(f32), gate_a_b[1].astype(f32),
                                     gate_x_w[1].astype(f32), gate_x_b[1].astype(f32), lam[1].astype(f32)))
    h = (h_fwd + h_bwd).astype(x.dtype)
    return (jax.nn.gelu(gate_branch) * h) @ w_out


def apply_rope(t, cos, sin):
    half = t.shape[-1] // 2
    t1, t2 = t[..., :half], t[..., half:]
    return jnp.concatenate([t1 * cos - t2 * sin, t2 * cos + t1 * sin], axis=-1)


def mla_mixer(x, positions, w_in, q_norm_g, kv_norm_g, w_uq, w_ukv, w_out):
    B, S, _ = x.shape
    f32 = jnp.float32
    z = x @ w_in
    cq, ckv, k_rope = jnp.split(z, [MLA_Q_RANK, MLA_Q_RANK + MLA_KV_RANK], axis=-1)
    q = (rms_norm(cq, q_norm_g) @ w_uq).reshape(B, S, MLA_HEADS, MLA_NOPE + MLA_ROPE)
    kv = (rms_norm(ckv, kv_norm_g) @ w_ukv).reshape(B, S, MLA_HEADS, MLA_NOPE + MLA_DV)
    q_nope, q_rope = jnp.split(q, [MLA_NOPE], axis=-1)
    k_nope, v = jnp.split(kv, [MLA_NOPE], axis=-1)
    half = MLA_ROPE // 2
    freq = ROPE_THETA ** (-jnp.arange(half, dtype=f32) / half)
    ang = positions.astype(f32)[..., None] * freq
    cos = jnp.cos(ang).astype(x.dtype)
    sin = jnp.sin(ang).astype(x.dtype)
    q_rope = apply_rope(q_rope, cos[:, :, None, :], sin[:, :, None, :])
    k_rope = apply_rope(k_rope, cos, sin)
    scale = (MLA_NOPE + MLA_ROPE) ** -0.5
    nq = S // Q_BLOCK
    qn_blocks = jnp.moveaxis(q_nope.reshape(B, nq, Q_BLOCK, MLA_HEADS, MLA_NOPE), 1, 0)
    qr_blocks = jnp.moveaxis(q_rope.reshape(B, nq, Q_BLOCK, MLA_HEADS, MLA_ROPE), 1, 0)

    def attend(blk):
        qn, qr = blk
        s = (jnp.einsum('bqhd,bkhd->bhqk', qn, k_nope) + jnp.einsum('bqhd,bkd->bhqk', qr, k_rope)).astype(f32) * scale
        p = jax.nn.softmax(s, axis=-1).astype(v.dtype)
        return jnp.einsum('bhqk,bkhv->bqhv', p, v)

    out = lax.map(attend, (qn_blocks, qr_blocks))
    out = jnp.moveaxis(out, 0, 1).reshape(B, S, MLA_HEADS * MLA_DV)
    return out @ w_out


def ec_moe(x, w_router, w_gate, w_up, w_down):
    B, N, _ = x.shape
    cap = CAPACITY_FACTOR * N // N_EXPERTS
    aff = jax.nn.softmax(jnp.einsum('bnd,de->bne', x, w_router).astype(jnp.float32), axis=-1)
    gates, idx = lax.top_k(jnp.swapaxes(aff, 1, 2), cap)
    bidx = jnp.arange(B)[:, None, None]
    xin = x[bidx, idx]
    h = jax.nn.silu(jnp.einsum('becd,edf->becf', xin, w_gate)) * jnp.einsum('becd,edf->becf', xin, w_up)
    out = jnp.einsum('becf,efd->becd', h, w_down) * gates[..., None].astype(x.dtype)
    return jnp.zeros_like(x).at[bidx, idx].add(out.astype(x.dtype))


def setup_inputs(seed: int = 0) -> dict:
    key = jax.random.key(seed)
    keys = iter(jax.random.split(key, 64))
    f32 = jnp.float32

    def nrm(shape, scale):
        return jax.random.normal(next(keys), shape, f32) * scale

    def gain(shape):
        return 1.0 + nrm(shape, 0.02)

    D = D_MODEL
    x = jax.random.normal(next(keys), (BATCH, SEQ, D), f32)
    positions = (jnp.arange(SEQ, dtype=jnp.int32)[None, :]
                 + jax.random.randint(next(keys), (BATCH, 1), 0, SEQ, dtype=jnp.int32))
    mlstm_w_in = nrm((N_MLSTM, D, ML_IN), D ** -0.5)
    ig_b = nrm((N_MLSTM, 2, 1, ML_HEADS), 0.1)
    fg_b = 3.0 + 3.0 * jax.random.uniform(next(keys), (N_MLSTM, 2, 1, ML_HEADS), f32)
    mlstm_gate_b = jnp.concatenate([ig_b, fg_b], axis=2)
    mlstm_norm_g = gain((N_MLSTM, D))
    mlstm_w_out = nrm((N_MLSTM, D, D), BETA * D ** -0.5)
    gla_w_in = nrm((N_GLA, D, GLA_IN), D ** -0.5)
    gla_gate_w = nrm((N_GLA, 2, GLA_RANK, GLA_HEADS * GLA_DK), GLA_RANK ** -0.5)
    gla_gate_b = nrm((N_GLA, 2, GLA_HEADS * GLA_DK), 0.1)
    gla_norm_g = gain((N_GLA, D))
    gla_w_out = nrm((N_GLA, D, D), BETA * D ** -0.5)
    lru_w_in = nrm((N_LRU, D, LRU_IN), D ** -0.5)
    lru_conv_w = nrm((N_LRU, CONV_WIDTH, LRU_WIDTH), CONV_WIDTH ** -0.5)
    lru_conv_b = nrm((N_LRU, LRU_WIDTH), 0.02)
    lru_gate_a_w = nrm((N_LRU, 2, LRU_BLOCKS, LRU_BW, LRU_BW), LRU_BW ** -0.5)
    lru_gate_a_b = nrm((N_LRU, 2, LRU_WIDTH), 0.1)
    lru_gate_x_w = nrm((N_LRU, 2, LRU_BLOCKS, LRU_BW, LRU_BW), LRU_BW ** -0.5)
    lru_gate_x_b = nrm((N_LRU, 2, LRU_WIDTH), 0.1)
    a0 = jax.random.uniform(next(keys), (N_LRU, 2, LRU_WIDTH), f32, minval=0.9, maxval=0.999)
    s0 = a0 ** (1.0 / LRU_C)
    lru_lambda = jnp.log(s0) - jnp.log1p(-s0)
    lru_w_out = nrm((N_LRU, LRU_WIDTH, D), BETA * LRU_WIDTH ** -0.5)
    mla_w_in = nrm((N_MLA, D, MLA_IN), D ** -0.5)
    mla_q_norm_g = gain((N_MLA, MLA_Q_RANK))
    mla_kv_norm_g = gain((N_MLA, MLA_KV_RANK))
    mla_w_uq = nrm((N_MLA, MLA_Q_RANK, MLA_HEADS * (MLA_NOPE + MLA_ROPE)), MLA_Q_RANK ** -0.5)
    mla_w_ukv = nrm((N_MLA, MLA_KV_RANK, MLA_HEADS * (MLA_NOPE + MLA_DV)), MLA_KV_RANK ** -0.5)
    mla_w_out = nrm((N_MLA, MLA_HEADS * MLA_DV, D), BETA * (MLA_HEADS * MLA_DV) ** -0.5)
    moe_router = nrm((DEPTH, D, N_EXPERTS), D ** -0.5)
    moe_w_gate = nrm((DEPTH, N_EXPERTS, D, EXPERT_FF), D ** -0.5)
    moe_w_up = nrm((DEPTH, N_EXPERTS, D, EXPERT_FF), D ** -0.5)
    moe_w_down = nrm((DEPTH, N_EXPERTS, EXPERT_FF, D), BETA * EXPERT_FF ** -0.5)
    ln_g = gain((DEPTH, 2, D))
    ln_b = nrm((DEPTH, 2, D), 0.02)
    return {
        'x': x, 'positions': positions,
        'mlstm_w_in': mlstm_w_in, 'mlstm_gate_b': mlstm_gate_b, 'mlstm_norm_g': mlstm_norm_g, 'mlstm_w_out': mlstm_w_out,
        'gla_w_in': gla_w_in, 'gla_gate_w': gla_gate_w, 'gla_gate_b': gla_gate_b, 'gla_norm_g': gla_norm_g, 'gla_w_out': gla_w_out,
        'lru_w_in': lru_w_in, 'lru_conv_w': lru_conv_w, 'lru_conv_b': lru_conv_b,
        'lru_gate_a_w': lru_gate_a_w, 'lru_gate_a_b': lru_gate_a_b, 'lru_gate_x_w': lru_gate_x_w, 'lru_gate_x_b': lru_gate_x_b,
        'lru_lambda': lru_lambda, 'lru_w_out': lru_w_out,
        'mla_w_in': mla_w_in, 'mla_q_norm_g': mla_q_norm_g, 'mla_kv_norm_g': mla_kv_norm_g,
        'mla_w_uq': mla_w_uq, 'mla_w_ukv': mla_w_ukv, 'mla_w_out': mla_w_out,
        'moe_router': moe_router, 'moe_w_gate': moe_w_gate, 'moe_w_up': moe_w_up, 'moe_w_down': moe_w_down,
        'ln_g': ln_g, 'ln_b': ln_b,
    }


def reference(x, positions,
              mlstm_w_in, mlstm_gate_b, mlstm_norm_g, mlstm_w_out,
              gla_w_in, gla_gate_w, gla_gate_b, gla_norm_g, gla_w_out,
              lru_w_in, lru_conv_w, lru_conv_b, lru_gate_a_w, lru_gate_a_b, lru_gate_x_w, lru_gate_x_b,
              lru_lambda, lru_w_out,
              mla_w_in, mla_q_norm_g, mla_kv_norm_g, mla_w_uq, mla_w_ukv, mla_w_out,
              moe_router, moe_w_gate, moe_w_up, moe_w_down,
              ln_g, ln_b):
    for i in range(DEPTH):
        m = i % N_MIXERS
        j = i // N_MIXERS
        if m == 0:
            h = mlstm_mixer(x, mlstm_w_in[j], mlstm_gate_b[j], mlstm_norm_g[j], mlstm_w_out[j])
        elif m == 1:
            h = gla_mixer(x, gla_w_in[j], gla_gate_w[j], gla_gate_b[j], gla_norm_g[j], gla_w_out[j])
        elif m == 2:
            h = rglru_mixer(x, lru_w_in[j], lru_conv_w[j], lru_conv_b[j], lru_gate_a_w[j], lru_gate_a_b[j],
                            lru_gate_x_w[j], lru_gate_x_b[j], lru_lambda[j], lru_w_out[j])
        else:
            h = mla_mixer(x, positions, mla_w_in[j], mla_q_norm_g[j], mla_kv_norm_g[j],
                          mla_w_uq[j], mla_w_ukv[j], mla_w_out[j])
        x = layer_norm(ALPHA * x + h, ln_g[i, 0], ln_b[i, 0])
        y = ec_moe(x, moe_router[i], moe_w_gate[i], moe_w_up[i], moe_w_down[i])
        x = layer_norm(ALPHA * x + y, ln_g[i, 1], ln_b[i, 1])
    return x
```

```cpp
#include <hip/hip_runtime.h>
#include <cstdio>
#include <cstdint>
#include <type_traits>

#define GAS __attribute__((address_space(1)))
#define LAS __attribute__((address_space(3)))
typedef unsigned short bf16_t;
typedef short bf16x8 __attribute__((ext_vector_type(8)));
typedef short s16x4 __attribute__((ext_vector_type(4)));
typedef float f32x2 __attribute__((ext_vector_type(2)));
typedef float f32x4 __attribute__((ext_vector_type(4)));
typedef float f32x16 __attribute__((ext_vector_type(16)));
typedef unsigned u32x2 __attribute__((ext_vector_type(2)));
typedef unsigned u32x4 __attribute__((ext_vector_type(4)));

constexpr int NB = 32, SEQ = 2048, DM = 1024, NT = NB * SEQ;
constexpr float ALPHA = 1.6817928305074290f;
constexpr float LN_EPS = 1e-5f;
constexpr int NEXP = 16, CAP = 256, NSEL = NB * NEXP * CAP;

constexpr size_t MiB = 1u << 20;
constexpr size_t WS_CTL = 0, CTL_BYTES = 1 * MiB;
constexpr size_t WS_WMIX = 1 * MiB;
constexpr size_t WS_ROPE = 33 * MiB;
constexpr size_t WS_SMALL = 49 * MiB;
constexpr size_t WS_WMOE = 65 * MiB;
constexpr size_t WS_XB = 161 * MiB;
constexpr size_t WS_Z = 289 * MiB;
constexpr size_t WS_H = 673 * MiB;
constexpr size_t WS_XB8 = 929 * MiB;
constexpr size_t WS_END = 993 * MiB;
constexpr size_t WM_ML_IN = 0;
constexpr size_t WM_ML_OUT = WM_ML_IN + (size_t)3328 * 1024 * 2;
constexpr size_t WM_GL_IN = WM_ML_OUT + (size_t)1024 * 1024 * 2;
constexpr size_t WM_GL_OUT = WM_GL_IN + (size_t)3328 * 1024 * 2;
constexpr size_t WM_LR_IN = WM_GL_OUT + (size_t)1024 * 1024 * 2;
constexpr size_t WM_LR_G = WM_LR_IN + (size_t)2048 * 1024 * 2;
constexpr size_t WM_LR_OUT = WM_LR_G + (size_t)4096 * 256 * 2;
constexpr size_t WM_MA_IN = WM_LR_OUT + (size_t)1024 * 1024 * 2;
constexpr size_t WM_MA_UQ = WM_MA_IN + (size_t)768 * 1024 * 2;
constexpr size_t WM_MA_UKV = WM_MA_UQ + (size_t)1536 * 384 * 2;
constexpr size_t WM_MA_OUT = WM_MA_UKV + (size_t)2048 * 256 * 2;
constexpr size_t WM_END = WM_MA_OUT + (size_t)1024 * 1024 * 2;
static_assert(WM_END <= 32 * MiB, "mixer weights fit");
constexpr size_t SM_GATES = 0;
constexpr size_t SM_AFF = 8 * MiB;
constexpr size_t SM_IDX = 12 * MiB;
constexpr size_t SM_INV = 13 * MiB;
constexpr int CW_BAR = 4096;

constexpr int LDS_MISC = 131072 + 16384;
constexpr int LDS_BYTES = 131072 + 16384 + 1024;

#define LDS_WAIT() asm volatile("s_waitcnt lgkmcnt(0)" ::: "memory")
#define VM_WAIT() asm volatile("s_waitcnt vmcnt(0)" ::: "memory")
typedef __bf16 bf16x2_t __attribute__((ext_vector_type(2)));
__device__ __forceinline__ unsigned cvt_pk_bf16(float lo, float hi) { bf16x2_t v = {(__bf16)lo, (__bf16)hi}; return __builtin_bit_cast(unsigned, v); }
__device__ __forceinline__ float bf_lo(unsigned w) { return __uint_as_float(w << 16); }
__device__ __forceinline__ float bf_hi(unsigned w) { return __uint_as_float(w & 0xffff0000u); }
__device__ __forceinline__ float bf2f(bf16_t b) { return __uint_as_float(((unsigned)b) << 16); }
__device__ __forceinline__ bf16_t f2bf(float f) { return (bf16_t)(cvt_pk_bf16(f, 0.f) & 0xffffu); }
__device__ __forceinline__ int opaque(int x) { asm volatile("" : "+v"(x)); return x; }
__device__ __forceinline__ unsigned char* opaque_sptr(unsigned char* p) {
    unsigned lo = __builtin_amdgcn_readfirstlane((unsigned)(uintptr_t)p), hi = __builtin_amdgcn_readfirstlane((unsigned)((uintptr_t)p >> 32));
    asm volatile("" : "+s"(lo), "+s"(hi));
    return (unsigned char*)(((uintptr_t)hi << 32) | (uintptr_t)lo);
}
template <int CTRL> __device__ __forceinline__ float dpp_f(float v) { return __int_as_float(__builtin_amdgcn_update_dpp(0, __float_as_int(v), CTRL, 0xF, 0xF, true)); }
__device__ __forceinline__ float rdlane_f(float v, int l) { return __int_as_float(__builtin_amdgcn_readlane(__float_as_int(v), l)); }
__device__ __forceinline__ float wave_sum(float v) {
    v += dpp_f<0xB1>(v); v += dpp_f<0x4E>(v); v += dpp_f<0x141>(v); v += dpp_f<0x140>(v);
    return (rdlane_f(v, 0) + rdlane_f(v, 16)) + (rdlane_f(v, 32) + rdlane_f(v, 48));
}
__device__ __forceinline__ float wave_max(float v) {
    v = fmaxf(v, dpp_f<0xB1>(v)); v = fmaxf(v, dpp_f<0x4E>(v)); v = fmaxf(v, dpp_f<0x141>(v)); v = fmaxf(v, dpp_f<0x140>(v));
    return fmaxf(fmaxf(rdlane_f(v, 0), rdlane_f(v, 16)), fmaxf(rdlane_f(v, 32), rdlane_f(v, 48)));
}
__device__ __forceinline__ float sigmoidf_(float x) { return __builtin_amdgcn_rcpf(1.0f + __expf(-x)); }
__device__ __forceinline__ float sigmoid_fast(float x) { return __builtin_amdgcn_rcpf(1.0f + __expf(-x)); }
__device__ __forceinline__ float one_minus_exp(float x) { const float ser = -x * (1.0f + x * (0.5f + x * (0.16666667f + x * 0.041666668f))); const float dir = 1.0f - __expf(x); return x > -0.125f ? ser : dir; }
__device__ __forceinline__ float logsigmoidf_(float x) { return fminf(x, 0.f) - log1pf(__expf(-fabsf(x))); }
__device__ __forceinline__ float logsigmoid_fast(float x) { return fminf(x, 0.f) - __logf(1.0f + __expf(-fabsf(x))); }
__device__ __forceinline__ float gelu_tanh(float x) { const float u = 0.7978845608028654f * (x + 0.044715f * x * x * x); const float t = 1.0f - 2.0f * __builtin_amdgcn_rcpf(__expf(2.0f * u) + 1.0f); return 0.5f * x * (1.0f + t); }
__device__ __forceinline__ float siluf_(float x) { return x * __builtin_amdgcn_rcpf(1.0f + __expf(-x)); }

typedef int i32x8 __attribute__((ext_vector_type(8)));
typedef int i32x4 __attribute__((ext_vector_type(4)));
constexpr float F8_SG = 32.0f;
constexpr float F8_SP = 256.0f, F8_SV = 8.0f;
constexpr float F8_SWI = 64.0f;
constexpr float F8_SU = 16.0f, F8_SWO = 128.0f;
constexpr float F8_SW1 = 64.0f, F8_SW2 = 128.0f, F8_SH = 8.0f, F8_SO = 32.0f;
__device__ __forceinline__ float f8clamp(float x) { return fminf(fmaxf(x, -416.0f), 416.0f); }
__device__ __forceinline__ unsigned pk4_fp8(float a, float b, float c, float d) {
    unsigned w = 0u; w = (unsigned)__builtin_amdgcn_cvt_pk_fp8_f32(f8clamp(a), f8clamp(b), (int)w, false); w = (unsigned)__builtin_amdgcn_cvt_pk_fp8_f32(f8clamp(c), f8clamp(d), (int)w, true); return w; }
__device__ __forceinline__ f32x4 unpk4_fp8(unsigned w) { const f32x2 lo = __builtin_amdgcn_cvt_pk_f32_fp8((int)w, false), hi = __builtin_amdgcn_cvt_pk_f32_fp8((int)w, true); return (f32x4){lo[0], lo[1], hi[0], hi[1]}; }
#define XB_TMO      128
#define XB_XCNT(j)  (256  + 64 * (j))
#define XB_XSUB(j)  (1280 + 64 * (j))
#define XB_XGEN(j)  (2304 + 64 * (j))
#define XB_TOP      3328
#define XB_TOPGEN   3392
#define XCD_BAR_WORDS 3456
#define XB_SPIN_CAP (1u << 20)

__device__ __forceinline__ unsigned xb_ld(unsigned* p)              { return __hip_atomic_load(p, __ATOMIC_RELAXED, __HIP_MEMORY_SCOPE_AGENT); }
__device__ __forceinline__ unsigned xb_add(unsigned* p, unsigned v) { return __hip_atomic_fetch_add(p, v, __ATOMIC_RELAXED, __HIP_MEMORY_SCOPE_AGENT); }
__device__ __forceinline__ unsigned xb_xcc_id() { return (unsigned)__builtin_amdgcn_s_getreg((3 << 11) | 20) & 0xFu; }
#define XB_SPIN(cond, bar) do { unsigned _sp = 0; while (cond) { __builtin_amdgcn_s_sleep(1); \
    if ((++_sp & 255u) == 0u) { if (xb_ld(&(bar)[XB_TMO])) break; if (_sp > XB_SPIN_CAP) { atomicAdd(&(bar)[XB_TMO], 1u); break; } } } } while (0)

struct XcdBarrier { unsigned* bar; unsigned x; volatile LAS unsigned* st; };

__device__ __forceinline__ XcdBarrier xcd_barrier_post(unsigned* bar, volatile LAS unsigned* st) {
    XcdBarrier b; b.bar = bar; b.x = xb_xcc_id(); b.st = st;
    if (threadIdx.x == 0) (void)xb_add(&bar[XB_XCNT(b.x)], 1u);
    return b;
}
__device__ __forceinline__ void xcd_barrier_complete(unsigned* bar, unsigned x, unsigned& nloc, unsigned& nx) {
    const unsigned G = gridDim.x * gridDim.y * gridDim.z;
    unsigned sum, cnt, mine, sp = 0u;
    for (;;) {
        sum = 0u; cnt = 0u; mine = 0u;
#pragma unroll
        for (unsigned j = 0; j < 16; ++j) { const unsigned c = xb_ld(&bar[XB_XCNT(j)]); sum += c; cnt += (c > 0u) ? 1u : 0u; mine = (j == x) ? c : mine; }
        if (sum == G) break;
        __builtin_amdgcn_s_sleep(1);
        if ((++sp & 255u) == 0u) { if (xb_ld(&bar[XB_TMO])) break; if (sp > XB_SPIN_CAP) { atomicAdd(&bar[XB_TMO], 1u); break; } }
    }
    nloc = mine > 0u ? mine : 1u; nx = cnt > 0u ? cnt : 1u;
}
__device__ __forceinline__ void xcd_barrier(const XcdBarrier& b) {
    asm volatile("s_waitcnt vmcnt(0)" ::: "memory");
    __syncthreads();
    if (threadIdx.x == 0) {
        unsigned* bar = b.bar;
        __builtin_amdgcn_s_waitcnt(0);
        unsigned nloc = b.st[0], nx = b.st[1];
        if (nloc == 0u) { xcd_barrier_complete(bar, b.x, nloc, nx); b.st[0] = nloc; b.st[1] = nx; }
        const unsigned old = xb_add(&bar[XB_XSUB(b.x)], 1u);
        const unsigned gen = old / nloc;
        if (old + 1u == (gen + 1u) * nloc) {
            __builtin_amdgcn_fence(__ATOMIC_RELEASE, "agent");
            asm volatile("s_waitcnt vmcnt(0)" ::: "memory");
            const unsigned og = xb_add(&bar[XB_TOP], 1u);
            const unsigned tg = og / nx;
            if (og + 1u == (tg + 1u) * nx) xb_add(&bar[XB_TOPGEN], 1u);
            else XB_SPIN(xb_ld(&bar[XB_TOPGEN]) == tg, bar);
            __builtin_amdgcn_fence(__ATOMIC_ACQUIRE, "agent");
            xb_add(&bar[XB_XGEN(b.x)], 1u);
            asm volatile("s_waitcnt vmcnt(0)" ::: "memory");
        } else {
            XB_SPIN(xb_ld(&bar[XB_XGEN(b.x)]) == gen, bar);
            __builtin_amdgcn_fence(__ATOMIC_ACQUIRE, "agent");
            asm volatile("s_waitcnt vmcnt(0)" ::: "memory");
        }
    }
    __syncthreads();
}
namespace pg8 {
constexpr int BM = 256, BK = 64, HALF = 128, HTB = HALF * BK * 2, STAGE_BYTES = 8 * HTB, NXCD = 8, WGM = 8;
__host__ __device__ __forceinline__ int lds_byte(int r, int c) { const int st = (r >> 4) * 2 + (c >> 5), rr = r & 15, cc = c & 31, ob = rr * 64 + cc * 2; return st * 1024 + (ob ^ (((ob >> 9) & 1) << 5)); }
__host__ __device__ __forceinline__ void stage_rc(int b, int& R, int& C) { const int st = b / 1024, sb = b % 1024, swz = sb ^ (((sb >> 9) & 1) << 5); R = (st >> 1) * 16 + swz / 64; C = (st & 1) * 32 + (swz % 64) / 2; }
__host__ __device__ __forceinline__ int perm32(int rho) { const int n = rho >> 4, i = rho & 15; return 8 * (i >> 2) + 4 * n + (i & 3); }

struct Unit { int pm, pn; };
struct StaticOrder {
    int nM, nN, nwg, G, c;
    __device__ void init(int nM_, int nN_, int G_, int c_) { nM = nM_; nN = nN_; nwg = nM * nN; G = G_; c = c_; }
    __device__ bool next(int i, Unit& u) const {
        const long L = (long)i * G + c; if (L >= nwg) return false;
        int wgid = (int)L; { const int q = nwg / NXCD, r = nwg % NXCD, xcd = wgid % NXCD, off = wgid / NXCD; wgid = (xcd < r ? xcd * (q + 1) : r * (q + 1) + (xcd - r) * q) + off; }
        const int nig = WGM * nN, gid = wgid / nig, fm = gid * WGM, gsz = (nM - fm) < WGM ? (nM - fm) : WGM;
        u.pm = fm + ((wgid % nig) % gsz); u.pn = (wgid % nig) / gsz; return true;
    }
};
struct OffsetOrder : StaticOrder { int pm_off;
    __device__ bool next(int i, Unit& u) const { if (!StaticOrder::next(i, u)) return false; u.pm += pm_off; return true; } };
struct PanelOrder { int nM, nN, G, c;
    __device__ void init(int nM_, int nN_, int G_, int c_) { nM = nM_; nN = nN_; G = G_; c = c_; }
    __device__ bool next(int i, Unit& u) const { const int p = c + (i / nN) * G; if (p >= nM) return false; u.pm = p; u.pn = i % nN; return true; } };
struct GPlain { const bf16_t* A; const bf16_t* Bt; int lda, ldb, K;
    __device__ __forceinline__ size_t kstep_a() const { return 128; }
    __device__ __forceinline__ const char* a(const Unit& u) const { return (const char*)A + (size_t)u.pm * BM * lda * 2; }
    __device__ __forceinline__ const char* b(const Unit& u) const { return (const char*)Bt + (size_t)u.pn * BM * ldb * 2; } };
struct GMoe { const bf16_t* A; const bf16_t* Bt; int lda, ldb, K; size_t estride;
    const int* rowtok;
    __device__ __forceinline__ size_t kstep_a() const { return 128; }
    __device__ __forceinline__ const char* a(const Unit& u) const { return (const char*)A + (size_t)u.pm * BM * lda * 2; }
    __device__ __forceinline__ const char* b(const Unit& u) const { return (const char*)Bt + (size_t)(u.pm >> 5) * estride + (size_t)u.pn * BM * ldb * 2; } };
struct GMoeTA { const bf16_t* A; const bf16_t* Bt; int lda, ldb, K; size_t estride;
    __device__ __forceinline__ size_t kstep_a() const { return 32768; }
    __device__ __forceinline__ const char* a(const Unit& u) const { return (const char*)A + (size_t)u.pm * 524288; }
    __device__ __forceinline__ const char* b(const Unit& u) const { return (const char*)Bt + (size_t)(u.pm >> 5) * estride + (size_t)u.pn * BM * ldb * 2; } };
struct GMoeTA8 { const unsigned char* A; const unsigned char* Bt; int lda, ldb, K; size_t estride;
    __device__ __forceinline__ size_t kstep_a() const { return 32768; }
    __device__ __forceinline__ const char* a(const Unit& u) const { return (const char*)A + (size_t)u.pm * 262144; }
    __device__ __forceinline__ const char* b(const Unit& u) const { return (const char*)Bt + (size_t)(u.pm >> 5) * estride + (size_t)u.pn * BM * ldb * 2; } };
struct GLruGate { const bf16_t* A; const bf16_t* Bt; int lda, ldb, K;
    __device__ __forceinline__ size_t kstep_a() const { return 128; }
    __device__ __forceinline__ const char* a(const Unit& u) const { return (const char*)A + (size_t)u.pm * BM * lda * 2 + (size_t)((u.pn >> 1) & 3) * 512; }
    __device__ __forceinline__ const char* b(const Unit& u) const { return (const char*)Bt + (size_t)u.pn * BM * ldb * 2; } };

template <class E, class = void> struct SwapB1 : std::false_type {};
template <class E> struct SwapB1<E, std::void_t<decltype(E::SWAPB1)>> : std::bool_constant<E::SWAPB1> {};
template <bool GATHER = false, bool FP8 = false, class Epi, class GD, class Sched>
__device__ __forceinline__ void gemm_phase(LAS unsigned char* lds, const GD g, const Sched& S, const Epi& E) {
    const int tid = opaque((int)threadIdx.x), wid = __builtin_amdgcn_readfirstlane(tid >> 6), lane = tid & 63, wr = wid >> 2, wc = wid & 3, fr = lane & 15, fq = lane >> 4;
    const int K = g.K, nt = K / BK;
    unsigned voffA[2], voffB[2]; int RA[2];
#pragma unroll
    for (int i = 0; i < 2; ++i) { int R, C; stage_rc(tid * 16 + i * 8192, R, C); const int Rb = Epi::PERM ? ((R & ~31) + perm32(R & 31)) : R;
        RA[i] = R; voffA[i] = GATHER ? (unsigned)C * 2u : (unsigned)(R * g.lda + C) * 2u; voffB[i] = (unsigned)(Rb * g.ldb + C) * 2u; }
    LAS unsigned* IDX = (LAS unsigned*)(lds + STAGE_BYTES);
    unsigned vA[2][2] = {{0u, 0u}, {0u, 0u}}, nvA[2][2] = {{0u, 0u}, {0u, 0u}};
    if constexpr (GATHER) {
        for (int i = 0; i < 16; ++i) { Unit uu; if (!S.next(i, uu)) break; if (tid < 256) IDX[i * 256 + tid] = (unsigned)g.rowtok[uu.pm * 256 + tid] * (unsigned)(g.lda * 2); }
        __syncthreads();
#pragma unroll
        for (int h = 0; h < 2; ++h)
#pragma unroll
            for (int i = 0; i < 2; ++i) vA[h][i] = IDX[h * HALF + RA[i]] + voffA[i];
    }
    const size_t kstep = (size_t)(BK * 2);
    const size_t kstepA = g.kstep_a();
    const size_t hstepA = (size_t)HALF * g.lda * 2, hstepB = (size_t)HALF * g.ldb * 2;
    const unsigned ldsw = (unsigned)wid * 1024u;
    const int aoff = lds_byte(wr * 64 + fr, fq * 8), boff = lds_byte(wc * 32 + fr, fq * 8);
#define PG8_SA(b, h) (((b) * 2 + (h)) * HTB)
#define PG8_SB(b, h) ((4 + (b) * 2 + (h)) * HTB)
#define PG8_STAGE(bufoff, gbase, voff) do { _Pragma("unroll") for (int _i = 0; _i < 2; ++_i) \
        __builtin_amdgcn_global_load_lds((const unsigned*)((const char*)(gbase) + (voff)[_i]), (LAS unsigned*)(lds + (bufoff) + ldsw + _i * 8192), 16, 0, 0); } while (0)
#define PG8_STAGE_GA(bufoff, gbase, VA) do { _Pragma("unroll") for (int _i = 0; _i < 2; ++_i) \
        __builtin_amdgcn_global_load_lds((const unsigned*)((const char*)(gbase) + (VA)[_i]), (LAS unsigned*)(lds + (bufoff) + ldsw + _i * 8192), 16, 0, 0); } while (0)
#define PG8_STAGE_A(bufoff, gbase, h, VA) do { if constexpr (GATHER) PG8_STAGE_GA(bufoff, gbase, (VA)[h]); else PG8_STAGE(bufoff, (gbase) + (h) * hstepA, voffA); } while (0)
#define PG8_LDA(dst, b, h) do { if constexpr (FP8) { _Pragma("unroll") for (int m = 0; m < 4; ++m) { const i32x4 _lo = *(const LAS i32x4*)(lds + PG8_SA(b, h) + aoff + m * 2048), _hi = *(const LAS i32x4*)(lds + PG8_SA(b, h) + aoff + m * 2048 + 1024); \
            dst##8[m] = __builtin_shufflevector(_lo, _hi, 0, 1, 2, 3, 4, 5, 6, 7); } } \
        else { _Pragma("unroll") for (int m = 0; m < 4; ++m) _Pragma("unroll") for (int k = 0; k < 2; ++k) dst[m][k] = *(const LAS bf16x8*)(lds + PG8_SA(b, h) + aoff + m * 2048 + k * 1024); } } while (0)
#define PG8_LDB(dst, b, h) do { if constexpr (FP8) { _Pragma("unroll") for (int n = 0; n < 2; ++n) { const i32x4 _lo = *(const LAS i32x4*)(lds + PG8_SB(b, h) + boff + n * 2048), _hi = *(const LAS i32x4*)(lds + PG8_SB(b, h) + boff + n * 2048 + 1024); \
            dst##8[n] = __builtin_shufflevector(_lo, _hi, 0, 1, 2, 3, 4, 5, 6, 7); } } \
        else { _Pragma("unroll") for (int n = 0; n < 2; ++n) _Pragma("unroll") for (int k = 0; k < 2; ++k) dst[n][k] = *(const LAS bf16x8*)(lds + PG8_SB(b, h) + boff + n * 2048 + k * 1024); } } while (0)
#define PG8_MMA(ai, bj, At, Bt) do { __builtin_amdgcn_s_setprio(1); \
        if constexpr (FP8) { _Pragma("unroll") for (int m = 0; m < 4; ++m) _Pragma("unroll") for (int n = 0; n < 2; ++n) \
            asm volatile("v_mfma_scale_f32_16x16x128_f8f6f4 %0, %1, %2, %0, %3, %3 op_sel_hi:[0,0,0]" : "+v"(acc[ai][bj][m][n]) : "v"(Bt##8[n]), "v"(At##8[m]), "v"(f8scale)); } \
        else if constexpr (SwapB1<Epi>::value && (bj) == 1) { _Pragma("unroll") for (int m = 0; m < 4; ++m) _Pragma("unroll") for (int n = 0; n < 2; ++n) _Pragma("unroll") for (int k = 0; k < 2; ++k) \
            acc[ai][bj][m][n] = __builtin_amdgcn_mfma_f32_16x16x32_bf16(At[m][k], Bt[n][k], acc[ai][bj][m][n], 0, 0, 0); } \
        else { _Pragma("unroll") for (int m = 0; m < 4; ++m) _Pragma("unroll") for (int n = 0; n < 2; ++n) _Pragma("unroll") for (int k = 0; k < 2; ++k) \
            acc[ai][bj][m][n] = __builtin_amdgcn_mfma_f32_16x16x32_bf16(Bt[n][k], At[m][k], acc[ai][bj][m][n], 0, 0, 0); } \
        __builtin_amdgcn_s_setprio(0); } while (0)
#define PG8_WAIT_V(n) asm volatile("s_waitcnt vmcnt(" #n ")" ::: "memory")
#define PG8_WAIT_L(n) asm volatile("s_waitcnt lgkmcnt(" #n ")" ::: "memory")
#define PG8_BAR __builtin_amdgcn_s_barrier()
#define PG8_SCHED __builtin_amdgcn_sched_barrier(0)
    Unit cur, nxt; int ui = 0;
    if (!S.next(0, cur)) return;
    f32x4 acc[2][2][4][2];
#pragma unroll
    for (int a = 0; a < 2; ++a)
#pragma unroll
        for (int b = 0; b < 2; ++b)
#pragma unroll
            for (int m = 0; m < 4; ++m)
#pragma unroll
                for (int n = 0; n < 2; ++n) acc[a][b][m][n] = (f32x4){0.f, 0.f, 0.f, 0.f};
    const int f8scale = 0x7f7f7f7f;
    bf16x8 At[4][2], B0[2][2], B1[2][2]; i32x8 At8[4], B08[2], B18[2];
    const char* cA = GATHER ? (const char*)g.A : g.a(cur); const char* cB = g.b(cur);
    PG8_STAGE(PG8_SB(0, 0), cB, voffB); PG8_STAGE_A(PG8_SA(0, 0), cA, 0, vA); PG8_STAGE(PG8_SB(0, 1), cB + hstepB, voffB); PG8_STAGE_A(PG8_SA(0, 1), cA, 1, vA);
    if (wr == 1) PG8_BAR;
    PG8_WAIT_V(4); PG8_BAR;
    PG8_STAGE(PG8_SB(1, 0), cB + kstep, voffB); PG8_STAGE_A(PG8_SA(1, 0), cA + kstepA, 0, vA); PG8_STAGE(PG8_SB(1, 1), cB + hstepB + kstep, voffB);
    PG8_WAIT_V(6); PG8_BAR;
    for (;;) {
        const bool has_next = S.next(ui + 1, nxt);
        const char* nA = GATHER ? cA : (has_next ? g.a(nxt) : cA); const char* nB = has_next ? g.b(nxt) : cB;
        if constexpr (GATHER) {
#pragma unroll
            for (int h = 0; h < 2; ++h)
#pragma unroll
                for (int i = 0; i < 2; ++i) nvA[h][i] = has_next ? IDX[(ui + 1) * 256 + h * HALF + RA[i]] + voffA[i] : vA[h][i];
        }
#pragma unroll 1
        for (int t = 0; t < nt; t += 2) {
            const bool last = (t == nt - 2);
            const char* a1 = cA + (size_t)(t + 1) * kstepA;
            const char* a2 = last ? nA : cA + (size_t)(t + 2) * kstepA; const char* b2 = last ? nB : cB + (size_t)(t + 2) * kstep;
            const char* a3 = a2 + kstepA; const char* b3 = b2 + kstep;
            unsigned sA[2][2];
#pragma unroll
            for (int h = 0; h < 2; ++h)
#pragma unroll
                for (int i = 0; i < 2; ++i) sA[h][i] = last ? nvA[h][i] : vA[h][i];
            PG8_LDB(B0, 0, 0); PG8_SCHED; PG8_LDA(At, 0, 0); PG8_STAGE_A(PG8_SA(1, 1), a1, 1, vA);
            PG8_WAIT_L(8); PG8_WAIT_V(10); PG8_BAR; PG8_WAIT_L(0); PG8_MMA(0, 0, At, B0); PG8_BAR; PG8_SCHED;
            PG8_LDB(B1, 0, 1); PG8_STAGE(PG8_SB(0, 0), b2, voffB);
            PG8_WAIT_V(10); PG8_BAR; PG8_WAIT_L(0); PG8_MMA(0, 1, At, B1); PG8_BAR;
            PG8_LDA(At, 0, 1); PG8_STAGE_A(PG8_SA(0, 0), a2, 0, sA);
            PG8_WAIT_V(10); PG8_BAR; PG8_WAIT_L(0); PG8_MMA(1, 0, At, B0); PG8_BAR; PG8_SCHED;
            PG8_STAGE(PG8_SB(0, 1), b2 + hstepB, voffB);
            PG8_WAIT_V(10); PG8_BAR; PG8_MMA(1, 1, At, B1); PG8_BAR;
            PG8_LDB(B0, 1, 0); PG8_SCHED; PG8_LDA(At, 1, 0); PG8_STAGE_A(PG8_SA(0, 1), a2, 1, sA);
            PG8_WAIT_L(8); PG8_WAIT_V(10); PG8_BAR; PG8_WAIT_L(0); PG8_MMA(0, 0, At, B0); PG8_BAR; PG8_SCHED;
            PG8_LDB(B1, 1, 1); PG8_STAGE(PG8_SB(1, 0), b3, voffB);
            PG8_WAIT_V(10); PG8_BAR; PG8_WAIT_L(0); PG8_MMA(0, 1, At, B1); PG8_BAR;
            PG8_LDA(At, 1, 1); PG8_STAGE_A(PG8_SA(1, 0), a3, 0, sA);
            PG8_WAIT_V(10); PG8_BAR; PG8_WAIT_L(0); PG8_MMA(1, 0, At, B0); PG8_BAR; PG8_SCHED;
            PG8_STAGE(PG8_SB(1, 1), b3 + hstepB, voffB);
            PG8_WAIT_V(10); PG8_BAR; PG8_MMA(1, 1, At, B1); PG8_BAR;
        }
        if constexpr (FP8) asm volatile("s_nop 15\n\ts_nop 15" ::: "memory");
        E(acc, cur, wr, wc, fr, fq);
        if (!has_next) break;
#pragma unroll
        for (int a = 0; a < 2; ++a)
#pragma unroll
            for (int b = 0; b < 2; ++b)
#pragma unroll
                for (int m = 0; m < 4; ++m)
#pragma unroll
                    for (int n = 0; n < 2; ++n) acc[a][b][m][n] = (f32x4){0.f, 0.f, 0.f, 0.f};
        cur = nxt; cA = nA; cB = nB; ++ui;
        if constexpr (GATHER) {
#pragma unroll
            for (int h = 0; h < 2; ++h)
#pragma unroll
                for (int i = 0; i < 2; ++i) vA[h][i] = nvA[h][i];
        }
    }
    PG8_WAIT_V(0);
    if (wr == 0) PG8_BAR;
    PG8_BAR;
#undef PG8_SA
#undef PG8_SB
#undef PG8_STAGE
#undef PG8_STAGE_GA
#undef PG8_STAGE_A
#undef PG8_LDA
#undef PG8_LDB
#undef PG8_MMA
#undef PG8_WAIT_V
#undef PG8_WAIT_L
#undef PG8_BAR
#undef PG8_SCHED
}

#define EPI_ROWS_BEGIN for (int ai = 0; ai < 2; ++ai) for (int m = 0; m < 4; ++m) { const int row = opaque(u.pm * BM + ai * HALF + wr * 64 + m * 16 + fr);
#define EPI_ROWS_END }
__device__ __forceinline__ u32x4 pack8(const f32x4 a, const f32x4 b) { u32x4 w; w.x = cvt_pk_bf16(a[0], a[1]); w.y = cvt_pk_bf16(a[2], a[3]); w.z = cvt_pk_bf16(b[0], b[1]); w.w = cvt_pk_bf16(b[2], b[3]); return w; }

struct EpiIn {
    static constexpr bool PERM = true;
    bf16_t* Z; int ldz, nz, nscale; float qscale; int split_cols; size_t split_stride; float* sm; int nsm; const float* smbias; float ascale = 1.0f;
    __device__ __forceinline__ void operator()(const f32x4 (&acc)[2][2][4][2], const Unit& u, int wr, int wc, int fr_, int fq_) const {
        const int fr = opaque(fr_), fq = opaque(fq_);
        if (u.pn < nz) {
            int colt = u.pn * BM; bf16_t* base = Z;
            if (split_cols) { const int t = colt / split_cols; base += (size_t)t * split_stride; colt -= t * split_cols; }
            const int col0 = colt + wc * 32 + 8 * fq; const float sc = ((u.pn < nscale) ? qscale : 1.0f) * ascale;
#pragma unroll
            for (int ai = 0; ai < 2; ++ai)
#pragma unroll
                for (int m = 0; m < 4; ++m) { const int row = opaque(u.pm * BM + ai * HALF + wr * 64 + m * 16 + fr); bf16_t* rowp = base + (size_t)row * ldz + col0;
#pragma unroll
                    for (int bj = 0; bj < 2; ++bj) *(u32x4*)(rowp + bj * HALF) = pack8(acc[ai][bj][m][0] * sc, acc[ai][bj][m][1] * sc); }
        } else if (u.pn == nz && sm) {
            if (wc == 0 && 8 * fq < nsm) {
                f32x4 b0 = {0.f, 0.f, 0.f, 0.f}, b1 = {0.f, 0.f, 0.f, 0.f};
                if (smbias) { b0 = *(const f32x4*)(smbias + 8 * fq); b1 = *(const f32x4*)(smbias + 8 * fq + 4); }
#pragma unroll
                for (int ai = 0; ai < 2; ++ai)
#pragma unroll
                    for (int m = 0; m < 4; ++m) { const int row = opaque(u.pm * BM + ai * HALF + wr * 64 + m * 16 + fr); float* rp = sm + (size_t)row * nsm + 8 * fq;
                        *(f32x4*)rp = acc[ai][0][m][0] * ascale + b0; *(f32x4*)(rp + 4) = acc[ai][0][m][1] * ascale + b1; }
            }
        }
    }
};
struct EpiOut {
    static constexpr bool PERM = false;
    const float* xres; float* Y;
    __device__ __forceinline__ void operator()(const f32x4 (&acc)[2][2][4][2], const Unit& u, int wr, int wc, int fr_, int fq_) const {
        const int fr = opaque(fr_), fq = opaque(fq_);
        const int col0 = u.pn * BM + wc * 32 + 4 * fq;
#pragma unroll
        for (int ai = 0; ai < 2; ++ai)
#pragma unroll
            for (int m = 0; m < 4; ++m) { const size_t off = (size_t)opaque(u.pm * BM + ai * HALF + wr * 64 + m * 16 + fr) * DM + col0;
#pragma unroll
                for (int bj = 0; bj < 2; ++bj)
#pragma unroll
                    for (int n = 0; n < 2; ++n) { const f32x4 xr = *(const f32x4*)(xres + off + bj * HALF + n * 16); *(f32x4*)(Y + off + bj * HALF + n * 16) = xr * ALPHA + acc[ai][bj][m][n]; } }
    }
};
struct EpiOutB {
    static constexpr bool PERM = true;
    const bf16_t* __restrict__ X; bf16_t* __restrict__ Y; float scale;
    __device__ __forceinline__ void operator()(const f32x4 (&acc)[2][2][4][2], const Unit& u, int wr, int wc, int fr_, int fq_) const {
        const int fr = opaque(fr_), fq = opaque(fq_);
        const int col0 = u.pn * BM + wc * 32 + 8 * fq;
#pragma unroll
        for (int ai = 0; ai < 2; ++ai) {
            const size_t off0 = (size_t)opaque(u.pm * BM + ai * HALF + wr * 64 + fr) * DM + col0;
            u32x4 xw[4][2];
#pragma unroll
            for (int m = 0; m < 4; ++m)
#pragma unroll
                for (int bj = 0; bj < 2; ++bj) xw[m][bj] = *(const u32x4*)(X + off0 + (size_t)m * 16 * DM + bj * HALF);
#pragma unroll
            for (int m = 0; m < 4; ++m)
#pragma unroll
                for (int bj = 0; bj < 2; ++bj) { const u32x4 w = xw[m][bj];
                    const f32x4 x0 = {bf_lo(w.x), bf_hi(w.x), bf_lo(w.y), bf_hi(w.y)}, x1 = {bf_lo(w.z), bf_hi(w.z), bf_lo(w.w), bf_hi(w.w)};
                    *(u32x4*)(Y + off0 + (size_t)m * 16 * DM + bj * HALF) = pack8(x0 * ALPHA + acc[ai][bj][m][0] * scale, x1 * ALPHA + acc[ai][bj][m][1] * scale); }
        }
    }
};
struct EpiSwiglu {
    static constexpr bool PERM = true;
    bf16_t* Hd;
    __device__ __forceinline__ void operator()(const f32x4 (&acc)[2][2][4][2], const Unit& u, int wr, int wc, int fr_, int fq_) const {
        const int fr = opaque(fr_), fq = opaque(fq_);
        const int col0 = u.pn * HALF + wc * 32 + 8 * fq;
#pragma unroll
        for (int ai = 0; ai < 2; ++ai)
#pragma unroll
            for (int m = 0; m < 4; ++m) { const int row = opaque(u.pm * BM + ai * HALF + wr * 64 + m * 16 + fr);
                f32x4 h0, h1;
#pragma unroll
                for (int j = 0; j < 4; ++j) { h0[j] = siluf_(acc[ai][0][m][0][j]) * acc[ai][1][m][0][j]; h1[j] = siluf_(acc[ai][0][m][1][j]) * acc[ai][1][m][1][j]; }
                *(u32x4*)(Hd + (size_t)u.pm * 262144 + (size_t)(col0 >> 6) * 16384 + (size_t)(row & 255) * 64 + (col0 & 63)) = pack8(h0, h1); }
    }
};
struct EpiSwiglu8 {
    static constexpr bool PERM = true;
    unsigned char* Hd;
    __device__ __forceinline__ void operator()(const f32x4 (&acc)[2][2][4][2], const Unit& u, int wr, int wc, int fr_, int fq_) const {
        const int fr = opaque(fr_), fq = opaque(fq_);
        const int c0 = wc * 32 + 8 * fq;
#pragma unroll
        for (int ai = 0; ai < 2; ++ai)
#pragma unroll
            for (int m = 0; m < 4; ++m) { const int r = ai * HALF + wr * 64 + m * 16 + fr;
                float h[8];
#pragma unroll
                for (int n = 0; n < 2; ++n)
#pragma unroll
                    for (int j = 0; j < 4; ++j) h[4 * n + j] = siluf_(acc[ai][0][m][n][j] * (1.0f / F8_SW1)) * acc[ai][1][m][n][j] * (F8_SH / F8_SW1);
                u32x2 o; o.x = pk4_fp8(h[0], h[1], h[2], h[3]); o.y = pk4_fp8(h[4], h[5], h[6], h[7]);
                *(u32x2*)(Hd + (size_t)u.pm * 262144 + (size_t)u.pn * 32768 + (size_t)r * 128 + c0) = o; }
    }
};
struct EpiBf16S {
    static constexpr bool PERM = true;
    bf16_t* O; int ldc; float scale;
    __device__ __forceinline__ void operator()(const f32x4 (&acc)[2][2][4][2], const Unit& u, int wr, int wc, int fr_, int fq_) const {
        const int fr = opaque(fr_), fq = opaque(fq_);
        const int col0 = u.pn * BM + wc * 32 + 8 * fq;
#pragma unroll
        for (int ai = 0; ai < 2; ++ai)
#pragma unroll
            for (int m = 0; m < 4; ++m) { const int row = opaque(u.pm * BM + ai * HALF + wr * 64 + m * 16 + fr); bf16_t* rowp = O + (size_t)row * ldc + col0;
#pragma unroll
                for (int bj = 0; bj < 2; ++bj) *(u32x4*)(rowp + bj * HALF) = pack8(acc[ai][bj][m][0] * scale, acc[ai][bj][m][1] * scale); }
    }
};
struct EpiFp8S {
    static constexpr bool PERM = true;
    unsigned char* O; int ldc; float scale;
    __device__ __forceinline__ void operator()(const f32x4 (&acc)[2][2][4][2], const Unit& u, int wr, int wc, int fr_, int fq_) const {
        const int fr = opaque(fr_), fq = opaque(fq_);
        const int col0 = u.pn * BM + wc * 32 + 8 * fq;
#pragma unroll
        for (int ai = 0; ai < 2; ++ai)
#pragma unroll
            for (int m = 0; m < 4; ++m) { const int row = opaque(u.pm * BM + ai * HALF + wr * 64 + m * 16 + fr); unsigned char* rowp = O + (size_t)row * ldc + col0;
#pragma unroll
                for (int bj = 0; bj < 2; ++bj) { const f32x4 a = acc[ai][bj][m][0] * scale, b = acc[ai][bj][m][1] * scale; u32x2 o; o.x = pk4_fp8(a[0], a[1], a[2], a[3]); o.y = pk4_fp8(b[0], b[1], b[2], b[3]);
                    *(u32x2*)(rowp + bj * HALF) = o; } }
    }
};
struct EpiBf16 {
    static constexpr bool PERM = true;
    bf16_t* O; int ldc;
    __device__ __forceinline__ void operator()(const f32x4 (&acc)[2][2][4][2], const Unit& u, int wr, int wc, int fr_, int fq_) const {
        const int fr = opaque(fr_), fq = opaque(fq_);
        const int col0 = u.pn * BM + wc * 32 + 8 * fq;
#pragma unroll
        for (int ai = 0; ai < 2; ++ai)
#pragma unroll
            for (int m = 0; m < 4; ++m) { const int row = opaque(u.pm * BM + ai * HALF + wr * 64 + m * 16 + fr); bf16_t* rowp = O + (size_t)row * ldc + col0;
#pragma unroll
                for (int bj = 0; bj < 2; ++bj) *(u32x4*)(rowp + bj * HALF) = pack8(acc[ai][bj][m][0], acc[ai][bj][m][1]); }
    }
};
struct EpiLruGate {
    static constexpr bool PERM = true;
    const bf16_t* UC; const float* ba; const float* bx; const float* lam;
    bf16_t* LA0; bf16_t* GT0; bf16_t* LA1; bf16_t* GT1;
    __device__ __forceinline__ void operator()(const f32x4 (&acc)[2][2][4][2], const Unit& u, int wr, int wc, int fr_, int fq_) const {
        const int fr = opaque(fr_), fq = opaque(fq_);
        const int dir = u.pn >> 3, ch0 = ((u.pn >> 1) & 3) * 256 + (u.pn & 1) * 128 + wc * 32 + 8 * fq;
        bf16_t* LA = dir ? LA1 : LA0; bf16_t* GT = dir ? GT1 : GT0;
#pragma unroll
        for (int n = 0; n < 2; ++n) {
            const int cc = dir * 1024 + ch0 + 4 * n;
            const f32x4 vba = *(const f32x4*)(ba + cc), vbx = *(const f32x4*)(bx + cc); f32x4 vll = *(const f32x4*)(lam + cc);
#pragma unroll
            for (int j = 0; j < 4; ++j) vll[j] = 8.0f * logsigmoidf_(vll[j]);
#pragma unroll
            for (int ai = 0; ai < 2; ++ai) {
                const size_t off0 = (size_t)opaque(u.pm * BM + ai * HALF + wr * 64 + fr) * 1024 + ch0 + 4 * n;
                u32x2 uw[4];
#pragma unroll
                for (int m = 0; m < 4; ++m) uw[m] = *(const u32x2*)(UC + off0 + (size_t)m * 16 * 1024);
#pragma unroll
                for (int m = 0; m < 4; ++m) {
                    const float uv[4] = {bf_lo(uw[m].x), bf_hi(uw[m].x), bf_lo(uw[m].y), bf_hi(uw[m].y)};
                    float la[4], gt[4];
#pragma unroll
                    for (int j = 0; j < 4; ++j) { const float r = sigmoid_fast(acc[ai][0][m][n][j] + vba[j]), ig = sigmoid_fast(acc[ai][1][m][n][j] + vbx[j]);
                        const float l = r * vll[j]; la[j] = l; gt[j] = __builtin_amdgcn_sqrtf(fmaxf(1.0f - __expf(2.0f * l), 0.f)) * ig * uv[j]; }
                    u32x2 o1; o1.x = cvt_pk_bf16(la[0], la[1]); o1.y = cvt_pk_bf16(la[2], la[3]);
                    *(u32x2*)(LA + off0 + (size_t)m * 16 * 1024) = o1;
                    *(unsigned*)((unsigned char*)GT + off0 + (size_t)m * 16 * 1024) = pk4_fp8(gt[0] * F8_SG, gt[1] * F8_SG, gt[2] * F8_SG, gt[3] * F8_SG); }
                __builtin_amdgcn_sched_barrier(0);
            }
        }
    }
};
#ifndef ATT_FP8
#define ATT_FP8 1
#endif
struct EpiMlaQ {
    static constexpr bool PERM = true;
    bf16_t* Q; const float* cs; const float* sn;
    __device__ __forceinline__ void st8(size_t eoff, const f32x4 a, const f32x4 b) const {
        if (ATT_FP8) { u32x2 o; o.x = pk4_fp8(a[0], a[1], a[2], a[3]); o.y = pk4_fp8(b[0], b[1], b[2], b[3]); *(u32x2*)((unsigned char*)Q + eoff) = o; }
        else *(u32x4*)(Q + eoff) = pack8(a, b);
    }
    __device__ __forceinline__ void operator()(const f32x4 (&acc)[2][2][4][2], const Unit& u, int wr, int wc, int fr_, int fq_) const {
        const int fr = opaque(fr_), fq = opaque(fq_);
        if (u.pn < 4) {
#pragma unroll
            for (int ai = 0; ai < 2; ++ai)
#pragma unroll
                for (int m = 0; m < 4; ++m) { const int row = opaque(u.pm * BM + ai * HALF + wr * 64 + m * 16 + fr);
#pragma unroll
                    for (int bj = 0; bj < 2; ++bj) { const int h = u.pn * 2 + bj; st8((size_t)row * 1536 + h * 192 + wc * 32 + 8 * fq, acc[ai][bj][m][0], acc[ai][bj][m][1]); } }
        } else {
            const int h = (u.pn - 4) * 4 + wc, i0 = 8 * fq;
#pragma unroll
            for (int ai = 0; ai < 2; ++ai) {
                const int row0 = opaque(u.pm * BM + ai * HALF + wr * 64 + fr);
                f32x4 c[4][2], s[4][2];
#pragma unroll
                for (int m = 0; m < 4; ++m)
#pragma unroll
                    for (int n = 0; n < 2; ++n) { c[m][n] = *(const f32x4*)(cs + (size_t)(row0 + 16 * m) * 32 + i0 + 4 * n); s[m][n] = *(const f32x4*)(sn + (size_t)(row0 + 16 * m) * 32 + i0 + 4 * n); }
#pragma unroll
                for (int m = 0; m < 4; ++m) { f32x4 o1[2], o2[2];
#pragma unroll
                    for (int n = 0; n < 2; ++n) { const f32x4 x1 = acc[ai][0][m][n], x2 = acc[ai][1][m][n]; o1[n] = x1 * c[m][n] - x2 * s[m][n]; o2[n] = x2 * c[m][n] + x1 * s[m][n]; }
                    const size_t qo = (size_t)(row0 + 16 * m) * 1536 + h * 192 + 128 + i0;
                    st8(qo, o1[0], o1[1]); st8(qo + 32, o2[0], o2[1]); }
            }
        }
    }
};
#ifndef ATT_PV8
#define ATT_PV8 0
#endif
struct EpiMlaKV {
    static constexpr bool PERM = true;
    static constexpr bool SWAPB1 = (ATT_FP8 && ATT_PV8);
    bf16_t* Kc; bf16_t* Vc;
    __device__ __forceinline__ void operator()(const f32x4 (&acc)[2][2][4][2], const Unit& u, int wr, int wc, int fr_, int fq_) const {
        const int fr = opaque(fr_), fq = opaque(fq_);
        const int h = u.pn, c0 = wc * 32 + 8 * fq;
#pragma unroll
        for (int ai = 0; ai < 2; ++ai)
#pragma unroll
            for (int m = 0; m < 4; ++m) { const int row = opaque(u.pm * BM + ai * HALF + wr * 64 + m * 16 + fr); const int b = row >> 11, s = row & 2047;
                const size_t r = ((size_t)(b * 8 + h) * SEQ + s);
                if (ATT_FP8) { u32x2 o; o.x = pk4_fp8(acc[ai][0][m][0][0], acc[ai][0][m][0][1], acc[ai][0][m][0][2], acc[ai][0][m][0][3]); o.y = pk4_fp8(acc[ai][0][m][1][0], acc[ai][0][m][1][1], acc[ai][0][m][1][2], acc[ai][0][m][1][3]);
                    *(u32x2*)((unsigned char*)Kc + r * 192 + c0) = o; }
                else *(u32x4*)(Kc + r * 192 + c0) = pack8(acc[ai][0][m][0], acc[ai][0][m][1]);
                if (!SWAPB1) *(u32x4*)(Vc + r * 128 + c0) = pack8(acc[ai][1][m][0], acc[ai][1][m][1]); }
        if (SWAPB1) {
#pragma unroll
            for (int n = 0; n < 2; ++n) { const int dv = wc * 32 + perm32(16 * n + fr);
#pragma unroll
                for (int ai = 0; ai < 2; ++ai)
#pragma unroll
                    for (int m = 0; m < 4; ++m) { const int row = opaque(u.pm * BM + ai * HALF + wr * 64 + m * 16 + 4 * fq); const int b = row >> 11, s0 = row & 2047;
                        const f32x4 v = acc[ai][1][m][n] * F8_SV;
                        *(unsigned*)((unsigned char*)Vc + ((size_t)((b * 8 + h) * 128 + dv)) * SEQ + s0) = pk4_fp8(v[0], v[1], v[2], v[3]); } }
        }
    }
};
}
#ifndef INP_FP8
#define INP_FP8 0
#endif
#ifndef OUT_FP8
#define OUT_FP8 0
#endif
#ifndef MOE_FP8
#define MOE_FP8 1
#endif
struct Ctx {
    LAS unsigned char* lds;
    int tid, lane, wave, G, gw, NGW;
    const void* const* in;
    float* out; unsigned char* ws;
};
#define IN_F(i) ((const float*)C.in[i])
enum { I_X = 0, I_POS, I_ML_WIN, I_ML_GB, I_ML_NG, I_ML_WOUT, I_GL_WIN, I_GL_GW, I_GL_GB, I_GL_NG, I_GL_WOUT,
       I_LR_WIN, I_LR_CW, I_LR_CB, I_LR_GAW, I_LR_GAB, I_LR_GXW, I_LR_GXB, I_LR_LAM, I_LR_WOUT,
       I_MA_WIN, I_MA_QG, I_MA_KVG, I_MA_UQ, I_MA_UKV, I_MA_WOUT, I_MOE_R, I_MOE_G, I_MOE_U, I_MOE_D, I_LN_G, I_LN_B, N_IN };

#ifndef USE_TOUCH
#define USE_TOUCH 0
#endif
__device__ __forceinline__ void touch_region(Ctx& C, const void* p, size_t bytes) {
    if (!USE_TOUCH) return;
    const u32x4* q = (const u32x4*)p; const size_t n = bytes / 16; unsigned acc = 0u;
    for (size_t i = (size_t)blockIdx.x * 512 + C.tid; i < n; i += (size_t)C.G * 512 * 4) {
        u32x4 v0 = q[i], v1 = {0u, 0u, 0u, 0u}, v2 = v1, v3 = v1;
        if (i + (size_t)C.G * 512 < n) v1 = q[i + (size_t)C.G * 512];
        if (i + (size_t)C.G * 1024 < n) v2 = q[i + (size_t)C.G * 1024];
        if (i + (size_t)C.G * 1536 < n) v3 = q[i + (size_t)C.G * 1536];
        acc ^= (v0.x ^ v1.x) ^ (v2.x ^ v3.x);
    }
    asm volatile("" :: "v"(acc));
    __syncthreads();
}
template <class RM>
__device__ __forceinline__ void tr_item(const float* W, int ldw, int nsrc, bf16_t* WT, int ldk, LAS float* scr, int k0, int n0, int lane, RM rowmap) {
    { const int n4 = (lane & 7) * 4; f32x4 w[8];
#pragma unroll
      for (int i = 0; i < 8; ++i) { const int kk = 8 * i + (lane >> 3); w[i] = (n0 + n4 < nsrc) ? *(const f32x4*)(W + (size_t)(k0 + kk) * ldw + n0 + n4) : (f32x4){0.f, 0.f, 0.f, 0.f}; }
#pragma unroll
      for (int i = 0; i < 8; ++i) { const int kk = 8 * i + (lane >> 3); LAS float* d = scr + kk * 33 + n4; d[0] = w[i][0]; d[1] = w[i][1]; d[2] = w[i][2]; d[3] = w[i][3]; } }
    LDS_WAIT(); asm volatile("" ::: "memory");
    const int c = lane & 7;
#pragma unroll
    for (int j = 0; j < 4; ++j) { const int n = (lane >> 3) + 8 * j; const LAS float* s = scr + (8 * c) * 33 + n;
        u32x4 o; o.x = cvt_pk_bf16(s[0 * 33], s[1 * 33]); o.y = cvt_pk_bf16(s[2 * 33], s[3 * 33]); o.z = cvt_pk_bf16(s[4 * 33], s[5 * 33]); o.w = cvt_pk_bf16(s[6 * 33], s[7 * 33]);
        *(u32x4*)(WT + (size_t)rowmap(n0 + n) * ldk + k0 + 8 * c) = o; }
    LDS_WAIT(); asm volatile("" ::: "memory");
}
template <class RM>
__device__ __forceinline__ void tr_item8(const float* W, int ldw, unsigned char* WT, int ldkb, LAS float* scr, int k0, int n0, int lane, float scale, RM rowmap, int nsrc = 1 << 30) {
    { const int n4 = (lane & 7) * 4; f32x4 w[8];
#pragma unroll
      for (int i = 0; i < 8; ++i) { const int kk = 8 * i + (lane >> 3); w[i] = (n0 + n4 < nsrc) ? *(const f32x4*)(W + (size_t)(k0 + kk) * ldw + n0 + n4) : (f32x4){0.f, 0.f, 0.f, 0.f}; }
#pragma unroll
      for (int i = 0; i < 8; ++i) { const int kk = 8 * i + (lane >> 3); LAS float* d = scr + kk * 33 + n4; d[0] = w[i][0]; d[1] = w[i][1]; d[2] = w[i][2]; d[3] = w[i][3]; } }
    LDS_WAIT(); asm volatile("" ::: "memory");
    const int c = lane & 7;
#pragma unroll
    for (int j = 0; j < 4; ++j) { const int n = (lane >> 3) + 8 * j; const LAS float* s = scr + (8 * c) * 33 + n;
        u32x2 o; o.x = pk4_fp8(s[0 * 33] * scale, s[1 * 33] * scale, s[2 * 33] * scale, s[3 * 33] * scale); o.y = pk4_fp8(s[4 * 33] * scale, s[5 * 33] * scale, s[6 * 33] * scale, s[7 * 33] * scale);
        *(u32x2*)(WT + (size_t)rowmap(n0 + n) * ldkb + k0 + 8 * c) = o; }
    LDS_WAIT(); asm volatile("" ::: "memory");
}
__device__ __forceinline__ void prep_moe_weights8(Ctx& C, int layer) {
    LAS float* scr = (LAS float*)(C.lds + C.wave * 16384);
    const float* wg = IN_F(I_MOE_G) + (size_t)layer * 16 * 1048576; const float* wu = IN_F(I_MOE_U) + (size_t)layer * 16 * 1048576; const float* wd = IN_F(I_MOE_D) + (size_t)layer * 16 * 1048576;
    unsigned char* W1 = C.ws + WS_WMOE; unsigned char* W2 = W1 + (size_t)16 * 2048 * 1024;
    for (int it = C.gw; it < 16 * 3 * 512; it += C.NGW) {
        const int e = it / 1536, r = it % 1536, which = r / 512, ib = r % 512, k0 = 64 * (ib / 32), n0 = 32 * (ib % 32);
        if (which < 2) tr_item8((which ? wu : wg) + (size_t)e * 1048576, 1024, W1 + (size_t)e * 2048 * 1024, 1024, scr, k0, n0, C.lane, F8_SW1, [which](int n) { return (n >> 7) * 256 + which * 128 + (n & 127); });
        else tr_item8(wd + (size_t)e * 1048576, 1024, W2 + (size_t)e * 1048576, 1024, scr, k0, n0, C.lane, F8_SW2, [](int n) { return n; });
    }
}
template <class RM>
__device__ __forceinline__ void convert_matrix(Ctx& C, const float* W, int K, int ldw, int nsrc, int npad, bf16_t* WT, int ldk, RM rowmap) {
    LAS float* scr = (LAS float*)(C.lds + C.wave * 16384);
    const int nkb = K / 64, nnb = npad / 32;
    for (int it = C.gw; it < nkb * nnb; it += C.NGW) tr_item(W, ldw, nsrc, WT, ldk, scr, 64 * (it / nnb), 32 * (it % nnb), C.lane, rowmap);
}
__device__ __forceinline__ void convert_matrix8(Ctx& C, const float* W, int K, int ldw, int N, unsigned char* WT, int ldkb, float scale, int nsrc = 1 << 30) {
    LAS float* scr = (LAS float*)(C.lds + C.wave * 16384);
    const int nkb = K / 64, nnb = N / 32;
    for (int it = C.gw; it < nkb * nnb; it += C.NGW) tr_item8(W, ldw, WT, ldkb, scr, 64 * (it / nnb), 32 * (it % nnb), C.lane, scale, [](int n) { return n; }, nsrc);
}
__device__ __forceinline__ void prep_mixer_weights(Ctx& C) {
    bf16_t* wm = (bf16_t*)(C.ws + WS_WMIX);
    auto ident = [](int n) { return n; };
    if (INP_FP8) convert_matrix8(C, IN_F(I_ML_WIN), 1024, 3088, 3328, (unsigned char*)wm + WM_ML_IN, 1024, F8_SWI, 3088); else convert_matrix(C, IN_F(I_ML_WIN), 1024, 3088, 3088, 3328, (bf16_t*)((char*)wm + WM_ML_IN), 1024, ident);
    if (OUT_FP8) convert_matrix8(C, IN_F(I_ML_WOUT), 1024, 1024, 1024, (unsigned char*)wm + WM_ML_OUT, 1024, F8_SWO); else convert_matrix(C, IN_F(I_ML_WOUT), 1024, 1024, 1024, 1024, (bf16_t*)((char*)wm + WM_ML_OUT), 1024, ident);
    if (INP_FP8) convert_matrix8(C, IN_F(I_GL_WIN), 1024, 3104, 3328, (unsigned char*)wm + WM_GL_IN, 1024, F8_SWI, 3104); else convert_matrix(C, IN_F(I_GL_WIN), 1024, 3104, 3104, 3328, (bf16_t*)((char*)wm + WM_GL_IN), 1024, ident);
    if (OUT_FP8) convert_matrix8(C, IN_F(I_GL_WOUT), 1024, 1024, 1024, (unsigned char*)wm + WM_GL_OUT, 1024, F8_SWO); else convert_matrix(C, IN_F(I_GL_WOUT), 1024, 1024, 1024, 1024, (bf16_t*)((char*)wm + WM_GL_OUT), 1024, ident);
    convert_matrix(C, IN_F(I_LR_WIN), 1024, 2048, 2048, 2048, (bf16_t*)((char*)wm + WM_LR_IN), 1024, ident);
    if (OUT_FP8) convert_matrix8(C, IN_F(I_LR_WOUT), 1024, 1024, 1024, (unsigned char*)wm + WM_LR_OUT, 1024, F8_SWO); else convert_matrix(C, IN_F(I_LR_WOUT), 1024, 1024, 1024, 1024, (bf16_t*)((char*)wm + WM_LR_OUT), 1024, ident);
    for (int sm = 0; sm < 16; ++sm) { const int which = sm >> 3, dir = (sm >> 2) & 1, blk = sm & 3;
        const float* src = (which ? IN_F(I_LR_GXW) : IN_F(I_LR_GAW)) + (size_t)(dir * 4 + blk) * 65536;
        const int rbase = dir * 2048 + blk * 512 + which * 128;
        convert_matrix(C, src, 256, 256, 256, 256, (bf16_t*)((char*)wm + WM_LR_G), 256, [rbase](int j) { return rbase + (j >> 7) * 256 + (j & 127); }); }
    convert_matrix(C, IN_F(I_MA_WIN), 1024, 704, 704, 768, (bf16_t*)((char*)wm + WM_MA_IN), 1024, ident);
    convert_matrix(C, IN_F(I_MA_UQ), 384, 1536, 1536, 1536, (bf16_t*)((char*)wm + WM_MA_UQ), 384,
                   [](int n) { const int h = n / 192, d = n - h * 192; if (d < 128) return h * 128 + d; const int i = d - 128; return 1024 + (h >> 2) * 256 + (i >> 5) * 128 + (h & 3) * 32 + (i & 31); });
    convert_matrix(C, IN_F(I_MA_UKV), 256, 2048, 2048, 2048, (bf16_t*)((char*)wm + WM_MA_UKV), 256, ident);
    convert_matrix(C, IN_F(I_MA_WOUT), 1024, 1024, 1024, 1024, (bf16_t*)((char*)wm + WM_MA_OUT), 1024, ident);
}
__device__ __forceinline__ void prep_moe_weights(Ctx& C, int layer) {
    LAS float* scr = (LAS float*)(C.lds + C.wave * 16384);
    const float* wg = IN_F(I_MOE_G) + (size_t)layer * 16 * 1048576; const float* wu = IN_F(I_MOE_U) + (size_t)layer * 16 * 1048576; const float* wd = IN_F(I_MOE_D) + (size_t)layer * 16 * 1048576;
    bf16_t* W1 = (bf16_t*)(C.ws + WS_WMOE); bf16_t* W2 = W1 + (size_t)16 * 2048 * 1024;
    for (int it = C.gw; it < 16 * 3 * 512; it += C.NGW) {
        const int e = it / 1536, r = it % 1536, which = r / 512, ib = r % 512, k0 = 64 * (ib / 32), n0 = 32 * (ib % 32);
        if (which < 2) tr_item((which ? wu : wg) + (size_t)e * 1048576, 1024, 1024, W1 + (size_t)e * 2048 * 1024, 1024, scr, k0, n0, C.lane, [which](int n) { return (n >> 7) * 256 + which * 128 + (n & 127); });
        else tr_item(wd + (size_t)e * 1048576, 1024, 1024, W2 + (size_t)e * 1048576, 1024, scr, k0, n0, C.lane, [](int n) { return n; });
    }
}
__device__ __forceinline__ void prep_xb(Ctx& C) {
    const f32x4* x = (const f32x4*)IN_F(I_X); u32x2* xb = (u32x2*)(C.ws + WS_XB);
    const size_t n4 = (size_t)NT * DM / 4;
    unsigned* x8 = (unsigned*)(C.ws + WS_XB8);
    for (size_t i = (size_t)blockIdx.x * 512 + C.tid; i < n4; i += (size_t)C.G * 512) { const f32x4 v = x[i]; u32x2 o; o.x = cvt_pk_bf16(v[0], v[1]); o.y = cvt_pk_bf16(v[2], v[3]); xb[i] = o;
        if (INP_FP8) x8[i] = pk4_fp8(v[0], v[1], v[2], v[3]); }
}
__device__ __forceinline__ void prep_rope(Ctx& C) {
    const int* pos = (const int*)C.in[I_POS]; float* cs = (float*)(C.ws + WS_ROPE); float* sn = cs + (size_t)NT * 32;
    for (size_t i = (size_t)blockIdx.x * 512 + C.tid; i < (size_t)NT * 32; i += (size_t)C.G * 512) {
        const int t = (int)(i >> 5), k = (int)(i & 31);
        const float freq = exp2f(-(float)k * (13.287712379549449f / 32.0f));
        const float ang = (float)pos[t] * freq;
        const double q = rint((double)ang * 0.15915494309189535); const float r = (float)((double)ang - q * 6.283185307179586);
        cs[i] = __cosf(r); sn[i] = __sinf(r);
    }
}

__device__ __forceinline__ void ln_row_norm(f32x4 (&v)[4], const f32x4 (&gv)[4], const f32x4 (&bv)[4]) {
    float s = 0.f;
#pragma unroll
    for (int j = 0; j < 4; ++j) s += (v[j][0] + v[j][1]) + (v[j][2] + v[j][3]);
    const float mean = wave_sum(s) * (1.f / DM); float s2 = 0.f;
#pragma unroll
    for (int j = 0; j < 4; ++j) { v[j] = v[j] - mean; s2 += (v[j][0] * v[j][0] + v[j][1] * v[j][1]) + (v[j][2] * v[j][2] + v[j][3] * v[j][3]); }
    const float rstd = 1.f / sqrtf(wave_sum(s2) * (1.f / DM) + LN_EPS);
#pragma unroll
    for (int j = 0; j < 4; ++j) v[j] = v[j] * rstd * gv[j] + bv[j];
}
__device__ __forceinline__ void router_reduce_store(const float (&p)[16], int lane, float* aff, int row) {
    float lg[16]; float mx = -3.0e38f;
#pragma unroll
    for (int e = 0; e < 16; ++e) { lg[e] = wave_sum(p[e]); mx = fmaxf(mx, lg[e]); }
    float sm = 0.f, mine = 0.f;
#pragma unroll
    for (int e = 0; e < 16; ++e) { const float ex = expf(lg[e] - mx); sm += ex; mine = (lane == e) ? ex : mine; }
    if (lane < 16) aff[((size_t)(row >> 11) * NEXP + lane) * SEQ + (row & 2047)] = mine / sm;
}
__device__ __forceinline__ float row_sum16(float v) { v += dpp_f<0xB1>(v); v += dpp_f<0x4E>(v); v += dpp_f<0x141>(v); v += dpp_f<0x140>(v); return v; }
__device__ __forceinline__ float row_max16(float v) { v = fmaxf(v, dpp_f<0xB1>(v)); v = fmaxf(v, dpp_f<0x4E>(v)); v = fmaxf(v, dpp_f<0x141>(v)); v = fmaxf(v, dpp_f<0x140>(v)); return v; }
__device__ __forceinline__ void ln1_router(Ctx& C, int layer, const bf16_t* Yb, int r0, int rs, int nr) {
    const float* g = IN_F(I_LN_G) + (size_t)(layer * 2 + 0) * DM; const float* bb = IN_F(I_LN_B) + (size_t)(layer * 2 + 0) * DM;
    const float* wr = IN_F(I_MOE_R) + (size_t)layer * DM * NEXP;
    constexpr int RP = 2064;
    LAS unsigned char* WT = C.lds;
    LAS unsigned char* XT = C.lds + 16 * RP + C.wave * (4 * RP);
    for (int i = C.tid; i < DM * NEXP; i += 512) { const int d = i >> 4, e = i & 15; *(LAS bf16_t*)(WT + e * RP + d * 2) = f2bf(wr[i]); }
    __syncthreads();
    float* aff = (float*)(C.ws + WS_SMALL + SM_AFF);
    f32x4 gv[4], bv[4];
#pragma unroll
    for (int j = 0; j < 4; ++j) { gv[j] = *(const f32x4*)(g + 4 * C.lane + 256 * j); bv[j] = *(const f32x4*)(bb + 4 * C.lane + 256 * j); }
    u32x2 n1[4], n2[4];
    { const u32x2* yr = (const u32x2*)(Yb + (size_t)r0 * DM); const u32x2* yr2 = (const u32x2*)(Yb + (size_t)(r0 + rs) * DM);
#pragma unroll
      for (int j = 0; j < 4; ++j) { n1[j] = yr[C.lane + 64 * j]; n2[j] = yr2[C.lane + 64 * j]; } }
    for (int k = 0; k < nr; ++k) { const int row = r0 + k * rs;
        f32x4 v[4];
#pragma unroll
        for (int j = 0; j < 4; ++j) { const u32x2 w = n1[j]; v[j] = (f32x4){bf_lo(w.x), bf_hi(w.x), bf_lo(w.y), bf_hi(w.y)}; n1[j] = n2[j]; }
        { const u32x2* yr = (const u32x2*)(Yb + (size_t)(r0 + (k + 2 < nr ? k + 2 : nr - 1) * rs) * DM);
#pragma unroll
            for (int j = 0; j < 4; ++j) n2[j] = yr[C.lane + 64 * j]; }
        ln_row_norm(v, gv, bv);
        u32x2* xb = (u32x2*)(C.ws + WS_XB + (size_t)row * DM * 2); u32x2 ob[4];
        LAS unsigned char* xt = XT + (k & 3) * RP + 8 * opaque(C.lane);
#pragma unroll
        for (int j = 0; j < 4; ++j) { ob[j].x = cvt_pk_bf16(v[j][0], v[j][1]); ob[j].y = cvt_pk_bf16(v[j][2], v[j][3]); xb[C.lane + 64 * j] = ob[j]; *(LAS u32x2*)(xt + 512 * j) = ob[j]; }
        if (MOE_FP8) { unsigned* x8 = (unsigned*)(C.ws + WS_XB8 + (size_t)row * DM);
#pragma unroll
            for (int j = 0; j < 4; ++j) x8[C.lane + 64 * j] = pk4_fp8(v[j][0], v[j][1], v[j][2], v[j][3]); }
        if ((k & 3) == 3) {
            const int ln = opaque(C.lane);
            const LAS unsigned char* xa = XT + (ln & 3) * RP + (ln >> 4) * 16; const LAS unsigned char* wb = WT + (ln & 15) * RP + (ln >> 4) * 16;
            f32x4 a0 = {0.f, 0.f, 0.f, 0.f}, a1 = a0, a2 = a0, a3 = a0;
#pragma unroll
            for (int s = 0; s < 32; s += 4) {
                a0 = __builtin_amdgcn_mfma_f32_16x16x32_bf16(*(const LAS bf16x8*)(xa + s * 64), *(const LAS bf16x8*)(wb + s * 64), a0, 0, 0, 0);
                a1 = __builtin_amdgcn_mfma_f32_16x16x32_bf16(*(const LAS bf16x8*)(xa + s * 64 + 64), *(const LAS bf16x8*)(wb + s * 64 + 64), a1, 0, 0, 0);
                a2 = __builtin_amdgcn_mfma_f32_16x16x32_bf16(*(const LAS bf16x8*)(xa + s * 64 + 128), *(const LAS bf16x8*)(wb + s * 64 + 128), a2, 0, 0, 0);
                a3 = __builtin_amdgcn_mfma_f32_16x16x32_bf16(*(const LAS bf16x8*)(xa + s * 64 + 192), *(const LAS bf16x8*)(wb + s * 64 + 192), a3, 0, 0, 0); }
            const f32x4 lg = (a0 + a1) + (a2 + a3);
#pragma unroll
            for (int i = 0; i < 4; ++i) { const float mx = row_max16(lg[i]), ex = __expf(lg[i] - mx), sm = row_sum16(ex); const int rr = r0 + (k - 3 + i) * rs;
                if (ln < 16) aff[((size_t)(rr >> 11) * NEXP + ln) * SEQ + (rr & 2047)] = ex * __builtin_amdgcn_rcpf(sm); }
        }
    }
    __syncthreads();
}

__device__ __forceinline__ void topk_select(Ctx& C) {
    const float* aff = (const float*)(C.ws + WS_SMALL + SM_AFF);
    int* rowtok = (int*)(C.ws + WS_SMALL + SM_IDX); short* inv = (short*)(C.ws + WS_SMALL + SM_INV);
    const int tid = C.tid, lane = C.lane, half = tid >> 8, ht = tid & 255, hw = (tid >> 6) & 3;
    LAS int* hist = (LAS int*)C.lds + half * 256; LAS unsigned* ctl = (LAS unsigned*)(C.lds + 2048) + half * 2; LAS unsigned* wtot = (LAS unsigned*)(C.lds + 2112) + half * 4;
    for (int u0 = 2 * blockIdx.x; u0 < NB * NEXP; u0 += 2 * C.G) {
        const int unit = u0 + half, b = unit >> 4, e = unit & 15;
        const u32x4 k0 = *(const u32x4*)(aff + (size_t)unit * SEQ + 8 * ht), k1 = *(const u32x4*)(aff + (size_t)unit * SEQ + 8 * ht + 4);
        const unsigned key[8] = {k0.x, k0.y, k0.z, k0.w, k1.x, k1.y, k1.z, k1.w};
        unsigned prefix = 0u, mask = 0u; int kneed = CAP;
#pragma unroll 1
        for (int pass = 0; pass < 4; ++pass) {
            const int shift = 24 - 8 * pass;
            hist[ht] = 0;
            __syncthreads();
#pragma unroll
            for (int k = 0; k < 8; ++k) if ((key[k] & mask) == prefix) __hip_atomic_fetch_add(&hist[(key[k] >> shift) & 255u], 1, __ATOMIC_RELAXED, __HIP_MEMORY_SCOPE_WORKGROUP);
            __syncthreads();
            if (hw == 0) {
                const int b0 = hist[255 - 4 * lane], b1 = hist[254 - 4 * lane], b2 = hist[253 - 4 * lane], b3 = hist[252 - 4 * lane];
                const int c4 = b0 + b1 + b2 + b3; int inc = c4;
#pragma unroll
                for (int o = 1; o < 64; o <<= 1) { const int t = __shfl_up(inc, o); if (lane >= o) inc += t; }
                const int before = inc - c4;
                if (before < kneed && kneed <= inc) {
                    int bin, above;
                    if (kneed <= before + b0) { bin = 255 - 4 * lane; above = before; }
                    else if (kneed <= before + b0 + b1) { bin = 254 - 4 * lane; above = before + b0; }
                    else if (kneed <= before + b0 + b1 + b2) { bin = 253 - 4 * lane; above = before + b0 + b1; }
                    else { bin = 252 - 4 * lane; above = before + b0 + b1 + b2; }
                    ctl[0] = prefix | ((unsigned)bin << shift); ctl[1] = (unsigned)(kneed - above);
                }
            }
            __syncthreads();
            prefix = ctl[0]; kneed = (int)ctl[1]; mask |= 255u << shift;
        }
        unsigned cnt = 0u;
#pragma unroll
        for (int k = 0; k < 8; ++k) cnt += (key[k] > prefix ? 1u : 0u) + (key[k] == prefix ? 0x10000u : 0u);
        unsigned inc = cnt;
#pragma unroll
        for (int o = 1; o < 64; o <<= 1) { const unsigned t = __shfl_up(inc, o); if (lane >= o) inc += t; }
        if (lane == 63) wtot[hw] = inc;
        __syncthreads();
        unsigned base = inc - cnt;
#pragma unroll
        for (int q = 0; q < 4; ++q) base += (q < hw) ? wtot[q] : 0u;
        int gtp = (int)(base & 0xffffu), eqp = (int)(base >> 16); unsigned short iv[8];
#pragma unroll
        for (int k = 0; k < 8; ++k) { const bool gt = key[k] > prefix, eq = key[k] == prefix; const bool sel = gt || (eq && eqp < kneed);
            const int slot = gtp + (eqp < kneed ? eqp : kneed);
            if (sel) rowtok[(e * NB + b) * CAP + slot] = b * SEQ + 8 * ht + k;
            iv[k] = sel ? (unsigned short)slot : (unsigned short)0xffffu; gtp += gt ? 1 : 0; eqp += eq ? 1 : 0; }
        u32x4 o; o.x = (unsigned)iv[0] | ((unsigned)iv[1] << 16); o.y = (unsigned)iv[2] | ((unsigned)iv[3] << 16); o.z = (unsigned)iv[4] | ((unsigned)iv[5] << 16); o.w = (unsigned)iv[6] | ((unsigned)iv[7] << 16);
        *(u32x4*)(inv + (size_t)unit * SEQ + 8 * ht) = o;
        __syncthreads();
    }
}

template <bool LAST>
__device__ __forceinline__ void moe_combine_ln2(Ctx& C, int layer) {
    const float* g = IN_F(I_LN_G) + (size_t)(layer * 2 + 1) * DM; const float* bb = IN_F(I_LN_B) + (size_t)(layer * 2 + 1) * DM;
    const float* aff = (const float*)(C.ws + WS_SMALL + SM_AFF); const short* inv = (const short*)(C.ws + WS_SMALL + SM_INV);
    const bf16_t* OUTB = (const bf16_t*)(C.ws + WS_Z);
    f32x4 gv[4], bv[4];
#pragma unroll
    for (int j = 0; j < 4; ++j) { gv[j] = *(const f32x4*)(g + 4 * C.lane + 256 * j); bv[j] = *(const f32x4*)(bb + 4 * C.lane + 256 * j); }
    u32x2 n1[4], n2[4]; int inv1 = -1, inv2 = -1; float aff1 = 0.f, aff2 = 0.f;
    { const int row = C.gw, r2 = C.gw + C.NGW; const u32x2* xr = (const u32x2*)(C.ws + WS_XB + (size_t)row * DM * 2); const u32x2* xr2 = (const u32x2*)(C.ws + WS_XB + (size_t)r2 * DM * 2);
#pragma unroll
      for (int j = 0; j < 4; ++j) { n1[j] = xr[C.lane + 64 * j]; n2[j] = xr2[C.lane + 64 * j]; }
      if (C.lane < 16) { const size_t ia = ((size_t)(row >> 11) * NEXP + C.lane) * SEQ + (row & 2047); inv1 = (int)inv[ia]; aff1 = aff[ia];
                         const size_t ib = ((size_t)(r2 >> 11) * NEXP + C.lane) * SEQ + (r2 & 2047); inv2 = (int)inv[ib]; aff2 = aff[ib]; } }
    for (int row = C.gw; row < NT; row += C.NGW) {
        u32x2* xb = (u32x2*)(C.ws + WS_XB + (size_t)row * DM * 2); const int b = row >> 11;
        f32x4 v[4];
#pragma unroll
        for (int j = 0; j < 4; ++j) { const u32x2 w = n1[j]; v[j] = (f32x4){bf_lo(w.x), bf_hi(w.x), bf_lo(w.y), bf_hi(w.y)} * ALPHA; n1[j] = n2[j]; }
        const int myinv = inv1; const float myaff = aff1; inv1 = inv2; aff1 = aff2;
        if (row + 2 * C.NGW < NT) { const int r2 = row + 2 * C.NGW; const u32x2* xr = (const u32x2*)(C.ws + WS_XB + (size_t)r2 * DM * 2);
#pragma unroll
            for (int j = 0; j < 4; ++j) n2[j] = xr[C.lane + 64 * j];
            if (C.lane < 16) { const size_t ia = ((size_t)(r2 >> 11) * NEXP + C.lane) * SEQ + (r2 & 2047); inv2 = (int)inv[ia]; aff2 = aff[ia]; } }
        unsigned long long m = __ballot(myinv >= 0);
        while (m) {
            const int e1 = __builtin_ctzll(m); m &= m - 1; const bool two = (m != 0ull); const int e2 = two ? __builtin_ctzll(m) : e1; if (two) m &= m - 1;
            const int c1 = __builtin_amdgcn_readlane(myinv, e1), c2 = __builtin_amdgcn_readlane(myinv, e2);
            const float g1 = __uint_as_float((unsigned)__builtin_amdgcn_readlane((int)__float_as_uint(myaff), e1));
            const float g2 = two ? __uint_as_float((unsigned)__builtin_amdgcn_readlane((int)__float_as_uint(myaff), e2)) : 0.f;
#if MOE_FP8
            const unsigned* o1 = (const unsigned*)((const unsigned char*)OUTB + ((size_t)(e1 * NB + b) * CAP + c1) * DM); const unsigned* o2 = (const unsigned*)((const unsigned char*)OUTB + ((size_t)(e2 * NB + b) * CAP + c2) * DM);
            unsigned w1[4], w2[4]; const float s1 = g1 * (1.0f / F8_SO), s2 = g2 * (1.0f / F8_SO);
#pragma unroll
            for (int j = 0; j < 4; ++j) { w1[j] = o1[C.lane + 64 * j]; w2[j] = o2[C.lane + 64 * j]; }
#pragma unroll
            for (int j = 0; j < 4; ++j) v[j] += unpk4_fp8(w1[j]) * s1 + unpk4_fp8(w2[j]) * s2;
#else
            const u32x2* o1 = (const u32x2*)(OUTB + ((size_t)(e1 * NB + b) * CAP + c1) * DM); const u32x2* o2 = (const u32x2*)(OUTB + ((size_t)(e2 * NB + b) * CAP + c2) * DM);
            u32x2 w1[4], w2[4];
#pragma unroll
            for (int j = 0; j < 4; ++j) { w1[j] = o1[C.lane + 64 * j]; w2[j] = o2[C.lane + 64 * j]; }
#pragma unroll
            for (int j = 0; j < 4; ++j) { v[j][0] += g1 * bf_lo(w1[j].x) + g2 * bf_lo(w2[j].x); v[j][1] += g1 * bf_hi(w1[j].x) + g2 * bf_hi(w2[j].x);
                v[j][2] += g1 * bf_lo(w1[j].y) + g2 * bf_lo(w2[j].y); v[j][3] += g1 * bf_hi(w1[j].y) + g2 * bf_hi(w2[j].y); }
#endif
        }
        float s = 0.f;
#pragma unroll
        for (int j = 0; j < 4; ++j) s += (v[j][0] + v[j][1]) + (v[j][2] + v[j][3]);
        const float mean = wave_sum(s) * (1.f / DM); float s2 = 0.f;
#pragma unroll
        for (int j = 0; j < 4; ++j) { v[j] = v[j] - mean; s2 += (v[j][0] * v[j][0] + v[j][1] * v[j][1]) + (v[j][2] * v[j][2] + v[j][3] * v[j][3]); }
        const float rstd = 1.f / sqrtf(wave_sum(s2) * (1.f / DM) + LN_EPS);
#pragma unroll
        for (int j = 0; j < 4; ++j) { v[j] = v[j] * rstd * gv[j] + bv[j];
            if (LAST) *(f32x4*)(C.out + (size_t)row * DM + 4 * C.lane + 256 * j) = v[j];
            else { u32x2 o; o.x = cvt_pk_bf16(v[j][0], v[j][1]); o.y = cvt_pk_bf16(v[j][2], v[j][3]); xb[C.lane + 64 * j] = o;
                if (INP_FP8 && layer == 0) ((unsigned*)(C.ws + WS_XB8 + (size_t)row * DM))[C.lane + 64 * j] = pk4_fp8(v[j][0], v[j][1], v[j][2], v[j][3]); } }
    }
}

template <int ACT>
__device__ __forceinline__ void headnorm_gate(Ctx& C, const bf16_t* Zo, int ldz, const bf16_t* H1, const bf16_t* H2, const float* ng, bf16_t* U, int r0, int rs, int nr) {
    static_assert(!OUT_FP8, "bf16 U only");
    const int lane = C.lane; const bool up = lane >= 32;
    f32x4 gv[2][2];
#pragma unroll
    for (int jj = 0; jj < 2; ++jj) { gv[jj][0] = *(const f32x4*)(ng + 512 * jj + 8 * lane); gv[jj][1] = *(const f32x4*)(ng + 512 * jj + 8 * lane + 4); }
    auto half_sum = [&](float v) { v += dpp_f<0xB1>(v); v += dpp_f<0x4E>(v); v += dpp_f<0x141>(v); v += dpp_f<0x140>(v);
        const float lo = rdlane_f(v, 0) + rdlane_f(v, 16), hi = rdlane_f(v, 32) + rdlane_f(v, 48); return up ? hi : lo; };
    u32x4 na[2], nb[2], no[2], ma[2], mb[2], mo[2];
    { const int row = r0, r2 = r0 + rs;
#pragma unroll
      for (int jj = 0; jj < 2; ++jj) { na[jj] = ((const u32x4*)(H1 + (size_t)row * DM))[lane + 64 * jj]; nb[jj] = ((const u32x4*)(H2 + (size_t)row * DM))[lane + 64 * jj]; no[jj] = ((const u32x4*)(Zo + (size_t)row * ldz))[lane + 64 * jj];
          ma[jj] = ((const u32x4*)(H1 + (size_t)r2 * DM))[lane + 64 * jj]; mb[jj] = ((const u32x4*)(H2 + (size_t)r2 * DM))[lane + 64 * jj]; mo[jj] = ((const u32x4*)(Zo + (size_t)r2 * ldz))[lane + 64 * jj]; } }
    for (int k = 0; k < nr; ++k) { const int row = r0 + k * rs;
        u32x4 a4[2], b4[2], o4[2];
#pragma unroll
        for (int jj = 0; jj < 2; ++jj) { a4[jj] = na[jj]; b4[jj] = nb[jj]; o4[jj] = no[jj]; na[jj] = ma[jj]; nb[jj] = mb[jj]; no[jj] = mo[jj]; }
        { const int r2 = r0 + (k + 2 < nr ? k + 2 : nr - 1) * rs;
#pragma unroll
            for (int jj = 0; jj < 2; ++jj) { ma[jj] = ((const u32x4*)(H1 + (size_t)r2 * DM))[lane + 64 * jj]; mb[jj] = ((const u32x4*)(H2 + (size_t)r2 * DM))[lane + 64 * jj]; mo[jj] = ((const u32x4*)(Zo + (size_t)r2 * ldz))[lane + 64 * jj]; } }
        u32x4* upp = (u32x4*)(U + (size_t)row * DM);
#pragma unroll
        for (int jj = 0; jj < 2; ++jj) {
            const u32x4 a = a4[jj], b = b4[jj], o = o4[jj];
            float v[8], ov[8];
#pragma unroll
            for (int q = 0; q < 4; ++q) { v[2 * q] = bf_lo(a[q]) + bf_lo(b[q]); v[2 * q + 1] = bf_hi(a[q]) + bf_hi(b[q]); ov[2 * q] = bf_lo(o[q]); ov[2 * q + 1] = bf_hi(o[q]); }
            const float mean = half_sum(((v[0] + v[1]) + (v[2] + v[3])) + ((v[4] + v[5]) + (v[6] + v[7]))) * (1.f / 256.f);
            float s2 = 0.f;
#pragma unroll
            for (int q = 0; q < 8; ++q) { v[q] -= mean; s2 += v[q] * v[q]; }
            const float rstd = 1.f / sqrtf(half_sum(s2) * (1.f / 256.f) + LN_EPS);
            float r[8];
#pragma unroll
            for (int q = 0; q < 8; ++q) { const float hn = v[q] * rstd * gv[jj][q >> 2][q & 3]; r[q] = (ACT == 0 ? sigmoidf_(ov[q]) : siluf_(ov[q])) * hn; }
            u32x4 w; w.x = cvt_pk_bf16(r[0], r[1]); w.y = cvt_pk_bf16(r[2], r[3]); w.z = cvt_pk_bf16(r[4], r[5]); w.w = cvt_pk_bf16(r[6], r[7]);
            upp[lane + 64 * jj] = w;
        }
    }
}
#define KSWZ(row, colB) ((row) * 256 + ((colB) ^ (((row) & 7) << 4)))
#define SSWZ(row, colB) ((row) * 128 + ((colB) ^ ((((row) >> 1) & 7) << 4)))
__device__ __forceinline__ int crow(int r, int hi) { return (r & 3) + 8 * (r >> 2) + 4 * hi; }
__device__ __forceinline__ int v_st(int k, int c) { const int kk = (k & ~0xC) | ((k & 4) << 1) | ((k & 8) >> 1); return ((kk >> 3) * 4 + (c >> 5)) * 512 + ((kk & 7) * 32 + (c & 31)) * 2; }
__device__ __forceinline__ int v_rd_base(int lane) { return ((lane & 3) << 3) | (((lane >> 2) & 3) << 6) | (((lane >> 4) & 1) << 5) | (((lane >> 5) & 1) << 8); }
constexpr int v_rd_off(int d0, int ks, int half) { return d0 * 512 + ks * 4096 + half * 2048; }
template <int OFF> __device__ __forceinline__ s16x4 tr_read(int vb) {
    s16x4 r; asm volatile("ds_read_b64_tr_b16 %0, %1 offset:%2" : "=&v"(r) : "v"(vb), "i"(OFF) : "memory"); return r;
}
#define PKLH(L, H) (bf16x8){L[0], L[1], L[2], L[3], H[0], H[1], H[2], H[3]}
template <int D0, int KS> __device__ __forceinline__ bf16x8 tr_frag(int vb) {
    const s16x4 l = tr_read<v_rd_off(D0, KS, 0)>(vb), h = tr_read<v_rd_off(D0, KS, 1)>(vb); LDS_WAIT(); __builtin_amdgcn_sched_barrier(0); return PKLH(l, h);
}
template <int D0> __device__ __forceinline__ void tr_frag4(int vb, bf16x8& f0, bf16x8& f1, bf16x8& f2, bf16x8& f3) {
    const s16x4 l0 = tr_read<v_rd_off(D0, 0, 0)>(vb), h0 = tr_read<v_rd_off(D0, 0, 1)>(vb), l1 = tr_read<v_rd_off(D0, 1, 0)>(vb), h1 = tr_read<v_rd_off(D0, 1, 1)>(vb);
    const s16x4 l2 = tr_read<v_rd_off(D0, 2, 0)>(vb), h2 = tr_read<v_rd_off(D0, 2, 1)>(vb), l3 = tr_read<v_rd_off(D0, 3, 0)>(vb), h3 = tr_read<v_rd_off(D0, 3, 1)>(vb);
    LDS_WAIT(); __builtin_amdgcn_sched_barrier(0); f0 = PKLH(l0, h0); f1 = PKLH(l1, h1); f2 = PKLH(l2, h2); f3 = PKLH(l3, h3);
}
template <int D0> __device__ __forceinline__ void tr_frag2(int vb, bf16x8& f0, bf16x8& f1) {
    const s16x4 l0 = tr_read<v_rd_off(D0, 0, 0)>(vb), h0 = tr_read<v_rd_off(D0, 0, 1)>(vb), l1 = tr_read<v_rd_off(D0, 1, 0)>(vb), h1 = tr_read<v_rd_off(D0, 1, 1)>(vb);
    LDS_WAIT(); __builtin_amdgcn_sched_barrier(0); f0 = PKLH(l0, h0); f1 = PKLH(l1, h1);
}
__device__ __forceinline__ bf16x8 as_bf16x8(u32x4 w) { return __builtin_bit_cast(bf16x8, w); }
__device__ __forceinline__ int lds_addr(LAS unsigned char* p) { return (int)(uintptr_t)p; }

__device__ __forceinline__ void mlstm_chain(Ctx& C) {
    const bf16_t* Z = (const bf16_t*)(C.ws + WS_Z); const float* gates = (const float*)(C.ws + WS_SMALL + SM_GATES);
    LAS unsigned char* L = C.lds;
    constexpr int QS = 0, KS_ = 16384, KT = 32768, VT = 49152, SS = 81920, FA = 90112, GA = 98304;
    LAS float* RD = (LAS float*)(L + FA); LAS float* QN = RD + 64; LAS float* NV = RD + 128; LAS float* NP = RD + 256;
    LAS float* BC = (LAS float*)(L + GA); LAS float* AV = BC + 2048; LAS float* CM = BC + 4096;
    const int tid0 = C.tid, w = C.wave;
    for (int chain = blockIdx.x; chain < 256; chain += C.G) {
        const int dir = chain >> 7, b = (chain >> 2) & 31, h = chain & 3;
        bf16_t* Hout = (bf16_t*)(C.ws + WS_H) + (size_t)dir * NT * DM;
        int tid = tid0, lane = tid & 63, r32 = lane & 31, hi = lane >> 5;
#define REOPAQUE() do { tid = opaque(tid0); lane = tid & 63; r32 = lane & 31; hi = lane >> 5; } while (0)
        f32x16 Cst[4];
#pragma unroll
        for (int j = 0; j < 4; ++j) Cst[j] = (f32x16){};
        if (tid < 128) NV[tid] = 0.f;
        auto tok_of = [&](int c, int j) { const int cidx = dir ? 31 - c : c; return b * SEQ + cidx * 64 + (dir ? 63 - j : j); };
#pragma unroll 1
        for (int cc = w; cc < 32; cc += 8) {
            const size_t t = (size_t)tok_of(cc, lane) * 16; const float ig = gates[t + dir * 8 + h], fg = gates[t + dir * 8 + 4 + h];
            float bc = logsigmoidf_(fg);
#pragma unroll
            for (int o = 1; o < 64; o <<= 1) { const float x = __shfl_up(bc, o); if (lane >= o) bc += x; }
            const float a = ig - bc; float cm = a;
#pragma unroll
            for (int o = 1; o < 64; o <<= 1) { const float x = __shfl_up(cm, o); if (lane >= o) cm = fmaxf(cm, x); }
            BC[cc * 64 + lane] = bc; AV[cc * 64 + lane] = a; CM[cc * 64 + lane] = cm;
        }
        float mcar = 0.f;
        u32x4 pq[2], pk[2], pv[4];
        auto prefetch = [&](int c) {
#pragma unroll
            for (int i = 0; i < 2; ++i) { const int cid = tid + 512 * i, row = cid >> 4, cc = cid & 15; const size_t t = (size_t)tok_of(c, row) * 3072;
                pq[i] = *(const u32x4*)(Z + t + h * 128 + cc * 8); pk[i] = *(const u32x4*)(Z + t + 512 + h * 128 + cc * 8); }
#pragma unroll
            for (int i = 0; i < 4; ++i) { const int cid = tid + 512 * i, row = cid >> 5, cc = cid & 31; pv[i] = *(const u32x4*)(Z + (size_t)tok_of(c, row) * 3072 + 1024 + h * 256 + cc * 8); }
        };
        prefetch(0);
        __syncthreads();
        for (int c = 0; c < 32; ++c) {
            REOPAQUE();
            const float M63 = fmaxf(mcar, CM[c * 64 + 63]), wc = __expf(mcar - M63);
#pragma unroll
            for (int i = 0; i < 2; ++i) { const int cid = tid + 512 * i, row = cid >> 4, cc = cid & 15;
                *(LAS u32x4*)(L + QS + KSWZ(row, cc * 16)) = pq[i]; *(LAS u32x4*)(L + KS_ + KSWZ(row, cc * 16)) = pk[i];
                const float ws = __expf(AV[c * 64 + row] - M63); u32x4 kw;
                kw.x = cvt_pk_bf16(bf_lo(pk[i].x) * ws, bf_hi(pk[i].x) * ws); kw.y = cvt_pk_bf16(bf_lo(pk[i].y) * ws, bf_hi(pk[i].y) * ws);
                kw.z = cvt_pk_bf16(bf_lo(pk[i].z) * ws, bf_hi(pk[i].z) * ws); kw.w = cvt_pk_bf16(bf_lo(pk[i].w) * ws, bf_hi(pk[i].w) * ws);
                *(LAS u32x4*)(L + KT + v_st(row, cc * 8)) = kw; }
#pragma unroll
            for (int i = 0; i < 4; ++i) { const int cid = tid + 512 * i, row = cid >> 5, cc = cid & 31; *(LAS u32x4*)(L + VT + (cc >> 4) * 16384 + v_st(row, (cc & 15) * 8)) = pv[i]; }
            if (c + 1 < 32) prefetch(c + 1);
            __syncthreads();
            REOPAQUE();
            if (w < 4) {
                const int ti = w >> 1, si = w & 1;
                if (si > ti) {
#pragma unroll
                    for (int i = 0; i < 4; ++i) *(LAS u32x2*)(L + SS + SSWZ(32 * ti + r32, (32 * si + 8 * i + 4 * hi) * 2)) = (u32x2){0u, 0u};
                } else {
                    f32x16 acc = (f32x16){};
#pragma unroll
                    for (int kk = 0; kk < 8; ++kk) { const int cb = (16 * kk + 8 * hi) * 2;
                        const bf16x8 kf = *(const LAS bf16x8*)(L + KS_ + KSWZ(32 * si + r32, cb)); const bf16x8 qf = *(const LAS bf16x8*)(L + QS + KSWZ(32 * ti + r32, cb));
                        acc = __builtin_amdgcn_mfma_f32_32x32x16_bf16(kf, qf, acc, 0, 0, 0); }
                    const int t = 32 * ti + r32; const float Mt = fmaxf(mcar, CM[c * 64 + t]);
#pragma unroll
                    for (int i = 0; i < 4; ++i) { const int s0 = 32 * si + 8 * i + 4 * hi; const f32x4 a4 = *(const LAS f32x4*)(AV + c * 64 + s0);
                        float v[4];
#pragma unroll
                        for (int q = 0; q < 4; ++q) v[q] = (s0 + q <= t) ? acc[4 * i + q] * __expf(a4[q] - Mt) : 0.f;
                        u32x2 o; o.x = cvt_pk_bf16(v[0], v[1]); o.y = cvt_pk_bf16(v[2], v[3]);
                        *(LAS u32x2*)(L + SS + SSWZ(t, s0 * 2)) = o; }
                }
            } else {
                const int t = (tid - 256) >> 2, seg = tid & 3; float a = 0.f;
#pragma unroll
                for (int i = 0; i < 4; ++i) { const u32x4 qv = *(const LAS u32x4*)(L + QS + KSWZ(t, (seg * 32 + i * 8) * 2)); const LAS float* nv = NV + seg * 32 + i * 8;
                    a += bf_lo(qv.x) * nv[0] + bf_hi(qv.x) * nv[1] + bf_lo(qv.y) * nv[2] + bf_hi(qv.y) * nv[3] + bf_lo(qv.z) * nv[4] + bf_hi(qv.z) * nv[5] + bf_lo(qv.w) * nv[6] + bf_hi(qv.w) * nv[7]; }
                a += __shfl_xor(a, 1); a += __shfl_xor(a, 2);
                if (seg == 0) QN[t] = a;
            }
            __syncthreads();
            REOPAQUE();
            { const int t = tid >> 3, seg = tid & 7; const u32x4 sv = *(const LAS u32x4*)(L + SS + SSWZ(t, seg * 16));
              float rs = (bf_lo(sv.x) + bf_hi(sv.x)) + (bf_lo(sv.y) + bf_hi(sv.y)) + (bf_lo(sv.z) + bf_hi(sv.z)) + (bf_lo(sv.w) + bf_hi(sv.w));
              rs += __shfl_xor(rs, 1); rs += __shfl_xor(rs, 2); rs += __shfl_xor(rs, 4);
              if (seg == 0) { const float Mt = fmaxf(mcar, CM[c * 64 + t]); const float den = rs + __expf(mcar - Mt) * QN[t]; RD[t] = 1.0f / fmaxf(fabsf(den), __expf(-(BC[c * 64 + t] + Mt))); } }
            { const int dk = tid & 127, part = tid >> 7; float a = 0.f;
              const LAS unsigned char* kp = L + KT + part * 4096 + (dk >> 5) * 512 + (dk & 31) * 2;
#pragma unroll
              for (int i = 0; i < 16; ++i) a += bf2f(*(const LAS bf16_t*)(kp + (i >> 3) * 2048 + (i & 7) * 64));
              NP[part * 128 + dk] = a; }
            __builtin_amdgcn_sched_barrier(0);
            const int vbV = lds_addr(L + VT) + v_rd_base(lane) + (w & 3) * 512 + (w >> 2) * 16384;
            const int vbK = lds_addr(L + KT) + v_rd_base(lane);
            f32x16 Y[2] = {(f32x16){}, (f32x16){}};
#pragma unroll
            for (int jd = 0; jd < 4; ++jd)
#pragma unroll
                for (int s = 0; s < 2; ++s) {
                    u32x4 cw; cw.x = cvt_pk_bf16(Cst[jd][8 * s + 0], Cst[jd][8 * s + 1]); cw.y = cvt_pk_bf16(Cst[jd][8 * s + 2], Cst[jd][8 * s + 3]);
                    cw.z = cvt_pk_bf16(Cst[jd][8 * s + 4], Cst[jd][8 * s + 5]); cw.w = cvt_pk_bf16(Cst[jd][8 * s + 6], Cst[jd][8 * s + 7]);
                    const bf16x8 bfr = as_bf16x8(cw); const int cb = (32 * jd + 16 * s + 4 * hi) * 2;
#pragma unroll
                    for (int ti = 0; ti < 2; ++ti) { const u32x2 lo = *(const LAS u32x2*)(L + QS + KSWZ(32 * ti + r32, cb)), hi2 = *(const LAS u32x2*)(L + QS + KSWZ(32 * ti + r32, cb + 16));
                        const bf16x8 afr = as_bf16x8((u32x4){lo.x, lo.y, hi2.x, hi2.y});
                        Y[ti] = __builtin_amdgcn_mfma_f32_32x32x16_bf16(afr, bfr, Y[ti], 0, 0, 0); }
                    __builtin_amdgcn_sched_barrier(0);
                }
#pragma unroll
            for (int ti = 0; ti < 2; ++ti)
#pragma unroll
                for (int i = 0; i < 4; ++i) { const f32x4 c4 = *(const LAS f32x4*)(CM + c * 64 + 32 * ti + 8 * i + 4 * hi);
#pragma unroll
                    for (int q = 0; q < 4; ++q) Y[ti][4 * i + q] *= __expf(mcar - fmaxf(mcar, c4[q])); }
            __builtin_amdgcn_sched_barrier(0);
            bf16x8 vf0, vf1, vf2, vf3; tr_frag4<0>(vbV, vf0, vf1, vf2, vf3);
#pragma unroll
            for (int ti = 0; ti < 2; ++ti) {
                const bf16x8 a0 = *(const LAS bf16x8*)(L + SS + SSWZ(32 * ti + r32, (0 + 8 * hi) * 2)), a1 = *(const LAS bf16x8*)(L + SS + SSWZ(32 * ti + r32, (16 + 8 * hi) * 2));
                Y[ti] = __builtin_amdgcn_mfma_f32_32x32x16_bf16(a0, vf0, Y[ti], 0, 0, 0); Y[ti] = __builtin_amdgcn_mfma_f32_32x32x16_bf16(a1, vf1, Y[ti], 0, 0, 0);
                if (ti == 1) { const bf16x8 a2 = *(const LAS bf16x8*)(L + SS + SSWZ(32 + r32, (32 + 8 * hi) * 2)), a3 = *(const LAS bf16x8*)(L + SS + SSWZ(32 + r32, (48 + 8 * hi) * 2));
                    Y[1] = __builtin_amdgcn_mfma_f32_32x32x16_bf16(a2, vf2, Y[1], 0, 0, 0); Y[1] = __builtin_amdgcn_mfma_f32_32x32x16_bf16(a3, vf3, Y[1], 0, 0, 0); }
            }
            __builtin_amdgcn_sched_barrier(0);
#define ML_UPD(JD) { Cst[JD] = Cst[JD] * wc; bf16x8 k0_, k1_, k2_, k3_; tr_frag4<JD>(vbK, k0_, k1_, k2_, k3_); \
                Cst[JD] = __builtin_amdgcn_mfma_f32_32x32x16_bf16(k0_, vf0, Cst[JD], 0, 0, 0); Cst[JD] = __builtin_amdgcn_mfma_f32_32x32x16_bf16(k1_, vf1, Cst[JD], 0, 0, 0); \
                Cst[JD] = __builtin_amdgcn_mfma_f32_32x32x16_bf16(k2_, vf2, Cst[JD], 0, 0, 0); Cst[JD] = __builtin_amdgcn_mfma_f32_32x32x16_bf16(k3_, vf3, Cst[JD], 0, 0, 0); }
            ML_UPD(0) __builtin_amdgcn_sched_barrier(0); ML_UPD(1) __builtin_amdgcn_sched_barrier(0); ML_UPD(2) __builtin_amdgcn_sched_barrier(0); ML_UPD(3)
#undef ML_UPD
            __syncthreads();
            REOPAQUE();
            if (tid < 128) NV[tid] = wc * NV[tid] + (NP[tid] + NP[128 + tid]) + (NP[256 + tid] + NP[384 + tid]);
#pragma unroll
            for (int ti = 0; ti < 2; ++ti)
#pragma unroll
                for (int i = 0; i < 4; ++i) { const f32x4 r4 = *(const LAS f32x4*)(RD + 32 * ti + 8 * i + 4 * hi);
#pragma unroll
                    for (int q = 0; q < 4; ++q) { const int t = 32 * ti + 8 * i + 4 * hi + q;
                        Hout[(size_t)tok_of(c, t) * DM + h * 256 + 32 * w + r32] = f2bf(Y[ti][4 * i + q] * r4[q]); } }
            mcar = BC[c * 64 + 63] + M63;
        }
#undef REOPAQUE
        __syncthreads();
    }
}

__device__ __forceinline__ void gla_chain(Ctx& C) {
    const bf16_t* Z = (const bf16_t*)(C.ws + WS_Z); const float* glr = (const float*)(C.ws + WS_SMALL + SM_GATES);
    LAS unsigned char* L = C.lds;
    constexpr int QE = 0, KE = 8192, KG = 16384, VT = 32768, BL = 65536, FA = 81920;
    LAS float* BLf = (LAS float*)(L + BL);
    LAS float* GT = (LAS float*)(L + FA); LAS float* EG = GT + 128;
    const int tid0 = C.tid, w = C.wave;
    for (int chain = blockIdx.x; chain < 256; chain += C.G) {
        const int dir = chain >> 7, b = (chain >> 2) & 31, h = chain & 3;
        bf16_t* Hout = (bf16_t*)(C.ws + WS_H) + (size_t)dir * NT * DM;
        int tid = tid0, lane = tid & 63, r32 = lane & 31, hi = lane >> 5;
#define REOPAQUE() do { tid = opaque(tid0); lane = tid & 63; r32 = lane & 31; hi = lane >> 5; } while (0)
        bf16x8 gwf; float gbias;
        { const int dkc = h * 128 + (w & 3) * 32 + r32; const float* gwp = IN_F(I_GL_GW) + (size_t)dir * 16 * 512 + dkc; float g8[8];
#pragma unroll
          for (int j = 0; j < 8; ++j) g8[j] = gwp[(size_t)(8 * hi + j) * 512];
          u32x4 gp; gp.x = cvt_pk_bf16(g8[0], g8[1]); gp.y = cvt_pk_bf16(g8[2], g8[3]); gp.z = cvt_pk_bf16(g8[4], g8[5]); gp.w = cvt_pk_bf16(g8[6], g8[7]); gwf = as_bf16x8(gp);
          gbias = IN_F(I_GL_GB)[dir * 512 + dkc]; }
        f32x16 St[4];
#pragma unroll
        for (int j = 0; j < 4; ++j) St[j] = (f32x16){};
        struct PF { u32x4 pq, pk, pv0, pv1; f32x4 pg0, pg1; };
        PF S0, S1; S0.pg0 = S0.pg1 = S1.pg0 = S1.pg1 = (f32x4){0.f, 0.f, 0.f, 0.f};
        auto tok_of = [&](int c, int j) { const int cidx = dir ? 63 - c : c; return b * SEQ + cidx * 32 + (dir ? 31 - j : j); };
        auto prefetch = [&](int c, PF& P) {
            { const int row = tid >> 4, cc = tid & 15; const size_t t = (size_t)tok_of(c, row) * 3072; P.pq = *(const u32x4*)(Z + t + h * 128 + cc * 8); P.pk = *(const u32x4*)(Z + t + 512 + h * 128 + cc * 8); }
            { const int row = tid >> 5, cc = tid & 31; P.pv0 = *(const u32x4*)(Z + (size_t)tok_of(c, row) * 3072 + 1024 + h * 256 + cc * 8); P.pv1 = *(const u32x4*)(Z + (size_t)tok_of(c, 16 + row) * 3072 + 1024 + h * 256 + cc * 8); }
            if (w < 4) { const float* gp = glr + (size_t)tok_of(c, r32) * 32 + dir * 16 + 8 * hi; P.pg0 = *(const f32x4*)gp; P.pg1 = *(const f32x4*)(gp + 4); }
        };
        prefetch(0, S0); prefetch(1, S1);
        auto chunk = [&](const int c, PF& P) {
            REOPAQUE();
            if (w < 4) {
                u32x4 ap; ap.x = cvt_pk_bf16(P.pg0[0], P.pg0[1]); ap.y = cvt_pk_bf16(P.pg0[2], P.pg0[3]); ap.z = cvt_pk_bf16(P.pg1[0], P.pg1[1]); ap.w = cvt_pk_bf16(P.pg1[2], P.pg1[3]);
                f32x16 lg = __builtin_amdgcn_mfma_f32_32x32x16_bf16(as_bf16x8(ap), gwf, (f32x16){}, 0, 0, 0);
                float T[4];
#pragma unroll
                for (int i = 0; i < 4; ++i) { float run = 0.f;
#pragma unroll
                    for (int q = 0; q < 4; ++q) { run += logsigmoid_fast(lg[4 * i + q] + gbias) * (1.0f / 16.0f); lg[4 * i + q] = run; }
                    T[i] = run; }
                float O[4];
#pragma unroll
                for (int i = 0; i < 4; ++i) { auto rr = __builtin_amdgcn_permlane32_swap(__float_as_uint(T[i]), __float_as_uint(T[i]), false, false); O[i] = __uint_as_float(hi ? rr[0] : rr[1]); }
                float off = hi ? O[0] : 0.f;
#pragma unroll
                for (int i = 0; i < 4; ++i) {
#pragma unroll
                    for (int q = 0; q < 4; ++q) BLf[(8 * i + 4 * hi + q) * 128 + 32 * w + r32] = off + lg[4 * i + q];
                    off += T[i] + (hi ? (i < 3 ? O[i + 1] : 0.f) : O[i]); }
                if (hi == 0) { const float g = (T[0] + T[1]) + (T[2] + T[3]) + (O[0] + O[1]) + (O[2] + O[3]); GT[32 * w + r32] = g; EG[(c & 1) * 128 + 32 * w + r32] = __expf(g); }
            }
            __syncthreads();
            REOPAQUE();
            { const int row = tid >> 5, cc = tid & 31; *(LAS u32x4*)(L + VT + (cc >> 4) * 16384 + v_st(row, (cc & 15) * 8)) = P.pv0; *(LAS u32x4*)(L + VT + (cc >> 4) * 16384 + v_st(16 + row, (cc & 15) * 8)) = P.pv1; }
            { const int row = tid >> 4, cc = tid & 15; const LAS float* br = BLf + row * 128 + cc * 8; const LAS float* gp = GT + cc * 8;
              const f32x4 b0 = *(const LAS f32x4*)br, b1 = *(const LAS f32x4*)(br + 4), g0 = *(const LAS f32x4*)gp, g1 = *(const LAS f32x4*)(gp + 4);
              float bv[8] = {b0[0], b0[1], b0[2], b0[3], b1[0], b1[1], b1[2], b1[3]}, gv[8] = {g0[0], g0[1], g0[2], g0[3], g1[0], g1[1], g1[2], g1[3]};
              const u32x4 pq = P.pq, pk = P.pk;
              float qf[8] = {bf_lo(pq.x), bf_hi(pq.x), bf_lo(pq.y), bf_hi(pq.y), bf_lo(pq.z), bf_hi(pq.z), bf_lo(pq.w), bf_hi(pq.w)};
              float kf[8] = {bf_lo(pk.x), bf_hi(pk.x), bf_lo(pk.y), bf_hi(pk.y), bf_lo(pk.z), bf_hi(pk.z), bf_lo(pk.w), bf_hi(pk.w)};
              float qe[8], ke[8], kg[8];
#pragma unroll
              for (int j = 0; j < 8; ++j) { const float eb = __expf(bv[j]), ib = __builtin_amdgcn_rcpf(eb); qe[j] = qf[j] * eb; ke[j] = kf[j] * ib; kg[j] = ke[j] * __expf(gv[j]); }
              u32x4 o;
              o.x = cvt_pk_bf16(qe[0], qe[1]); o.y = cvt_pk_bf16(qe[2], qe[3]); o.z = cvt_pk_bf16(qe[4], qe[5]); o.w = cvt_pk_bf16(qe[6], qe[7]); *(LAS u32x4*)(L + QE + KSWZ(row, cc * 16)) = o;
              o.x = cvt_pk_bf16(ke[0], ke[1]); o.y = cvt_pk_bf16(ke[2], ke[3]); o.z = cvt_pk_bf16(ke[4], ke[5]); o.w = cvt_pk_bf16(ke[6], ke[7]); *(LAS u32x4*)(L + KE + KSWZ(row, cc * 16)) = o;
              o.x = cvt_pk_bf16(kg[0], kg[1]); o.y = cvt_pk_bf16(kg[2], kg[3]); o.z = cvt_pk_bf16(kg[4], kg[5]); o.w = cvt_pk_bf16(kg[6], kg[7]); *(LAS u32x4*)(L + KG + v_st(row, cc * 8)) = o; }
            if (c + 2 < 64) prefetch(c + 2, P);
            __syncthreads();
            REOPAQUE();
            const int vbV = lds_addr(L + VT) + v_rd_base(lane) + (w & 3) * 512 + (w >> 2) * 16384;
            const int vbK = lds_addr(L + KG) + v_rd_base(lane);
            f32x16 acc = (f32x16){};
#pragma unroll
            for (int kk = 0; kk < 8; ++kk) { const int cb = (16 * kk + 8 * hi) * 2;
                const bf16x8 kf = *(const LAS bf16x8*)(L + KE + KSWZ(r32, cb)); const bf16x8 qf = *(const LAS bf16x8*)(L + QE + KSWZ(r32, cb));
                acc = __builtin_amdgcn_mfma_f32_32x32x16_bf16(kf, qf, acc, 0, 0, 0); }
#pragma unroll
            for (int r = 0; r < 16; ++r) acc[r] = (crow(r, hi) <= r32) ? acc[r] : 0.f;
            bf16x8 pa0, pa1;
#define PK4(P, BASE, OUT) do { unsigned a0 = cvt_pk_bf16(P[BASE + 0], P[BASE + 1]), a1 = cvt_pk_bf16(P[BASE + 2], P[BASE + 3]);   \
    unsigned b0 = cvt_pk_bf16(P[BASE + 4], P[BASE + 5]), b1 = cvt_pk_bf16(P[BASE + 6], P[BASE + 7]);                              \
    auto r0 = __builtin_amdgcn_permlane32_swap(a0, b0, false, false); auto r1 = __builtin_amdgcn_permlane32_swap(a1, b1, false, false); \
    u32x4 wv = {r0[0], r1[0], r0[1], r1[1]}; OUT = as_bf16x8(wv); } while (0)
            PK4(acc, 0, pa0); PK4(acc, 8, pa1);
#undef PK4
            f32x16 Y = (f32x16){};
#pragma unroll
            for (int jd = 0; jd < 4; ++jd)
#pragma unroll
                for (int s = 0; s < 2; ++s) {
                    u32x4 cw; cw.x = cvt_pk_bf16(St[jd][8 * s + 0], St[jd][8 * s + 1]); cw.y = cvt_pk_bf16(St[jd][8 * s + 2], St[jd][8 * s + 3]);
                    cw.z = cvt_pk_bf16(St[jd][8 * s + 4], St[jd][8 * s + 5]); cw.w = cvt_pk_bf16(St[jd][8 * s + 6], St[jd][8 * s + 7]);
                    const int cb = (32 * jd + 16 * s + 4 * hi) * 2;
                    const u32x2 lo = *(const LAS u32x2*)(L + QE + KSWZ(r32, cb)), hi2 = *(const LAS u32x2*)(L + QE + KSWZ(r32, cb + 16));
                    Y = __builtin_amdgcn_mfma_f32_32x32x16_bf16(as_bf16x8((u32x4){lo.x, lo.y, hi2.x, hi2.y}), as_bf16x8(cw), Y, 0, 0, 0);
                }
            bf16x8 vf0, vf1; tr_frag2<0>(vbV, vf0, vf1);
            Y = __builtin_amdgcn_mfma_f32_32x32x16_bf16(pa0, vf0, Y, 0, 0, 0); Y = __builtin_amdgcn_mfma_f32_32x32x16_bf16(pa1, vf1, Y, 0, 0, 0);
#define GL_UPD(JD) { _Pragma("unroll") for (int i = 0; i < 4; ++i) { const f32x4 e4 = *(const LAS f32x4*)(EG + (c & 1) * 128 + 32 * JD + 8 * i + 4 * hi); \
                    _Pragma("unroll") for (int q = 0; q < 4; ++q) St[JD][4 * i + q] *= e4[q]; } \
                bf16x8 k0_, k1_; tr_frag2<JD>(vbK, k0_, k1_); St[JD] = __builtin_amdgcn_mfma_f32_32x32x16_bf16(k0_, vf0, St[JD], 0, 0, 0); St[JD] = __builtin_amdgcn_mfma_f32_32x32x16_bf16(k1_, vf1, St[JD], 0, 0, 0); }
            GL_UPD(0) GL_UPD(1) GL_UPD(2) GL_UPD(3)
#undef GL_UPD
#pragma unroll
            for (int r = 0; r < 16; ++r) Hout[(size_t)tok_of(c, crow(r, hi)) * DM + h * 256 + 32 * w + r32] = f2bf(Y[r]);
        };
#pragma unroll 1
        for (int c = 0; c < 64; c += 2) { chunk(c, S0); chunk(c + 1, S1); }
#undef REOPAQUE
        __syncthreads();
    }
}
__device__ __forceinline__ void lru_conv(Ctx& C, const bf16_t* UR, bf16_t* UC) {
    const float* cw = IN_F(I_LR_CW); const float* cb = IN_F(I_LR_CB);
    const int c8 = (C.tid & 127) * 8;
    f32x4 w[4][2], bias[2];
#pragma unroll
    for (int k = 0; k < 4; ++k) { w[k][0] = *(const f32x4*)(cw + (size_t)k * DM + c8); w[k][1] = *(const f32x4*)(cw + (size_t)k * DM + c8 + 4); }
    bias[0] = *(const f32x4*)(cb + c8); bias[1] = *(const f32x4*)(cb + c8 + 4);
#pragma unroll 1
    for (int seg = blockIdx.x * 4 + (C.tid >> 7); seg < NT / 16; seg += C.G * 4) {
        const int t0 = seg * 16, s0 = t0 & 2047;
        u32x4 r[19];
#pragma unroll
        for (int q = 0; q < 19; ++q) { int tt = t0 - 2 + q; tt = tt < 0 ? 0 : (tt > NT - 1 ? NT - 1 : tt); r[q] = *(const u32x4*)(UR + (size_t)tt * DM + c8); }
        if (s0 == 0) { r[0] = (u32x4){0u, 0u, 0u, 0u}; r[1] = (u32x4){0u, 0u, 0u, 0u}; }
        if (s0 == SEQ - 16) r[18] = (u32x4){0u, 0u, 0u, 0u};
#pragma unroll
        for (int j = 0; j < 16; ++j) {
            f32x4 a0 = bias[0], a1 = bias[1];
#pragma unroll
            for (int k = 0; k < 4; ++k) { const u32x4 u = r[j + k];
                a0 += w[k][0] * (f32x4){bf_lo(u.x), bf_hi(u.x), bf_lo(u.y), bf_hi(u.y)}; a1 += w[k][1] * (f32x4){bf_lo(u.z), bf_hi(u.z), bf_lo(u.w), bf_hi(u.w)}; }
            u32x4 o; o.x = cvt_pk_bf16(a0[0], a0[1]); o.y = cvt_pk_bf16(a0[2], a0[3]); o.z = cvt_pk_bf16(a1[0], a1[1]); o.w = cvt_pk_bf16(a1[2], a1[3]);
            *(u32x4*)(UC + (size_t)(t0 + j) * DM + c8) = o;
        }
    }
}
__device__ __forceinline__ void lru_scan(Ctx& C, const bf16_t* LA0, const unsigned char* GT0, const bf16_t* LA1, const unsigned char* GT1, bf16_t* GBU, bf16_t* HF) {
    static_assert(!OUT_FP8, "this scan writes U as bf16 only");
    LAS float* PF = (LAS float*)C.lds; LAS float* EF = PF + 4096; LAS float* PB = PF + 8192; LAS float* EB = PF + 12288;
    const int lane = C.lane, cg = lane & 15, sg = C.wave * 4 + (lane >> 4);
#define LRU_UNPK(w, q, lo, hi) const float lo = bf_lo((w)[q]), hi = bf_hi((w)[q])
    for (int unit = blockIdx.x; unit < NB * 8; unit += C.G) {
        const int b = unit >> 3;
        const unsigned boff = (unsigned)((((size_t)b * SEQ + sg * 64) * DM + (unit & 7) * 128 + cg * 8) * 2);
        const int so = sg * 128 + cg * 8;
#define LRU_LD(P, t) (*(const u32x4*)((const char*)(P) + (size_t)(boff + (unsigned)((t) * (DM * 2)))))
#define LRU_ST(P, t, v) (*(u32x4*)((char*)(P) + (size_t)(boff + (unsigned)((t) * (DM * 2)))) = (v))
#define LRU_LD8(P, t) (*(const u32x2*)((const unsigned char*)(P) + (size_t)((boff >> 1) + (unsigned)((t) * DM))))
#define LRU_G8(w, gf) float gf[8]; { const f32x4 lo_ = unpk4_fp8((w).x), hi_ = unpk4_fp8((w).y); gf[0] = lo_[0]; gf[1] = lo_[1]; gf[2] = lo_[2]; gf[3] = lo_[3]; gf[4] = hi_[0]; gf[5] = hi_[1]; gf[6] = hi_[2]; gf[7] = hi_[3]; }
        auto pass1 = [&](const bf16_t* LA, const unsigned char* GT, int t0, int dt, LAS float* Pd, LAS float* Ed) {
            float p[8], e[8];
#pragma unroll
            for (int c = 0; c < 8; ++c) { p[c] = 0.f; e[c] = 0.f; }
            u32x4 lA[4], lB[4]; u32x2 gA[4], gB[4];
            auto ld = [&](int k, u32x4 (&l)[4], u32x2 (&g)[4]) {
#pragma unroll
                for (int j = 0; j < 4; ++j) { const int t = t0 + dt * (4 * k + j); l[j] = LRU_LD(LA, t); g[j] = LRU_LD8(GT, t); } };
            auto cp = [&](const u32x4 (&l)[4], const u32x2 (&g)[4]) {
#pragma unroll
                for (int j = 0; j < 4; ++j) { LRU_G8(g[j], gf);
#pragma unroll
                    for (int q = 0; q < 4; ++q) { LRU_UNPK(l[j], q, l0, l1);
                        e[2 * q] = __expf(l0) * e[2 * q] + gf[2 * q]; e[2 * q + 1] = __expf(l1) * e[2 * q + 1] + gf[2 * q + 1]; p[2 * q] += l0; p[2 * q + 1] += l1; } } };
            ld(0, lA, gA);
#pragma unroll 1
            for (int k = 0; k < 16; k += 2) {
                ld(k + 1, lB, gB); __builtin_amdgcn_sched_barrier(0); cp(lA, gA);
                ld(k + 2 < 16 ? k + 2 : 15, lA, gA); __builtin_amdgcn_sched_barrier(0); cp(lB, gB); }
            *(LAS f32x4*)(Pd + so) = (f32x4){p[0], p[1], p[2], p[3]}; *(LAS f32x4*)(Pd + so + 4) = (f32x4){p[4], p[5], p[6], p[7]};
            *(LAS f32x4*)(Ed + so) = (f32x4){e[0], e[1], e[2], e[3]}; *(LAS f32x4*)(Ed + so + 4) = (f32x4){e[4], e[5], e[6], e[7]}; };
        pass1(LA0, GT0, 0, 1, PF, EF);
        pass1(LA1, GT1, 63, -1, PB, EB);
        __syncthreads();
        float hf[8], hb[8];
#pragma unroll
        for (int c = 0; c < 8; ++c) { hf[c] = 0.f; hb[c] = 0.f; }
        for (int q = 0; q < sg; ++q) { const f32x4 pa = *(const LAS f32x4*)(PF + q * 128 + cg * 8), pb = *(const LAS f32x4*)(PF + q * 128 + cg * 8 + 4), ea = *(const LAS f32x4*)(EF + q * 128 + cg * 8), eb = *(const LAS f32x4*)(EF + q * 128 + cg * 8 + 4);
#pragma unroll
            for (int c = 0; c < 4; ++c) { hf[c] = __expf(pa[c]) * hf[c] + ea[c]; hf[4 + c] = __expf(pb[c]) * hf[4 + c] + eb[c]; } }
        for (int q = 31; q > sg; --q) { const f32x4 pa = *(const LAS f32x4*)(PB + q * 128 + cg * 8), pb = *(const LAS f32x4*)(PB + q * 128 + cg * 8 + 4), ea = *(const LAS f32x4*)(EB + q * 128 + cg * 8), eb = *(const LAS f32x4*)(EB + q * 128 + cg * 8 + 4);
#pragma unroll
            for (int c = 0; c < 4; ++c) { hb[c] = __expf(pa[c]) * hb[c] + ea[c]; hb[4 + c] = __expf(pb[c]) * hb[4 + c] + eb[c]; } }
        {
            u32x4 lA[4], lB[4]; u32x2 gA[4], gB[4];
            auto ld = [&](int k, u32x4 (&l)[4], u32x2 (&g)[4]) {
#pragma unroll
                for (int j = 0; j < 4; ++j) { l[j] = LRU_LD(LA0, 4 * k + j); g[j] = LRU_LD8(GT0, 4 * k + j); } };
            auto cp = [&](int k, const u32x4 (&l)[4], const u32x2 (&g)[4]) {
#pragma unroll
                for (int j = 0; j < 4; ++j) { u32x4 o; LRU_G8(g[j], gf);
#pragma unroll
                    for (int q = 0; q < 4; ++q) { LRU_UNPK(l[j], q, l0, l1);
                        hf[2 * q] = __expf(l0) * hf[2 * q] + gf[2 * q]; hf[2 * q + 1] = __expf(l1) * hf[2 * q + 1] + gf[2 * q + 1]; o[q] = cvt_pk_bf16(hf[2 * q], hf[2 * q + 1]); }
                    LRU_ST(HF, 4 * k + j, o); } };
            ld(0, lA, gA);
#pragma unroll 1
            for (int k = 0; k < 16; k += 2) {
                ld(k + 1, lB, gB); __builtin_amdgcn_sched_barrier(0); cp(k, lA, gA);
                ld(k + 2 < 16 ? k + 2 : 15, lA, gA); __builtin_amdgcn_sched_barrier(0); cp(k + 1, lB, gB); }
        }
        {
            u32x4 lA[2], fA[2], bA[2], lB[2], fB[2], bB[2]; u32x2 gA[2], gB[2];
            auto ld = [&](int k, u32x4 (&l)[2], u32x2 (&g)[2], u32x4 (&f)[2], u32x4 (&bb)[2]) {
#pragma unroll
                for (int j = 0; j < 2; ++j) { const int t = 63 - (2 * k + j); l[j] = LRU_LD(LA1, t); g[j] = LRU_LD8(GT1, t); f[j] = LRU_LD(HF, t); bb[j] = LRU_LD(GBU, t); } };
            auto cp = [&](int k, const u32x4 (&l)[2], const u32x2 (&g)[2], const u32x4 (&f)[2], const u32x4 (&bb)[2]) {
#pragma unroll
                for (int j = 0; j < 2; ++j) { u32x4 o; LRU_G8(g[j], gf);
#pragma unroll
                    for (int q = 0; q < 4; ++q) { LRU_UNPK(l[j], q, l0, l1); LRU_UNPK(f[j], q, f0, f1); LRU_UNPK(bb[j], q, x0, x1);
                        hb[2 * q] = __expf(l0) * hb[2 * q] + gf[2 * q]; hb[2 * q + 1] = __expf(l1) * hb[2 * q + 1] + gf[2 * q + 1];
                        o[q] = cvt_pk_bf16(gelu_tanh(x0) * ((hb[2 * q] + f0) * (1.0f / F8_SG)), gelu_tanh(x1) * ((hb[2 * q + 1] + f1) * (1.0f / F8_SG))); }
                    LRU_ST(GBU, 63 - (2 * k + j), o); } };
            ld(0, lA, gA, fA, bA);
#pragma unroll 1
            for (int k = 0; k < 32; k += 2) {
                ld(k + 1, lB, gB, fB, bB); __builtin_amdgcn_sched_barrier(0); cp(k, lA, gA, fA, bA);
                ld(k + 2 < 32 ? k + 2 : 31, lA, gA, fA, bA); __builtin_amdgcn_sched_barrier(0); cp(k + 1, lB, gB, fB, bB); }
        }
        __syncthreads();
    }
#undef LRU_LD
#undef LRU_LD8
#undef LRU_G8
#undef LRU_ST
#undef LRU_UNPK
}
__device__ __forceinline__ void mla_norm_rope(Ctx& C, const bf16_t* Zm, bf16_t* CQN, bf16_t* CKVN, bf16_t* Kc, int r0, int rs, int nr) {
    const float* qg = IN_F(I_MA_QG); const float* kvg = IN_F(I_MA_KVG);
    const float* cs = (const float*)(C.ws + WS_ROPE); const float* sn = cs + (size_t)NT * 32;
    const int lane = C.lane;
    const int i0r = 4 * (lane & 7);
    const f32x4 gq0 = *(const f32x4*)(qg + 4 * lane), g1 = lane < 32 ? *(const f32x4*)(qg + 256 + 4 * lane) : *(const f32x4*)(kvg + 4 * (lane - 32)), g2 = *(const f32x4*)(kvg + 128 + 4 * (lane & 31));
    u32x2 zc[3], zn[3]; f32x4 cc, sc, cn, sn2;
    { const u32x2* zr = (const u32x2*)(Zm + (size_t)r0 * 768);
#pragma unroll
      for (int j = 0; j < 3; ++j) zc[j] = zr[lane + 64 * j];
      cc = *(const f32x4*)(cs + (size_t)r0 * 32 + i0r); sc = *(const f32x4*)(sn + (size_t)r0 * 32 + i0r); }
    for (int k = 0; k < nr; ++k) { const int row = r0 + k * rs;
        { const int rn = r0 + (k + 1 < nr ? k + 1 : nr - 1) * rs; const u32x2* zr = (const u32x2*)(Zm + (size_t)rn * 768);
#pragma unroll
          for (int j = 0; j < 3; ++j) zn[j] = zr[lane + 64 * j];
          cn = *(const f32x4*)(cs + (size_t)rn * 32 + i0r); sn2 = *(const f32x4*)(sn + (size_t)rn * 32 + i0r); }
        f32x4 v[3];
#pragma unroll
        for (int j = 0; j < 3; ++j) { const u32x2 w = zc[j]; v[j] = (f32x4){bf_lo(w.x), bf_hi(w.x), bf_lo(w.y), bf_hi(w.y)}; zc[j] = zn[j]; }
        const f32x4 c = cc, s = sc; cc = cn; sc = sn2;
        const float sq0 = (v[0][0] * v[0][0] + v[0][1] * v[0][1]) + (v[0][2] * v[0][2] + v[0][3] * v[0][3]);
        const float sq1 = (v[1][0] * v[1][0] + v[1][1] * v[1][1]) + (v[1][2] * v[1][2] + v[1][3] * v[1][3]);
        const float sq2 = (v[2][0] * v[2][0] + v[2][1] * v[2][1]) + (v[2][2] * v[2][2] + v[2][3] * v[2][3]);
        const float ssq_q = wave_sum(sq0 + (lane < 32 ? sq1 : 0.f)), ssq_kv = wave_sum((lane >= 32 ? sq1 : 0.f) + (lane < 32 ? sq2 : 0.f));
        const float rq = 1.f / sqrtf(ssq_q * (1.f / 384.f) + LN_EPS), rkv = 1.f / sqrtf(ssq_kv * (1.f / 256.f) + LN_EPS);
        { const f32x4 o = v[0] * rq * gq0; u32x2 w; w.x = cvt_pk_bf16(o[0], o[1]); w.y = cvt_pk_bf16(o[2], o[3]); *(u32x2*)(CQN + (size_t)row * 384 + 4 * lane) = w; }
        if (lane < 32) { const f32x4 o = v[1] * rq * g1; u32x2 w; w.x = cvt_pk_bf16(o[0], o[1]); w.y = cvt_pk_bf16(o[2], o[3]); *(u32x2*)(CQN + (size_t)row * 384 + 256 + 4 * lane) = w;
                         const f32x4 o2 = v[2] * rkv * g2; u32x2 w2; w2.x = cvt_pk_bf16(o2[0], o2[1]); w2.y = cvt_pk_bf16(o2[2], o2[3]); *(u32x2*)(CKVN + (size_t)row * 256 + 128 + 4 * lane) = w2; }
        else { const f32x4 o = v[1] * rkv * g1; u32x2 w; w.x = cvt_pk_bf16(o[0], o[1]); w.y = cvt_pk_bf16(o[2], o[3]); *(u32x2*)(CKVN + (size_t)row * 256 + 4 * (lane - 32)) = w; }
        f32x4 part;
#pragma unroll
        for (int q = 0; q < 4; ++q) part[q] = __shfl_xor(v[2][q], 8);
        if (lane >= 32 && lane < 48) {
            const bool second = lane >= 40; const int i0 = i0r;
            const f32x4 o = second ? (v[2] * c + part * s) : (v[2] * c - part * s);
            u32x2 w; w.x = cvt_pk_bf16(o[0], o[1]); w.y = cvt_pk_bf16(o[2], o[3]);
            const int b = row >> 11, s_ = row & 2047;
            if (ATT_FP8) { const unsigned w8 = pk4_fp8(o[0], o[1], o[2], o[3]);
#pragma unroll
                for (int h = 0; h < 8; ++h) *(unsigned*)((unsigned char*)Kc + ((size_t)(b * 8 + h) * SEQ + s_) * 192 + 128 + (second ? 32 : 0) + i0) = w8; }
            else {
#pragma unroll
            for (int h = 0; h < 8; ++h) *(u32x2*)(Kc + ((size_t)(b * 8 + h) * SEQ + s_) * 192 + 128 + (second ? 32 : 0) + i0) = w; }
        }
    }
}
namespace attn {
constexpr int DQK = 192, DV = 128, NW = 8, QBLK = 32, KVBLK = 64;
constexpr float SCALE = 0.07216878364870322f;
constexpr float THR = 8.f;
constexpr int LDQ = 8 * DQK, LDK = DQK, LDVV = DV, LDO = 1024;
constexpr int SHM_V = KVBLK * DV * 2, SHM_K = KVBLK * DQK * 2;
constexpr int SHM_ATTN = 2 * SHM_V + 2 * SHM_K + NW * 64 * 4;
#define KSWZ192(row, colB) ((row) * 384 + ((colB) ^ ((((row) >> 1) & 7) << 4)))
#define SBAR() __builtin_amdgcn_sched_barrier(0)

template <bool DEFER = true>
__device__ __forceinline__ void partialSM(f32x16& p0, f32x16& p1, float& m_reg, float& mn, float& alpha) {
    constexpr float Cc = SCALE * 1.4426950408889634f;
    float pmax = p0[0];
#pragma unroll
    for (int r = 1; r < 16; ++r) pmax = fmaxf(pmax, p0[r]);
#pragma unroll
    for (int r = 0; r < 16; ++r) pmax = fmaxf(pmax, p1[r]);
    { auto rr = __builtin_amdgcn_permlane32_swap(__float_as_uint(pmax), __float_as_uint(pmax), false, false);
      pmax = fmaxf(__uint_as_float(rr[0]), __uint_as_float(rr[1])); }
    if (__builtin_expect(__all(pmax - m_reg <= (DEFER ? THR / SCALE : 0.f)), 1)) { mn = m_reg; alpha = 1.f; }
    else { mn = fmaxf(m_reg, pmax); alpha = __builtin_amdgcn_exp2f((m_reg - mn) * Cc); m_reg = mn; }
    const float mnC = -mn * Cc;
#pragma unroll
    for (int r = 0; r < 16; ++r) p0[r] = fmaf(p0[r], Cc, mnC);
#pragma unroll
    for (int r = 0; r < 16; ++r) p1[r] = fmaf(p1[r], Cc, mnC);
#pragma unroll
    for (int r = 0; r < 16; ++r) p0[r] = __builtin_amdgcn_exp2f(p0[r]);
}
__device__ __forceinline__ void finishSM(f32x16& p0, f32x16& p1, float alpha, float& l_reg, bf16x8& pa0, bf16x8& pa1, bf16x8& pa2, bf16x8& pa3) {
#pragma unroll
    for (int r = 0; r < 16; ++r) p1[r] = __builtin_amdgcn_exp2f(p1[r]);
    float ps = 0;
#pragma unroll
    for (int r = 0; r < 16; ++r) ps += p0[r];
#pragma unroll
    for (int r = 0; r < 16; ++r) ps += p1[r];
    { auto rr = __builtin_amdgcn_permlane32_swap(__float_as_uint(ps), __float_as_uint(ps), false, false);
      ps = __uint_as_float(rr[0]) + __uint_as_float(rr[1]); }
    l_reg = l_reg * alpha + ps;
#define PK4(P, BASE, OUT) do { unsigned a0 = cvt_pk_bf16(P[BASE + 0], P[BASE + 1]), a1 = cvt_pk_bf16(P[BASE + 2], P[BASE + 3]);   \
    unsigned b0 = cvt_pk_bf16(P[BASE + 4], P[BASE + 5]), b1 = cvt_pk_bf16(P[BASE + 6], P[BASE + 7]);                              \
    auto r0 = __builtin_amdgcn_permlane32_swap(a0, b0, false, false); auto r1 = __builtin_amdgcn_permlane32_swap(a1, b1, false, false); \
    u32x4 w = {r0[0], r1[0], r0[1], r1[1]}; OUT = __builtin_bit_cast(bf16x8, w); } while (0)
    PK4(p0, 0, pa0); PK4(p0, 8, pa1); PK4(p1, 0, pa2); PK4(p1, 8, pa3);
#undef PK4
}
template <int KOFF>
__device__ __forceinline__ void qkt(f32x16& p0, f32x16& p1, const int (&kb)[4], const bf16x8* qr) {
    p0 = f32x16{}; p1 = f32x16{};
#pragma unroll
    for (int d0 = 0; d0 < 12; ++d0) { const int a = d0 >> 2, b = d0 & 3;
        const bf16x8 b0 = *(const LAS bf16x8*)(uintptr_t)(unsigned)(kb[b] + 128 * a + KOFF);
        const bf16x8 b1 = *(const LAS bf16x8*)(uintptr_t)(unsigned)(kb[b] + 128 * a + 12288 + KOFF);
        p0 = __builtin_amdgcn_mfma_f32_32x32x16_bf16(b0, qr[d0], p0, 0, 0, 0);
        p1 = __builtin_amdgcn_mfma_f32_32x32x16_bf16(b1, qr[d0], p1, 0, 0, 0); }
}
template <int D0> __device__ __forceinline__ void pv_one(f32x16& od, int vb, bf16x8 pa0, bf16x8 pa1, bf16x8 pa2, bf16x8 pa3) {
    const s16x4 l0 = tr_read<v_rd_off(D0, 0, 0)>(vb), h0 = tr_read<v_rd_off(D0, 0, 1)>(vb), l1 = tr_read<v_rd_off(D0, 1, 0)>(vb), h1 = tr_read<v_rd_off(D0, 1, 1)>(vb);
    const s16x4 l2 = tr_read<v_rd_off(D0, 2, 0)>(vb), h2 = tr_read<v_rd_off(D0, 2, 1)>(vb), l3 = tr_read<v_rd_off(D0, 3, 0)>(vb), h3 = tr_read<v_rd_off(D0, 3, 1)>(vb);
    asm volatile("s_waitcnt lgkmcnt(0)" ::: "memory"); SBAR();
    od = __builtin_amdgcn_mfma_f32_32x32x16_bf16(pa0, PKLH(l0, h0), od, 0, 0, 0);
    od = __builtin_amdgcn_mfma_f32_32x32x16_bf16(pa1, PKLH(l1, h1), od, 0, 0, 0);
    od = __builtin_amdgcn_mfma_f32_32x32x16_bf16(pa2, PKLH(l2, h2), od, 0, 0, 0);
    od = __builtin_amdgcn_mfma_f32_32x32x16_bf16(pa3, PKLH(l3, h3), od, 0, 0, 0);
}
__device__ __forceinline__ void pv_d0(f32x16* o, int vb, bf16x8 pa0, bf16x8 pa1, bf16x8 pa2, bf16x8 pa3) {
    pv_one<0>(o[0], vb, pa0, pa1, pa2, pa3); pv_one<1>(o[1], vb, pa0, pa1, pa2, pa3); pv_one<2>(o[2], vb, pa0, pa1, pa2, pa3); pv_one<3>(o[3], vb, pa0, pa1, pa2, pa3);
}
__device__ __forceinline__ void attn_unit(const bf16_t* __restrict__ Qb, const bf16_t* __restrict__ Kh, const bf16_t* __restrict__ Vh, bf16_t* __restrict__ Ob, LAS unsigned char* lds) {
    const int tid = opaque((int)threadIdx.x), wid = tid >> 6, lane = tid & 63, r32 = lane & 31, hi = lane >> 5;
    LAS unsigned char* V_lds = lds; LAS unsigned char* K_lds = lds + 2 * SHM_V;
    LAS float* wsf = (LAS float*)(lds + 2 * SHM_V + 2 * SHM_K) + wid * 64; LAS float* li_l = wsf; LAS float* al_l = wsf + 32;
    float m_reg = -1e30f, l_reg = 0; f32x16 o[4] = {}; bf16x8 qr[12];
    const bf16_t* Qw = Qb + (long)(wid * QBLK + r32) * LDQ + hi * 8;
#pragma unroll
    for (int d0 = 0; d0 < 12; ++d0) qr[d0] = *(const bf16x8*)(Qw + d0 * 16);
    const int sr = tid >> 4, sc = (tid & 15) * 8, vst0 = v_st(sr, sc), vst1 = v_st(32 + sr, sc);
    int krow[3], kch[3];
#pragma unroll
    for (int i = 0; i < 3; ++i) { const int id = tid + 512 * i; krow[i] = id / 24; kch[i] = id % 24; }
    const int vb0 = lds_addr(V_lds) + v_rd_base(lane);
    bf16x8 vs0, vs1, ks0, ks1, ks2;
#define SLOAD(k0) do { vs0 = *(const bf16x8*)(Vh + (long)((k0) + sr) * LDVV + sc); vs1 = *(const bf16x8*)(Vh + (long)((k0) + 32 + sr) * LDVV + sc); \
    ks0 = *(const bf16x8*)(Kh + (long)((k0) + krow[0]) * LDK + kch[0] * 8); ks1 = *(const bf16x8*)(Kh + (long)((k0) + krow[1]) * LDK + kch[1] * 8); ks2 = *(const bf16x8*)(Kh + (long)((k0) + krow[2]) * LDK + kch[2] * 8); } while (0)
#define SWRITE(b) do { *(LAS bf16x8*)(V_lds + (b) * SHM_V + vst0) = vs0; *(LAS bf16x8*)(V_lds + (b) * SHM_V + vst1) = vs1; \
    *(LAS bf16x8*)(K_lds + (b) * SHM_K + KSWZ192(krow[0], kch[0] * 16)) = ks0; *(LAS bf16x8*)(K_lds + (b) * SHM_K + KSWZ192(krow[1], kch[1] * 16)) = ks1; \
    *(LAS bf16x8*)(K_lds + (b) * SHM_K + KSWZ192(krow[2], kch[2] * 16)) = ks2; } while (0)
#define RESC(a) do { if (__any((a) < 1.f)) { if (hi == 0) al_l[r32] = (a); asm volatile("s_waitcnt lgkmcnt(0)" ::: "memory"); \
    _Pragma("unroll") for (int d = 0; d < 4; ++d) _Pragma("unroll") for (int r = 0; r < 16; ++r) o[d][r] *= al_l[crow(r, hi)]; } } while (0)
    int kb[4];
    { const int xr = ((r32 >> 1) & 7) << 4;
#pragma unroll
      for (int b = 0; b < 4; ++b) kb[b] = lds_addr(K_lds) + r32 * 384 + (((b << 5) | (hi << 4)) ^ xr); }
    f32x16 pA0, pA1, pB0, pB1; float mnA, mnB, alA, alB; bf16x8 pa0, pa1, pa2, pa3; constexpr int NTILES = SEQ / KVBLK;
    SLOAD(0); asm volatile("s_waitcnt vmcnt(0)" ::: "memory"); SWRITE(0); __syncthreads();
    qkt<0>(pA0, pA1, kb, qr); partialSM(pA0, pA1, m_reg, mnA, alA);
    SLOAD(KVBLK);
    asm volatile("s_waitcnt vmcnt(0)" ::: "memory"); SWRITE(1); __syncthreads();
    for (int j = 1; j + 1 < NTILES; j += 2) {
        SBAR(); qkt<SHM_K>(pB0, pB1, kb, qr);
        finishSM(pA0, pA1, alA, l_reg, pa0, pa1, pa2, pa3); SBAR();
        SLOAD((j + 1) * KVBLK); SBAR();
        pv_d0(o, vb0, pa0, pa1, pa2, pa3); partialSM(pB0, pB1, m_reg, mnB, alB);
        __syncthreads(); asm volatile("s_waitcnt vmcnt(0)" ::: "memory"); SWRITE(0);
        RESC(alB); __syncthreads();
        SBAR(); qkt<0>(pA0, pA1, kb, qr);
        finishSM(pB0, pB1, alB, l_reg, pa0, pa1, pa2, pa3); SBAR();
        SLOAD((j + 2) * KVBLK); SBAR();
        pv_d0(o, vb0 + SHM_V, pa0, pa1, pa2, pa3); partialSM(pA0, pA1, m_reg, mnA, alA);
        __syncthreads(); asm volatile("s_waitcnt vmcnt(0)" ::: "memory"); SWRITE(1);
        RESC(alA); __syncthreads();
    }
    SBAR(); qkt<SHM_K>(pB0, pB1, kb, qr);
    finishSM(pA0, pA1, alA, l_reg, pa0, pa1, pa2, pa3); SBAR();
    pv_d0(o, vb0, pa0, pa1, pa2, pa3); partialSM(pB0, pB1, m_reg, mnB, alB);
    __syncthreads(); RESC(alB);
    finishSM(pB0, pB1, alB, l_reg, pa0, pa1, pa2, pa3); SBAR();
    pv_d0(o, vb0 + SHM_V, pa0, pa1, pa2, pa3);
    if (hi == 0) li_l[r32] = l_reg; asm volatile("s_waitcnt lgkmcnt(0)" ::: "memory");
    float rli[16];
#pragma unroll
    for (int r = 0; r < 16; ++r) rli[r] = __builtin_amdgcn_rcpf(li_l[crow(r, hi)]);
    bf16_t* Ow = Ob + (long)(wid * QBLK) * LDO;
#pragma unroll
    for (int r = 0; r < 16; ++r) { const int orow = crow(r, hi);
#pragma unroll
        for (int d0 = 0; d0 < 4; ++d0) Ow[(long)orow * LDO + d0 * 32 + r32] = f2bf(o[d0][r] * rli[r]); }
    __syncthreads();
#undef SLOAD
#undef SWRITE
#undef RESC
}
constexpr int SHM_K8 = KVBLK * DQK;
#define KSWZ8(row, ch) ((row) * 192 + ((((ch)) ^ (((row) >> 2) & 3)) << 4))
template <int KOFF>
__device__ __forceinline__ void qkt8(f32x16& p0, f32x16& p1, int kbA, int kbB, const i32x8 (&q8)[3], int f8sc) {
    p0 = f32x16{}; p1 = f32x16{};
    asm volatile("s_nop 1" ::: "memory");
#pragma unroll
    for (int i = 0; i < 3; ++i) {
        const i32x4 a0 = *(const LAS i32x4*)(uintptr_t)(unsigned)(kbA + 64 * i + KOFF), a1 = *(const LAS i32x4*)(uintptr_t)(unsigned)(kbB + 64 * i + KOFF);
        const i32x4 b0 = *(const LAS i32x4*)(uintptr_t)(unsigned)(kbA + 64 * i + 6144 + KOFF), b1 = *(const LAS i32x4*)(uintptr_t)(unsigned)(kbB + 64 * i + 6144 + KOFF);
        const i32x8 k0 = __builtin_shufflevector(a0, a1, 0, 1, 2, 3, 4, 5, 6, 7), k1 = __builtin_shufflevector(b0, b1, 0, 1, 2, 3, 4, 5, 6, 7);
        asm volatile("v_mfma_scale_f32_32x32x64_f8f6f4 %0, %1, %2, %0, %3, %3 op_sel_hi:[0,0,0]" : "+v"(p0) : "v"(k0), "v"(q8[i]), "v"(f8sc));
        asm volatile("v_mfma_scale_f32_32x32x64_f8f6f4 %0, %1, %2, %0, %3, %3 op_sel_hi:[0,0,0]" : "+v"(p1) : "v"(k1), "v"(q8[i]), "v"(f8sc));
    }
    asm volatile("s_nop 15\n\ts_nop 15" : "+v"(p0), "+v"(p1));
}
__device__ __forceinline__ void attn_unit8(const unsigned char* __restrict__ Qb, const unsigned char* __restrict__ Kh, const bf16_t* __restrict__ Vh, bf16_t* __restrict__ Ob, LAS unsigned char* lds) {
    const int tid = opaque((int)threadIdx.x), wid = tid >> 6, lane = tid & 63, r32 = lane & 31, hi = lane >> 5;
    LAS unsigned char* V_lds = lds; LAS unsigned char* K_lds = lds + 2 * SHM_V;
    LAS float* wsf = (LAS float*)(lds + 2 * SHM_V + 2 * SHM_K8) + wid * 64; LAS float* li_l = wsf; LAS float* al_l = wsf + 32;
    float m_reg = -1e30f, l_reg = 0; f32x16 o[4] = {}; i32x8 q8[3]; const int f8sc = 0x7f7f7f7f;
    { const unsigned char* Qw = Qb + (size_t)(wid * QBLK + r32) * 1536 + 32 * hi;
#pragma unroll
      for (int i = 0; i < 3; ++i) { const i32x4 lo = *(const i32x4*)(Qw + 64 * i), hi4 = *(const i32x4*)(Qw + 64 * i + 16); q8[i] = __builtin_shufflevector(lo, hi4, 0, 1, 2, 3, 4, 5, 6, 7); } }
    const int sr = tid >> 4, sc = (tid & 15) * 8, vst0 = v_st(sr, sc), vst1 = v_st(32 + sr, sc);
    const int kr0 = tid / 12, kc0 = tid % 12, kr1 = (tid + 512) / 12, kc1 = (tid + 512) % 12; const bool k2 = tid < 256;
    const int vb0 = lds_addr(V_lds) + v_rd_base(lane);
    bf16x8 vs0, vs1; i32x4 ks0, ks1 = {0, 0, 0, 0};
#define SLOAD(k0) do { vs0 = *(const bf16x8*)(Vh + (long)((k0) + sr) * LDVV + sc); vs1 = *(const bf16x8*)(Vh + (long)((k0) + 32 + sr) * LDVV + sc); \
    ks0 = *(const i32x4*)(Kh + (size_t)((k0) + kr0) * 192 + kc0 * 16); if (k2) ks1 = *(const i32x4*)(Kh + (size_t)((k0) + kr1) * 192 + kc1 * 16); } while (0)
#define SWRITE(b) do { *(LAS bf16x8*)(V_lds + (b) * SHM_V + vst0) = vs0; *(LAS bf16x8*)(V_lds + (b) * SHM_V + vst1) = vs1; \
    *(LAS i32x4*)(K_lds + (b) * SHM_K8 + KSWZ8(kr0, kc0)) = ks0; if (k2) *(LAS i32x4*)(K_lds + (b) * SHM_K8 + KSWZ8(kr1, kc1)) = ks1; } while (0)
#define RESC(a) do { if (__any((a) < 1.f)) { if (hi == 0) al_l[r32] = (a); asm volatile("s_waitcnt lgkmcnt(0)" ::: "memory"); \
    _Pragma("unroll") for (int d = 0; d < 4; ++d) _Pragma("unroll") for (int r = 0; r < 16; ++r) o[d][r] *= al_l[crow(r, hi)]; } } while (0)
    const int xr = (r32 >> 2) & 3;
    const int kbA = lds_addr(K_lds) + r32 * 192 + (((2 * hi) ^ xr) << 4), kbB = lds_addr(K_lds) + r32 * 192 + (((2 * hi + 1) ^ xr) << 4);
    f32x16 pA0, pA1, pB0, pB1; float mnA, mnB, alA, alB; bf16x8 pa0, pa1, pa2, pa3; constexpr int NTILES = SEQ / KVBLK;
    SLOAD(0); asm volatile("s_waitcnt vmcnt(0)" ::: "memory"); SWRITE(0); __syncthreads();
    qkt8<0>(pA0, pA1, kbA, kbB, q8, f8sc); partialSM(pA0, pA1, m_reg, mnA, alA);
    SLOAD(KVBLK);
    asm volatile("s_waitcnt vmcnt(0)" ::: "memory"); SWRITE(1); __syncthreads();
    for (int j = 1; j + 1 < NTILES; j += 2) {
        SBAR(); qkt8<SHM_K8>(pB0, pB1, kbA, kbB, q8, f8sc);
        finishSM(pA0, pA1, alA, l_reg, pa0, pa1, pa2, pa3); SBAR();
        SLOAD((j + 1) * KVBLK); SBAR();
        pv_d0(o, vb0, pa0, pa1, pa2, pa3); partialSM(pB0, pB1, m_reg, mnB, alB);
        __syncthreads(); asm volatile("s_waitcnt vmcnt(0)" ::: "memory"); SWRITE(0);
        RESC(alB); __syncthreads();
        SBAR(); qkt8<0>(pA0, pA1, kbA, kbB, q8, f8sc);
        finishSM(pB0, pB1, alB, l_reg, pa0, pa1, pa2, pa3); SBAR();
        SLOAD((j + 2) * KVBLK); SBAR();
        pv_d0(o, vb0 + SHM_V, pa0, pa1, pa2, pa3); partialSM(pA0, pA1, m_reg, mnA, alA);
        __syncthreads(); asm volatile("s_waitcnt vmcnt(0)" ::: "memory"); SWRITE(1);
        RESC(alA); __syncthreads();
    }
    SBAR(); qkt8<SHM_K8>(pB0, pB1, kbA, kbB, q8, f8sc);
    finishSM(pA0, pA1, alA, l_reg, pa0, pa1, pa2, pa3); SBAR();
    pv_d0(o, vb0, pa0, pa1, pa2, pa3); partialSM(pB0, pB1, m_reg, mnB, alB);
    __syncthreads(); RESC(alB);
    finishSM(pB0, pB1, alB, l_reg, pa0, pa1, pa2, pa3); SBAR();
    pv_d0(o, vb0 + SHM_V, pa0, pa1, pa2, pa3);
    if (hi == 0) li_l[r32] = l_reg; asm volatile("s_waitcnt lgkmcnt(0)" ::: "memory");
    float rli[16];
#pragma unroll
    for (int r = 0; r < 16; ++r) rli[r] = __builtin_amdgcn_rcpf(li_l[crow(r, hi)]);
    bf16_t* Ow = Ob + (long)(wid * QBLK) * LDO;
#pragma unroll
    for (int r = 0; r < 16; ++r) { const int orow = crow(r, hi);
#pragma unroll
        for (int d0 = 0; d0 < 4; ++d0) Ow[(long)orow * LDO + d0 * 32 + r32] = f2bf(o[d0][r] * rli[r]); }
    __syncthreads();
#undef SLOAD
#undef SWRITE
#undef RESC
}
constexpr int SHM_V8 = KVBLK * DV;
__device__ __forceinline__ void finishSM8(f32x16& p0, f32x16& p1, float alpha, float& l_reg, i32x8& P8) {
#pragma unroll
    for (int r = 0; r < 16; ++r) p1[r] = __builtin_amdgcn_exp2f(p1[r]);
    float ps = 0;
#pragma unroll
    for (int r = 0; r < 16; ++r) ps += p0[r];
#pragma unroll
    for (int r = 0; r < 16; ++r) ps += p1[r];
    { auto rr = __builtin_amdgcn_permlane32_swap(__float_as_uint(ps), __float_as_uint(ps), false, false);
      ps = __uint_as_float(rr[0]) + __uint_as_float(rr[1]); }
    l_reg = l_reg * alpha + ps;
#pragma unroll
    for (int i = 0; i < 4; ++i) { P8[i] = (int)pk4_fp8(p0[4 * i] * F8_SP, p0[4 * i + 1] * F8_SP, p0[4 * i + 2] * F8_SP, p0[4 * i + 3] * F8_SP); P8[4 + i] = (int)pk4_fp8(p1[4 * i] * F8_SP, p1[4 * i + 1] * F8_SP, p1[4 * i + 2] * F8_SP, p1[4 * i + 3] * F8_SP); }
}
template <int VOFF>
__device__ __forceinline__ void pv8(f32x16 (&o)[4], int vbA, int vbB, const i32x8& P8, int f8sc) {
    i32x8 vf[4];
#pragma unroll
    for (int d0 = 0; d0 < 4; ++d0) { const i32x4 a = *(const LAS i32x4*)(uintptr_t)(unsigned)(vbA + d0 * 2048 + VOFF), b = *(const LAS i32x4*)(uintptr_t)(unsigned)(vbB + d0 * 2048 + VOFF); vf[d0] = __builtin_shufflevector(a, b, 0, 1, 2, 3, 4, 5, 6, 7); }
    asm volatile("s_nop 4" ::: "memory");
#pragma unroll
    for (int d0 = 0; d0 < 4; ++d0) asm volatile("v_mfma_scale_f32_32x32x64_f8f6f4 %0, %1, %2, %0, %3, %3 op_sel_hi:[0,0,0]" : "+v"(o[d0]) : "v"(P8), "v"(vf[d0]), "v"(f8sc));
    asm volatile("s_nop 15\n\ts_nop 15" : "+v"(o[0]), "+v"(o[1]), "+v"(o[2]), "+v"(o[3]));
}
__device__ __forceinline__ void attn_unit88(const unsigned char* __restrict__ Qb, const unsigned char* __restrict__ Kh, const unsigned char* __restrict__ Vt, bf16_t* __restrict__ Ob, LAS unsigned char* lds) {
    const int tid = opaque((int)threadIdx.x), wid = tid >> 6, lane = tid & 63, r32 = lane & 31, hi = lane >> 5;
    LAS unsigned char* V_lds = lds; LAS unsigned char* K_lds = lds + 2 * SHM_V8;
    LAS float* wsf = (LAS float*)(lds + 2 * SHM_V8 + 2 * SHM_K8) + wid * 64; LAS float* li_l = wsf; LAS float* al_l = wsf + 32;
    float m_reg = -1e30f, l_reg = 0; f32x16 o[4] = {}; i32x8 q8[3]; const int f8sc = 0x7f7f7f7f;
    { const unsigned char* Qw = Qb + (size_t)(wid * QBLK + r32) * 1536 + 32 * hi;
#pragma unroll
      for (int i = 0; i < 3; ++i) { const i32x4 lo = *(const i32x4*)(Qw + 64 * i), hi4 = *(const i32x4*)(Qw + 64 * i + 16); q8[i] = __builtin_shufflevector(lo, hi4, 0, 1, 2, 3, 4, 5, 6, 7); } }
    const int vdv = tid >> 2, vc = tid & 3;
    int vwa[4];
#pragma unroll
    for (int g = 0; g < 4; ++g) { const int h = g & 1, slotbase = 16 * (vc >> 1) + 4 * (2 * (vc & 1) + (g >> 1)); const int chunk = 2 * h + (slotbase >> 4); vwa[g] = vdv * 64 + ((chunk ^ ((vdv >> 2) & 3)) << 4) + (slotbase & 15); }
    const int kr0 = tid / 12, kc0 = tid % 12, kr1 = (tid + 512) / 12, kc1 = (tid + 512) % 12; const bool k2 = tid < 256;
    i32x4 vs, ks0, ks1 = {0, 0, 0, 0};
#define SLOAD(k0) do { vs = *(const i32x4*)(Vt + (size_t)vdv * SEQ + (k0) + 16 * vc); \
    ks0 = *(const i32x4*)(Kh + (size_t)((k0) + kr0) * 192 + kc0 * 16); if (k2) ks1 = *(const i32x4*)(Kh + (size_t)((k0) + kr1) * 192 + kc1 * 16); } while (0)
#define SWRITE(b) do { _Pragma("unroll") for (int g = 0; g < 4; ++g) *(LAS int*)(V_lds + (b) * SHM_V8 + vwa[g]) = vs[g]; \
    *(LAS i32x4*)(K_lds + (b) * SHM_K8 + KSWZ8(kr0, kc0)) = ks0; if (k2) *(LAS i32x4*)(K_lds + (b) * SHM_K8 + KSWZ8(kr1, kc1)) = ks1; } while (0)
#define RESC(a) do { if (__any((a) < 1.f)) { if (hi == 0) al_l[r32] = (a); asm volatile("s_waitcnt lgkmcnt(0)" ::: "memory"); \
    _Pragma("unroll") for (int d = 0; d < 4; ++d) _Pragma("unroll") for (int r = 0; r < 16; ++r) o[d][r] *= al_l[crow(r, hi)]; } } while (0)
    const int xr = (r32 >> 2) & 3;
    const int kbA = lds_addr(K_lds) + r32 * 192 + (((2 * hi) ^ xr) << 4), kbB = lds_addr(K_lds) + r32 * 192 + (((2 * hi + 1) ^ xr) << 4);
    const int vbA = lds_addr(V_lds) + r32 * 64 + (((2 * hi) ^ xr) << 4), vbB = lds_addr(V_lds) + r32 * 64 + (((2 * hi + 1) ^ xr) << 4);
    f32x16 pA0, pA1, pB0, pB1; float mnA, mnB, alA, alB; i32x8 P8; constexpr int NTILES = SEQ / KVBLK;
    SLOAD(0); asm volatile("s_waitcnt vmcnt(0)" ::: "memory"); SWRITE(0); __syncthreads();
    qkt8<0>(pA0, pA1, kbA, kbB, q8, f8sc); partialSM<false>(pA0, pA1, m_reg, mnA, alA);
    SLOAD(KVBLK);
    asm volatile("s_waitcnt vmcnt(0)" ::: "memory"); SWRITE(1); __syncthreads();
    for (int j = 1; j + 1 < NTILES; j += 2) {
        SBAR(); qkt8<SHM_K8>(pB0, pB1, kbA, kbB, q8, f8sc);
        finishSM8(pA0, pA1, alA, l_reg, P8); SBAR();
        SLOAD((j + 1) * KVBLK); SBAR();
        pv8<0>(o, vbA, vbB, P8, f8sc); partialSM<false>(pB0, pB1, m_reg, mnB, alB);
        __syncthreads(); asm volatile("s_waitcnt vmcnt(0)" ::: "memory"); SWRITE(0);
        RESC(alB); __syncthreads();
        SBAR(); qkt8<0>(pA0, pA1, kbA, kbB, q8, f8sc);
        finishSM8(pB0, pB1, alB, l_reg, P8); SBAR();
        SLOAD((j + 2) * KVBLK); SBAR();
        pv8<SHM_V8>(o, vbA, vbB, P8, f8sc); partialSM<false>(pA0, pA1, m_reg, mnA, alA);
        __syncthreads(); asm volatile("s_waitcnt vmcnt(0)" ::: "memory"); SWRITE(1);
        RESC(alA); __syncthreads();
    }
    SBAR(); qkt8<SHM_K8>(pB0, pB1, kbA, kbB, q8, f8sc);
    finishSM8(pA0, pA1, alA, l_reg, P8); SBAR();
    pv8<0>(o, vbA, vbB, P8, f8sc); partialSM<false>(pB0, pB1, m_reg, mnB, alB);
    __syncthreads(); RESC(alB);
    finishSM8(pB0, pB1, alB, l_reg, P8); SBAR();
    pv8<SHM_V8>(o, vbA, vbB, P8, f8sc);
    if (hi == 0) li_l[r32] = l_reg; asm volatile("s_waitcnt lgkmcnt(0)" ::: "memory");
    float rli[16];
#pragma unroll
    for (int r = 0; r < 16; ++r) rli[r] = __builtin_amdgcn_rcpf(li_l[crow(r, hi)]) * (1.0f / (F8_SP * F8_SV));
    bf16_t* Ow = Ob + (long)(wid * QBLK) * LDO;
#pragma unroll
    for (int r = 0; r < 16; ++r) { const int orow = crow(r, hi);
#pragma unroll
        for (int d0 = 0; d0 < 4; ++d0) Ow[(long)orow * LDO + d0 * 32 + r32] = f2bf(o[d0][r] * rli[r]); }
    __syncthreads();
#undef SLOAD
#undef SWRITE
#undef RESC
}
}
#ifndef MK_SPLIT
#define MK_SPLIT 0
#endif
#ifndef PROBE_REPEAT
#define PROBE_REPEAT -1
#endif
constexpr int N_PHASES = 34;
struct Args { const void* in[N_IN]; float* out; unsigned char* ws; };

template <int LO, int HI>
__global__ void __launch_bounds__(512, 2) fwd_kernel(Args args) {
    extern __shared__ __attribute__((aligned(16))) unsigned char lds_raw[];
    Ctx C;
    C.lds = (LAS unsigned char*)lds_raw;
    C.tid = threadIdx.x; C.lane = C.tid & 63; C.wave = __builtin_amdgcn_readfirstlane(C.tid >> 6);
    C.G = gridDim.x; C.gw = blockIdx.x * 8 + C.wave; C.NGW = C.G * 8;
    C.in = args.in; C.out = args.out; C.ws = args.ws;
    volatile LAS unsigned* MISC = (volatile LAS unsigned*)(C.lds + LDS_MISC);
    if (C.tid < 64) MISC[C.tid] = 0u;
    __syncthreads();
    unsigned* barw = (unsigned*)(args.ws + WS_CTL) + CW_BAR;
    XcdBarrier bar; bar.bar = barw; bar.x = 0; bar.st = MISC + 8;
    if (HI - LO > 1) bar = xcd_barrier_post(barw, MISC + 8);
#define IN(k) (LO <= (k) && (k) < HI)
#define PH_BEGIN() do { C.tid = opaque((int)threadIdx.x); C.lane = C.tid & 63; ws = opaque_sptr(args.ws); C.ws = ws; C.out = (float*)opaque_sptr((unsigned char*)args.out); } while (0)
#define SEAM(k) do { if (IN(k) && IN((k) + 1)) xcd_barrier(bar); } while (0)

    unsigned char* ws = args.ws;
    const int bx = blockIdx.x;
#define XB ((bf16_t*)(ws + WS_XB))
#define Zb ((bf16_t*)(ws + WS_Z))
#define Hb ((bf16_t*)(ws + WS_H))
#define wm ((const char*)(ws + WS_WMIX))
#define gatesf ((float*)(ws + WS_SMALL + SM_GATES))
#define W1 ((bf16_t*)(ws + WS_WMOE))
#define W2 (W1 + (size_t)16 * 2048 * 1024)
#define UB ((bf16_t*)C.out)
#define YB ((bf16_t*)C.out + (size_t)NT * DM)

#define PHASE(k) if (IN(k)) for (int rep_ = 0; rep_ < ((k) == PROBE_REPEAT ? 2 : 1); ++rep_)
#define MOE_UP(eg) { pg8::GMoe g{XB, W1, 1024, 1024, 1024, (size_t)2048 * 1024 * 2, (const int*)(ws + WS_SMALL + SM_IDX)}; pg8::OffsetOrder S; S.init(128, 8, C.G, bx); S.pm_off = 128 * (eg); pg8::EpiSwiglu E{Hb}; \
        pg8::gemm_phase<true>(C.lds, g, S, E); }
#define MOE_DOWN(eg) { pg8::GMoeTA g{Hb, W2, 64, 1024, 1024, (size_t)1024 * 1024 * 2}; pg8::OffsetOrder S; S.init(128, 4, C.G, bx); S.pm_off = 128 * (eg); pg8::EpiBf16 E{Zb, 1024}; \
        pg8::gemm_phase(C.lds, g, S, E); }
#if MOE_FP8
#define MOE_PREP(l) prep_moe_weights8(C, l)
#define MOE_BLOCK(base, layer) \
    PHASE((base) + 0) { PH_BEGIN(); topk_select(C); } SEAM((base) + 0); \
    PHASE((base) + 1) { PH_BEGIN(); pg8::GMoe g{(const bf16_t*)(ws + WS_XB8), (const bf16_t*)(ws + WS_WMOE), 512, 512, 512, (size_t)2048 * 1024, (const int*)(ws + WS_SMALL + SM_IDX)}; pg8::EpiSwiglu8 E{(unsigned char*)Hb}; \
        for (int p0 = 0; p0 < 512; p0 += 2 * C.G) { pg8::OffsetOrder S; S.init((512 - p0) < 2 * C.G ? (512 - p0) : 2 * C.G, 8, C.G, bx); S.pm_off = p0; pg8::gemm_phase<true, true>(C.lds, g, S, E); }     \
        } SEAM((base) + 1); \
    PHASE((base) + 2) { PH_BEGIN(); pg8::GMoeTA8 g{(const unsigned char*)Hb, ws + WS_WMOE + (size_t)16 * 2048 * 1024, 64, 512, 512, (size_t)1024 * 1024}; pg8::StaticOrder S; S.init(512, 4, C.G, bx); pg8::EpiFp8S E{(unsigned char*)Zb, 1024, F8_SO / (F8_SH * F8_SW2)}; \
        pg8::gemm_phase<false, true>(C.lds, g, S, E); } SEAM((base) + 2); \
    PHASE((base) + 3) { PH_BEGIN(); moe_combine_ln2<(layer) == 3>(C, layer); if ((layer) < 3) MOE_PREP((layer) + 1); } SEAM((base) + 3);
#else
#define MOE_PREP(l) prep_moe_weights(C, l)
#define MOE_BLOCK(base, layer) \
    PHASE((base) + 0) { PH_BEGIN(); topk_select(C); } SEAM((base) + 0); \
    PHASE((base) + 1) { PH_BEGIN(); touch_region(C, XB, (size_t)NT * DM * 2); pg8::GMoe g{XB, W1, 1024, 1024, 1024, (size_t)2048 * 1024 * 2, (const int*)(ws + WS_SMALL + SM_IDX)}; pg8::StaticOrder S; S.init(512, 8, C.G, bx); pg8::EpiSwiglu E{Hb}; \
        pg8::gemm_phase<true>(C.lds, g, S, E); } SEAM((base) + 1); \
    PHASE((base) + 2) { PH_BEGIN(); touch_region(C, Hb, (size_t)NSEL * 1024 * 2 * 3 / 4); pg8::GMoeTA g{Hb, W2, 64, 1024, 1024, (size_t)1024 * 1024 * 2}; pg8::StaticOrder S; S.init(512, 4, C.G, bx); pg8::EpiBf16 E{Zb, 1024}; \
        pg8::gemm_phase(C.lds, g, S, E); } SEAM((base) + 2); \
    PHASE((base) + 3) { PH_BEGIN(); moe_combine_ln2<(layer) == 3>(C, layer); if ((layer) < 3) MOE_PREP((layer) + 1); } SEAM((base) + 3);

#endif

#define OUT_LN1(Aop, Wofs, layer) { pg8::GPlain g{Aop, (const bf16_t*)(wm + (Wofs)), 1024, 1024, 1024}; pg8::PanelOrder S; S.init(256, 4, C.G, bx); \
        pg8::EpiOutB E{XB, YB, 1.0f}; pg8::gemm_phase(C.lds, g, S, E); VM_WAIT(); __syncthreads(); \
        for (int pnl = bx; pnl < 256; pnl += C.G) ln1_router(C, layer, YB, pnl * 256 + C.wave, 8, 32); }
#define OUT_LN1_F8(Aop8, Wofs, layer) { pg8::GPlain g{(const bf16_t*)(Aop8), (const bf16_t*)(wm + (Wofs)), 512, 512, 512}; pg8::PanelOrder S; S.init(256, 4, C.G, bx); \
        pg8::EpiOutB E{XB, YB, 1.0f / (F8_SU * F8_SWO)}; pg8::gemm_phase<false, true>(C.lds, g, S, E); VM_WAIT(); __syncthreads(); \
        for (int pnl = bx; pnl < 256; pnl += C.G) ln1_router(C, layer, YB, pnl * 256 + C.wave, 8, 32); }
#if OUT_FP8
#define OUT_LN1_X(Aop, Wofs, layer) OUT_LN1_F8(Aop, Wofs, layer)
#else
#define OUT_LN1_X(Aop, Wofs, layer) OUT_LN1(Aop, Wofs, layer)
#endif

    PHASE(0) { PH_BEGIN(); prep_mixer_weights(C); prep_xb(C); prep_rope(C); MOE_PREP(0); }
    SEAM(0);

    PHASE(1) { PH_BEGIN(); pg8::StaticOrder S; S.init(256, 13, C.G, bx);
        if (INP_FP8) { pg8::GPlain g{(const bf16_t*)(ws + WS_XB8), (const bf16_t*)(wm + WM_ML_IN), 512, 512, 512}; pg8::EpiIn E{Zb, 3072, 12, 2, 0.08838834764831845f, 0, 0, gatesf, 16, IN_F(I_ML_GB), 1.0f / F8_SWI}; pg8::gemm_phase<false, true>(C.lds, g, S, E); }
        else { pg8::GPlain g{XB, (const bf16_t*)(wm + WM_ML_IN), 1024, 1024, 1024}; pg8::EpiIn E{Zb, 3072, 12, 2, 0.08838834764831845f, 0, 0, gatesf, 16, IN_F(I_ML_GB)}; pg8::gemm_phase(C.lds, g, S, E); } }
    SEAM(1);
    PHASE(2) { PH_BEGIN(); mlstm_chain(C); }
    SEAM(2);
    PHASE(3) { PH_BEGIN(); }
    PHASE(4) { PH_BEGIN();
        for (int pnl = bx; pnl < 256; pnl += C.G) headnorm_gate<0>(C, Zb + 2048, 3072, Hb, Hb + (size_t)NT * DM, IN_F(I_ML_NG), UB, pnl * 256 + C.wave, 8, 32);
        VM_WAIT(); __syncthreads(); OUT_LN1_X(UB, WM_ML_OUT, 0) }
    SEAM(4);
    MOE_BLOCK(5, 0)

    PHASE(9) { PH_BEGIN(); pg8::StaticOrder S; S.init(256, 13, C.G, bx);
        if (INP_FP8) { pg8::GPlain g{(const bf16_t*)(ws + WS_XB8), (const bf16_t*)(wm + WM_GL_IN), 512, 512, 512}; pg8::EpiIn E{Zb, 3072, 12, 2, 0.08838834764831845f, 0, 0, gatesf, 32, nullptr, 1.0f / F8_SWI}; pg8::gemm_phase<false, true>(C.lds, g, S, E); }
        else { pg8::GPlain g{XB, (const bf16_t*)(wm + WM_GL_IN), 1024, 1024, 1024}; pg8::EpiIn E{Zb, 3072, 12, 2, 0.08838834764831845f, 0, 0, gatesf, 32, nullptr}; pg8::gemm_phase(C.lds, g, S, E); } }
    SEAM(9);
    PHASE(10) { PH_BEGIN(); gla_chain(C); }
    SEAM(10);
    PHASE(11) { PH_BEGIN(); }
    PHASE(12) { PH_BEGIN();
        for (int pnl = bx; pnl < 256; pnl += C.G) headnorm_gate<1>(C, Zb + 2048, 3072, Hb, Hb + (size_t)NT * DM, IN_F(I_GL_NG), UB, pnl * 256 + C.wave, 8, 32);
        VM_WAIT(); __syncthreads(); OUT_LN1_X(UB, WM_GL_OUT, 1) }
    SEAM(12);
    MOE_BLOCK(13, 1)

#define GB Zb
#define UR (Zb + (size_t)NT * DM)
#define UC (Zb + (size_t)2 * NT * DM)
    PHASE(17) { PH_BEGIN(); pg8::GPlain g{XB, (const bf16_t*)(wm + WM_LR_IN), 1024, 1024, 1024}; pg8::StaticOrder S; S.init(256, 8, C.G, bx);
        pg8::EpiIn E{Zb, 1024, 8, 0, 1.f, 1024, (size_t)NT * DM, nullptr, 0, nullptr};
        pg8::gemm_phase(C.lds, g, S, E); }
    SEAM(17);
    PHASE(18) { PH_BEGIN(); lru_conv(C, UR, UC); }
    SEAM(18);
    PHASE(19) { PH_BEGIN(); pg8::GLruGate g{UC, (const bf16_t*)(wm + WM_LR_G), 1024, 256, 256}; pg8::StaticOrder S; S.init(256, 16, C.G, bx);
        pg8::EpiLruGate E{UC, IN_F(I_LR_GAB), IN_F(I_LR_GXB), IN_F(I_LR_LAM), Hb, Hb + (size_t)NT * DM, UB, UR};
        pg8::gemm_phase(C.lds, g, S, E); }
    SEAM(19);
    PHASE(20) { PH_BEGIN(); lru_scan(C, Hb, (const unsigned char*)(Hb + (size_t)NT * DM), UB, (const unsigned char*)UR, GB, UC); }
    SEAM(20);
    PHASE(21) { PH_BEGIN(); if (OUT_FP8) OUT_LN1_F8(UC, WM_LR_OUT, 2) else OUT_LN1(GB, WM_LR_OUT, 2) }
    SEAM(21);
    MOE_BLOCK(22, 2)

#define Zm (Hb + (size_t)NT * DM)
#define CQN UB
#define CKVN (UB + (size_t)NT * 384)
#define Qm Zb
#define Km (Zb + (size_t)NT * 1536)
#define Vm Hb
#define Om (Hb + (size_t)NT * DM)
    PHASE(26) { PH_BEGIN(); pg8::GPlain g{XB, (const bf16_t*)(wm + WM_MA_IN), 1024, 1024, 1024}; pg8::PanelOrder S; S.init(256, 3, C.G, bx);
        pg8::EpiIn E{Zm, 768, 3, 0, 1.f, 0, 0, nullptr, 0, nullptr};
        pg8::gemm_phase(C.lds, g, S, E); VM_WAIT(); __syncthreads();
        for (int pnl = bx; pnl < 256; pnl += C.G) mla_norm_rope(C, Zm, CQN, CKVN, Km, pnl * 256 + C.wave, 8, 32); }
    SEAM(26);
    PHASE(27) {  PH_BEGIN();
        { pg8::GPlain g{CQN, (const bf16_t*)(wm + WM_MA_UQ), 384, 384, 384}; pg8::StaticOrder S; S.init(256, 6, C.G, bx);
          pg8::EpiMlaQ E{Qm, (const float*)(ws + WS_ROPE), (const float*)(ws + WS_ROPE) + (size_t)NT * 32}; pg8::gemm_phase(C.lds, g, S, E); }
        { pg8::GPlain g{CKVN, (const bf16_t*)(wm + WM_MA_UKV), 256, 256, 256}; pg8::StaticOrder S; S.init(256, 8, C.G, bx);
          pg8::EpiMlaKV E{Km, Vm}; pg8::gemm_phase(C.lds, g, S, E); }
    }
    SEAM(27);
    PHASE(28) { PH_BEGIN();
        for (int unit = bx; unit < NB * 8 * 8; unit += C.G) { const int bh = unit >> 3, qb = unit & 7, b = bh >> 3, h = bh & 7;
            if (ATT_FP8 && ATT_PV8) attn::attn_unit88((const unsigned char*)Qm + ((size_t)(b * SEQ + qb * 256) * 8 + h) * 192, (const unsigned char*)Km + (size_t)bh * SEQ * 192, (const unsigned char*)Vm + (size_t)bh * 128 * SEQ, Om + (size_t)(b * SEQ + qb * 256) * DM + h * 128, C.lds);
            else if (ATT_FP8) attn::attn_unit8((const unsigned char*)Qm + ((size_t)(b * SEQ + qb * 256) * 8 + h) * 192, (const unsigned char*)Km + (size_t)bh * SEQ * 192, Vm + (size_t)bh * SEQ * 128, Om + (size_t)(b * SEQ + qb * 256) * DM + h * 128, C.lds);
            else attn::attn_unit(Qm + ((size_t)(b * SEQ + qb * 256) * 8 + h) * 192, Km + (size_t)bh * SEQ * 192, Vm + (size_t)bh * SEQ * 128, Om + (size_t)(b * SEQ + qb * 256) * DM + h * 128, C.lds); }
    }
    SEAM(28);
    PHASE(29) { PH_BEGIN(); OUT_LN1(Om, WM_MA_OUT, 3) }
    SEAM(29);
    MOE_BLOCK(30, 3)
#undef OUT_LN1
#undef OUT_LN1_F8
#undef OUT_LN1_X
#undef IN
#undef SEAM
#undef MOE_BLOCK
#undef MOE_UP
#undef MOE_DOWN
#undef PHASE
#undef XB
#undef Zb
#undef Hb
#undef wm
#undef gatesf
#undef W1
#undef W2
#undef UB
#undef YB
#undef GB
#undef UR
#undef UC
#undef Zm
#undef CQN
#undef CKVN
#undef Qm
#undef Km
#undef Vm
#undef Om
}

template <int P> struct SplitLaunch {
    static bool setup() { return hipFuncSetAttribute((const void*)fwd_kernel<P, P + 1>, hipFuncAttributeMaxDynamicSharedMemorySize, LDS_BYTES) == hipSuccess && SplitLaunch<P + 1>::setup(); }
    static void run(int grid, hipStream_t stream, const Args& a) { hipLaunchKernelGGL((fwd_kernel<P, P + 1>), dim3(grid), dim3(512), LDS_BYTES, stream, a); SplitLaunch<P + 1>::run(grid, stream, a); }
};
template <> struct SplitLaunch<N_PHASES> { static bool setup() { return true; } static void run(int, hipStream_t, const Args&) {} };

extern "C" void kernel_launch(void* const* d_in, const int* in_sizes, int n_in, void* d_out, int out_size, void* d_ws, size_t ws_size, hipStream_t stream) {
    static int grid = 0;
    if (grid == 0) {
        if (n_in != N_IN || out_size != NT * DM || ws_size < WS_END) { fprintf(stderr, "kernel_launch: unexpected shapes (n_in %d, out %d, ws %zu)\n", n_in, out_size, ws_size); grid = -1; return; }
        int dev = 0, cus = 0, per_cu = 0;
        if (hipGetDevice(&dev) != hipSuccess || hipDeviceGetAttribute(&cus, hipDeviceAttributeMultiprocessorCount, dev) != hipSuccess) { grid = -1; return; }
#if MK_SPLIT
        if (!SplitLaunch<0>::setup()) { fprintf(stderr, "kernel_launch: hipFuncSetAttribute failed\n"); grid = -1; return; }
#else
        if (hipFuncSetAttribute((const void*)fwd_kernel<0, N_PHASES>, hipFuncAttributeMaxDynamicSharedMemorySize, LDS_BYTES) != hipSuccess) { fprintf(stderr, "kernel_launch: hipFuncSetAttribute failed\n"); grid = -1; return; }
        if (hipOccupancyMaxActiveBlocksPerMultiprocessor(&per_cu, (const void*)fwd_kernel<0, N_PHASES>, 512, LDS_BYTES) != hipSuccess || per_cu < 1) { fprintf(stderr, "kernel_launch: occupancy query says %d\n", per_cu); }
#endif
        (void)hipGetLastError();
        grid = cus;
    }
    if (grid < 0) return;
    (void)hipMemsetAsync((char*)d_ws + WS_CTL, 0, CTL_BYTES, stream);
    Args a{};
    for (int i = 0; i < N_IN; ++i) a.in[i] = d_in[i];
    a.out = (float*)d_out; a.ws = (unsigned char*)d_ws;
#if MK_SPLIT
    SplitLaunch<0>::run(grid, stream, a);
#else
    hipLaunchKernelGGL((fwd_kernel<0, N_PHASES>), dim3(grid), dim3(512), LDS_BYTES, stream, a);
#endif
    const hipError_t le = hipPeekAtLastError();
    if (le != hipSuccess) fprintf(stderr, "kernel_launch: launch failed: %s\n", hipGetErrorName(le));
}
```

```cpp
#include <hip/hip_runtime.h>
#include <cstdio>
#include <cstdint>
#include <type_traits>

#define GAS __attribute__((address_space(1)))
#define LAS __attribute__((address_space(3)))
typedef unsigned short bf16_t;
typedef short bf16x8 __attribute__((ext_vector_type(8)));
typedef short s16x4 __attribute__((ext_vector_type(4)));
typedef float f32x2 __attribute__((ext_vector_type(2)));
typedef float f32x4 __attribute__((ext_vector_type(4)));
typedef float f32x16 __attribute__((ext_vector_type(16)));
typedef unsigned u32x2 __attribute__((ext_vector_type(2)));
typedef unsigned u32x4 __attribute__((ext_vector_type(4)));

constexpr int NB = 32, SEQ = 2048, DM = 1024, NT = NB * SEQ;
constexpr float ALPHA = 1.6817928305074290f;
constexpr float LN_EPS = 1e-5f;
constexpr int NEXP = 16, CAP = 256, NSEL = NB * NEXP * CAP;

constexpr size_t MiB = 1u << 20;
constexpr size_t WS_CTL = 0, CTL_BYTES = 1 * MiB;
constexpr size_t WS_WMIX = 1 * MiB;
constexpr size_t WS_ROPE = 33 * MiB;
constexpr size_t WS_SMALL = 49 * MiB;
constexpr size_t WS_WMOE = 65 * MiB;
constexpr size_t WS_XB = 161 * MiB;
constexpr size_t WS_Z = 289 * MiB;
constexpr size_t WS_H = 673 * MiB;
constexpr size_t WS_XB8 = 929 * MiB;
constexpr size_t WS_END = 993 * MiB;
constexpr size_t WM_ML_IN = 0;
constexpr size_t WM_ML_OUT = WM_ML_IN + (size_t)3328 * 1024 * 2;
constexpr size_t WM_GL_IN = WM_ML_OUT + (size_t)1024 * 1024 * 2;
constexpr size_t WM_GL_OUT = WM_GL_IN + (size_t)3328 * 1024 * 2;
constexpr size_t WM_LR_IN = WM_GL_OUT + (size_t)1024 * 1024 * 2;
constexpr size_t WM_LR_G = WM_LR_IN + (size_t)2048 * 1024 * 2;
constexpr size_t WM_LR_OUT = WM_LR_G + (size_t)4096 * 256 * 2;
constexpr size_t WM_MA_IN = WM_LR_OUT + (size_t)1024 * 1024 * 2;
constexpr size_t WM_MA_UQ = WM_MA_IN + (size_t)768 * 1024 * 2;
constexpr size_t WM_MA_UKV = WM_MA_UQ + (size_t)1536 * 384 * 2;
constexpr size_t WM_MA_OUT = WM_MA_UKV + (size_t)2048 * 256 * 2;
constexpr size_t WM_END = WM_MA_OUT + (size_t)1024 * 1024 * 2;
static_assert(WM_END <= 32 * MiB, "mixer weights fit");
constexpr size_t SM_GATES = 0;
constexpr size_t SM_AFF = 8 * MiB;
constexpr size_t SM_IDX = 12 * MiB;
constexpr size_t SM_INV = 13 * MiB;
constexpr int CW_BAR = 4096;

constexpr int LDS_MISC = 131072 + 16384;
constexpr int LDS_BYTES = 131072 + 16384 + 1024;

#define LDS_WAIT() asm volatile("s_waitcnt lgkmcnt(0)" ::: "memory")
#define VM_WAIT() asm volatile("s_waitcnt vmcnt(0)" ::: "memory")
typedef __bf16 bf16x2_t __attribute__((ext_vector_type(2)));
__device__ __forceinline__ unsigned cvt_pk_bf16(float lo, float hi) { bf16x2_t v = {(__bf16)lo, (__bf16)hi}; return __builtin_bit_cast(unsigned, v); }
__device__ __forceinline__ float bf_lo(unsigned w) { return __uint_as_float(w << 16); }
__device__ __forceinline__ float bf_hi(unsigned w) { return __uint_as_float(w & 0xffff0000u); }
__device__ __forceinline__ float bf2f(bf16_t b) { return __uint_as_float(((unsigned)b) << 16); }
__device__ __forceinline__ bf16_t f2bf(float f) { return (bf16_t)(cvt_pk_bf16(f, 0.f) & 0xffffu); }
__device__ __forceinline__ int opaque(int x) { asm volatile("" : "+v"(x)); return x; }
__device__ __forceinline__ unsigned char* opaque_sptr(unsigned char* p) {
    unsigned lo = __builtin_amdgcn_readfirstlane((unsigned)(uintptr_t)p), hi = __builtin_amdgcn_readfirstlane((unsigned)((uintptr_t)p >> 32));
    asm volatile("" : "+s"(lo), "+s"(hi));
    return (unsigned char*)(((uintptr_t)hi << 32) | (uintptr_t)lo);
}
template <int CTRL> __device__ __forceinline__ float dpp_f(float v) { return __int_as_float(__builtin_amdgcn_update_dpp(0, __float_as_int(v), CTRL, 0xF, 0xF, true)); }
__device__ __forceinline__ float rdlane_f(float v, int l) { return __int_as_float(__builtin_amdgcn_readlane(__float_as_int(v), l)); }
__device__ __forceinline__ float wave_sum(float v) {
    v += dpp_f<0xB1>(v); v += dpp_f<0x4E>(v); v += dpp_f<0x141>(v); v += dpp_f<0x140>(v);
    return (rdlane_f(v, 0) + rdlane_f(v, 16)) + (rdlane_f(v, 32) + rdlane_f(v, 48));
}
__device__ __forceinline__ float wave_max(float v) {
    v = fmaxf(v, dpp_f<0xB1>(v)); v = fmaxf(v, dpp_f<0x4E>(v)); v = fmaxf(v, dpp_f<0x141>(v)); v = fmaxf(v, dpp_f<0x140>(v));
    return fmaxf(fmaxf(rdlane_f(v, 0), rdlane_f(v, 16)), fmaxf(rdlane_f(v, 32), rdlane_f(v, 48)));
}
__device__ __forceinline__ float sigmoidf_(float x) { return __builtin_amdgcn_rcpf(1.0f + __expf(-x)); }
__device__ __forceinline__ float sigmoid_fast(float x) { return __builtin_amdgcn_rcpf(1.0f + __expf(-x)); }
__device__ __forceinline__ float one_minus_exp(float x) { const float ser = -x * (1.0f + x * (0.5f + x * (0.16666667f + x * 0.041666668f))); const float dir = 1.0f - __expf(x); return x > -0.125f ? ser : dir; }
__device__ __forceinline__ float logsigmoidf_(float x) { return fminf(x, 0.f) - log1pf(__expf(-fabsf(x))); }
__device__ __forceinline__ float logsigmoid_fast(float x) { return fminf(x, 0.f) - __logf(1.0f + __expf(-fabsf(x))); }
__device__ __forceinline__ float gelu_tanh(float x) { const float u = 0.7978845608028654f * (x + 0.044715f * x * x * x); const float t = 1.0f - 2.0f * __builtin_amdgcn_rcpf(__expf(2.0f * u) + 1.0f); return 0.5f * x * (1.0f + t); }
__device__ __forceinline__ float siluf_(float x) { return x * __builtin_amdgcn_rcpf(1.0f + __expf(-x)); }

typedef int i32x8 __attribute__((ext_vector_type(8)));
typedef int i32x4 __attribute__((ext_vector_type(4)));
constexpr float F8_SG = 32.0f;
constexpr float F8_SP = 256.0f, F8_SV = 8.0f;
constexpr float F8_SWI = 64.0f;
constexpr float F8_SU = 16.0f, F8_SWO = 128.0f;
constexpr float F8_SW1 = 64.0f, F8_SW2 = 128.0f, F8_SH = 8.0f, F8_SO = 32.0f;
__device__ __forceinline__ float f8clamp(float x) { return fminf(fmaxf(x, -416.0f), 416.0f); }
__device__ __forceinline__ unsigned pk4_fp8(float a, float b, float c, float d) {
    unsigned w = 0u; w = (unsigned)__builtin_amdgcn_cvt_pk_fp8_f32(f8clamp(a), f8clamp(b), (int)w, false); w = (unsigned)__builtin_amdgcn_cvt_pk_fp8_f32(f8clamp(c), f8clamp(d), (int)w, true); return w; }
__device__ __forceinline__ f32x4 unpk4_fp8(unsigned w) { const f32x2 lo = __builtin_amdgcn_cvt_pk_f32_fp8((int)w, false), hi = __builtin_amdgcn_cvt_pk_f32_fp8((int)w, true); return (f32x4){lo[0], lo[1], hi[0], hi[1]}; }
#define XB_TMO      128
#define XB_XCNT(j)  (256  + 64 * (j))
#define XB_XSUB(j)  (1280 + 64 * (j))
#define XB_XGEN(j)  (2304 + 64 * (j))
#define XB_TOP      3328
#define XB_TOPGEN   3392
#define XCD_BAR_WORDS 3456
#define XB_SPIN_CAP (1u << 20)

__device__ __forceinline__ unsigned xb_ld(unsigned* p)              { return __hip_atomic_load(p, __ATOMIC_RELAXED, __HIP_MEMORY_SCOPE_AGENT); }
__device__ __forceinline__ unsigned xb_add(unsigned* p, unsigned v) { return __hip_atomic_fetch_add(p, v, __ATOMIC_RELAXED, __HIP_MEMORY_SCOPE_AGENT); }
__device__ __forceinline__ unsigned xb_xcc_id() { return (unsigned)__builtin_amdgcn_s_getreg((3 << 11) | 20) & 0xFu; }
#define XB_SPIN(cond, bar) do { unsigned _sp = 0; while (cond) { __builtin_amdgcn_s_sleep(1); \
    if ((++_sp & 255u) == 0u) { if (xb_ld(&(bar)[XB_TMO])) break; if (_sp > XB_SPIN_CAP) { atomicAdd(&(bar)[XB_TMO], 1u); break; } } } } while (0)

struct XcdBarrier { unsigned* bar; unsigned x; volatile LAS unsigned* st; };

__device__ __forceinline__ XcdBarrier xcd_barrier_post(unsigned* bar, volatile LAS unsigned* st) {
    XcdBarrier b; b.bar = bar; b.x = xb_xcc_id(); b.st = st;
    if (threadIdx.x == 0) (void)xb_add(&bar[XB_XCNT(b.x)], 1u);
    return b;
}
__device__ __forceinline__ void xcd_barrier_complete(unsigned* bar, unsigned x, unsigned& nloc, unsigned& nx) {
    const unsigned G = gridDim.x * gridDim.y * gridDim.z;
    unsigned sum, cnt, mine, sp = 0u;
    for (;;) {
        sum = 0u; cnt = 0u; mine = 0u;
#pragma unroll
        for (unsigned j = 0; j < 16; ++j) { const unsigned c = xb_ld(&bar[XB_XCNT(j)]); sum += c; cnt += (c > 0u) ? 1u : 0u; mine = (j == x) ? c : mine; }
        if (sum == G) break;
        __builtin_amdgcn_s_sleep(1);
        if ((++sp & 255u) == 0u) { if (xb_ld(&bar[XB_TMO])) break; if (sp > XB_SPIN_CAP) { atomicAdd(&bar[XB_TMO], 1u); break; } }
    }
    nloc = mine > 0u ? mine : 1u; nx = cnt > 0u ? cnt : 1u;
}
__device__ __forceinline__ void xcd_barrier(const XcdBarrier& b) {
    asm volatile("s_waitcnt vmcnt(0)" ::: "memory");
    __syncthreads();
    if (threadIdx.x == 0) {
        unsigned* bar = b.bar;
        __builtin_amdgcn_s_waitcnt(0);
        unsigned nloc = b.st[0], nx = b.st[1];
        if (nloc == 0u) { xcd_barrier_complete(bar, b.x, nloc, nx); b.st[0] = nloc; b.st[1] = nx; }
        const unsigned old = xb_add(&bar[XB_XSUB(b.x)], 1u);
        const unsigned gen = old / nloc;
        if (old + 1u == (gen + 1u) * nloc) {
            __builtin_amdgcn_fence(__ATOMIC_RELEASE, "agent");
            asm volatile("s_waitcnt vmcnt(0)" ::: "memory");
            const unsigned og = xb_add(&bar[XB_TOP], 1u);
            const unsigned tg = og / nx;
            if (og + 1u == (tg + 1u) * nx) xb_add(&bar[XB_TOPGEN], 1u);
            else XB_SPIN(xb_ld(&bar[XB_TOPGEN]) == tg, bar);
            __builtin_amdgcn_fence(__ATOMIC_ACQUIRE, "agent");
            xb_add(&bar[XB_XGEN(b.x)], 1u);
            asm volatile("s_waitcnt vmcnt(0)" ::: "memory");
        } else {
            XB_SPIN(xb_ld(&bar[XB_XGEN(b.x)]) == gen, bar);
            __builtin_amdgcn_fence(__ATOMIC_ACQUIRE, "agent");
            asm volatile("s_waitcnt vmcnt(0)" ::: "memory");
        }
    }
    __syncthreads();
}
namespace pg8 {
constexpr int BM = 256, BK = 64, HALF = 128, HTB = HALF * BK * 2, STAGE_BYTES = 8 * HTB, NXCD = 8, WGM = 8;
__host__ __device__ __forceinline__ int lds_byte(int r, int c) { const int st = (r >> 4) * 2 + (c >> 5), rr = r & 15, cc = c & 31, ob = rr * 64 + cc * 2; return st * 1024 + (ob ^ (((ob >> 9) & 1) << 5)); }
__host__ __device__ __forceinline__ void stage_rc(int b, int& R, int& C) { const int st = b / 1024, sb = b % 1024, swz = sb ^ (((sb >> 9) & 1) << 5); R = (st >> 1) * 16 + swz / 64; C = (st & 1) * 32 + (swz % 64) / 2; }
__host__ __device__ __forceinline__ int perm32(int rho) { const int n = rho >> 4, i = rho & 15; return 8 * (i >> 2) + 4 * n + (i & 3); }

struct Unit { int pm, pn; };
struct StaticOrder {
    int nM, nN, nwg, G, c;
    __device__ void init(int nM_, int nN_, int G_, int c_) { nM = nM_; nN = nN_; nwg = nM * nN; G = G_; c = c_; }
    __device__ bool next(int i, Unit& u) const {
        const long L = (long)i * G + c; if (L >= nwg) return false;
        int wgid = (int)L; { const int q = nwg / NXCD, r = nwg % NXCD, xcd = wgid % NXCD, off = wgid / NXCD; wgid = (xcd < r ? xcd * (q + 1) : r * (q + 1) + (xcd - r) * q) + off; }
        const int nig = WGM * nN, gid = wgid / nig, fm = gid * WGM, gsz = (nM - fm) < WGM ? (nM - fm) : WGM;
        u.pm = fm + ((wgid % nig) % gsz); u.pn = (wgid % nig) / gsz; return true;
    }
};
struct OffsetOrder : StaticOrder { int pm_off;
    __device__ bool next(int i, Unit& u) const { if (!StaticOrder::next(i, u)) return false; u.pm += pm_off; return true; } };
struct PanelOrder { int nM, nN, G, c;
    __device__ void init(int nM_, int nN_, int G_, int c_) { nM = nM_; nN = nN_; G = G_; c = c_; }
    __device__ bool next(int i, Unit& u) const { const int p = c + (i / nN) * G; if (p >= nM) return false; u.pm = p; u.pn = i % nN; return true; } };
struct GPlain { const bf16_t* A; const bf16_t* Bt; int lda, ldb, K;
    __device__ __forceinline__ size_t kstep_a() const { return 128; }
    __device__ __forceinline__ const char* a(const Unit& u) const { return (const char*)A + (size_t)u.pm * BM * lda * 2; }
    __device__ __forceinline__ const char* b(const Unit& u) const { return (const char*)Bt + (size_t)u.pn * BM * ldb * 2; } };
struct GMoe { const bf16_t* A; const bf16_t* Bt; int lda, ldb, K; size_t estride;
    const int* rowtok;
    __device__ __forceinline__ size_t kstep_a() const { return 128; }
    __device__ __forceinline__ const char* a(const Unit& u) const { return (const char*)A + (size_t)u.pm * BM * lda * 2; }
    __device__ __forceinline__ const char* b(const Unit& u) const { return (const char*)Bt + (size_t)(u.pm >> 5) * estride + (size_t)u.pn * BM * ldb * 2; } };
struct GMoeTA { const bf16_t* A; const bf16_t* Bt; int lda, ldb, K; size_t estride;
    __device__ __forceinline__ size_t kstep_a() const { return 32768; }
    __device__ __forceinline__ const char* a(const Unit& u) const { return (const char*)A + (size_t)u.pm * 524288; }
    __device__ __forceinline__ const char* b(const Unit& u) const { return (const char*)Bt + (size_t)(u.pm >> 5) * estride + (size_t)u.pn * BM * ldb * 2; } };
struct GMoeTA8 { const unsigned char* A; const unsigned char* Bt; int lda, ldb, K; size_t estride;
    __device__ __forceinline__ size_t kstep_a() const { return 32768; }
    __device__ __forceinline__ const char* a(const Unit& u) const { return (const char*)A + (size_t)u.pm * 262144; }
    __device__ __forceinline__ const char* b(const Unit& u) const { return (const char*)Bt + (size_t)(u.pm >> 5) * estride + (size_t)u.pn * BM * ldb * 2; } };
struct GLruGate { const bf16_t* A; const bf16_t* Bt; int lda, ldb, K;
    __device__ __forceinline__ size_t kstep_a() const { return 128; }
    __device__ __forceinline__ const char* a(const Unit& u) const { return (const char*)A + (size_t)u.pm * BM * lda * 2 + (size_t)((u.pn >> 1) & 3) * 512; }
    __device__ __forceinline__ const char* b(const Unit& u) const { return (const char*)Bt + (size_t)u.pn * BM * ldb * 2; } };

template <class E, class = void> struct SwapB1 : std::false_type {};
template <class E> struct SwapB1<E, std::void_t<decltype(E::SWAPB1)>> : std::bool_constant<E::SWAPB1> {};
template <bool GATHER = false, bool FP8 = false, class Epi, class GD, class Sched>
__device__ __forceinline__ void gemm_phase(LAS unsigned char* lds, const GD g, const Sched& S, const Epi& E) {
    const int tid = opaque((int)threadIdx.x), wid = __builtin_amdgcn_readfirstlane(tid >> 6), lane = tid & 63, wr = wid >> 2, wc = wid & 3, fr = lane & 15, fq = lane >> 4;
    const int K = g.K, nt = K / BK;
    unsigned voffA[2], voffB[2]; int RA[2];
#pragma unroll
    for (int i = 0; i < 2; ++i) { int R, C; stage_rc(tid * 16 + i * 8192, R, C); const int Rb = Epi::PERM ? ((R & ~31) + perm32(R & 31)) : R;
        RA[i] = R; voffA[i] = GATHER ? (unsigned)C * 2u : (unsigned)(R * g.lda + C) * 2u; voffB[i] = (unsigned)(Rb * g.ldb + C) * 2u; }
    LAS unsigned* IDX = (LAS unsigned*)(lds + STAGE_BYTES);
    unsigned vA[2][2] = {{0u, 0u}, {0u, 0u}}, nvA[2][2] = {{0u, 0u}, {0u, 0u}};
    if constexpr (GATHER) {
        for (int i = 0; i < 16; ++i) { Unit uu; if (!S.next(i, uu)) break; if (tid < 256) IDX[i * 256 + tid] = (unsigned)g.rowtok[uu.pm * 256 + tid] * (unsigned)(g.lda * 2); }
        __syncthreads();
#pragma unroll
        for (int h = 0; h < 2; ++h)
#pragma unroll
            for (int i = 0; i < 2; ++i) vA[h][i] = IDX[h * HALF + RA[i]] + voffA[i];
    }
    const size_t kstep = (size_t)(BK * 2);
    const size_t kstepA = g.kstep_a();
    const size_t hstepA = (size_t)HALF * g.lda * 2, hstepB = (size_t)HALF * g.ldb * 2;
    const unsigned ldsw = (unsigned)wid * 1024u;
    const int aoff = lds_byte(wr * 64 + fr, fq * 8), boff = lds_byte(wc * 32 + fr, fq * 8);
#define PG8_SA(b, h) (((b) * 2 + (h)) * HTB)
#define PG8_SB(b, h) ((4 + (b) * 2 + (h)) * HTB)
#define PG8_STAGE(bufoff, gbase, voff) do { _Pragma("unroll") for (int _i = 0; _i < 2; ++_i) \
        __builtin_amdgcn_global_load_lds((const unsigned*)((const char*)(gbase) + (voff)[_i]), (LAS unsigned*)(lds + (bufoff) + ldsw + _i * 8192), 16, 0, 0); } while (0)
#define PG8_STAGE_GA(bufoff, gbase, VA) do { _Pragma("unroll") for (int _i = 0; _i < 2; ++_i) \
        __builtin_amdgcn_global_load_lds((const unsigned*)((const char*)(gbase) + (VA)[_i]), (LAS unsigned*)(lds + (bufoff) + ldsw + _i * 8192), 16, 0, 0); } while (0)
#define PG8_STAGE_A(bufoff, gbase, h, VA) do { if constexpr (GATHER) PG8_STAGE_GA(bufoff, gbase, (VA)[h]); else PG8_STAGE(bufoff, (gbase) + (h) * hstepA, voffA); } while (0)
#define PG8_LDA(dst, b, h) do { if constexpr (FP8) { _Pragma("unroll") for (int m = 0; m < 4; ++m) { const i32x4 _lo = *(const LAS i32x4*)(lds + PG8_SA(b, h) + aoff + m * 2048), _hi = *(const LAS i32x4*)(lds + PG8_SA(b, h) + aoff + m * 2048 + 1024); \
            dst##8[m] = __builtin_shufflevector(_lo, _hi, 0, 1, 2, 3, 4, 5, 6, 7); } } \
        else { _Pragma("unroll") for (int m = 0; m < 4; ++m) _Pragma("unroll") for (int k = 0; k < 2; ++k) dst[m][k] = *(const LAS bf16x8*)(lds + PG8_SA(b, h) + aoff + m * 2048 + k * 1024); } } while (0)
#define PG8_LDB(dst, b, h) do { if constexpr (FP8) { _Pragma("unroll") for (int n = 0; n < 2; ++n) { const i32x4 _lo = *(const LAS i32x4*)(lds + PG8_SB(b, h) + boff + n * 2048), _hi = *(const LAS i32x4*)(lds + PG8_SB(b, h) + boff + n * 2048 + 1024); \
            dst##8[n] = __builtin_shufflevector(_lo, _hi, 0, 1, 2, 3, 4, 5, 6, 7); } } \
        else { _Pragma("unroll") for (int n = 0; n < 2; ++n) _Pragma("unroll") for (int k = 0; k < 2; ++k) dst[n][k] = *(const LAS bf16x8*)(lds + PG8_SB(b, h) + boff + n * 2048 + k * 1024); } } while (0)
#define PG8_MMA(ai, bj, At, Bt) do { __builtin_amdgcn_s_setprio(1); \
        if constexpr (FP8) { _Pragma("unroll") for (int m = 0; m < 4; ++m) _Pragma("unroll") for (int n = 0; n < 2; ++n) \
            asm volatile("v_mfma_scale_f32_16x16x128_f8f6f4 %0, %1, %2, %0, %3, %3 op_sel_hi:[0,0,0]" : "+v"(acc[ai][bj][m][n]) : "v"(Bt##8[n]), "v"(At##8[m]), "v"(f8scale)); } \
        else if constexpr (SwapB1<Epi>::value && (bj) == 1) { _Pragma("unroll") for (int m = 0; m < 4; ++m) _Pragma("unroll") for (int n = 0; n < 2; ++n) _Pragma("unroll") for (int k = 0; k < 2; ++k) \
            acc[ai][bj][m][n] = __builtin_amdgcn_mfma_f32_16x16x32_bf16(At[m][k], Bt[n][k], acc[ai][bj][m][n], 0, 0, 0); } \
        else { _Pragma("unroll") for (int m = 0; m < 4; ++m) _Pragma("unroll") for (int n = 0; n < 2; ++n) _Pragma("unroll") for (int k = 0; k < 2; ++k) \
            acc[ai][bj][m][n] = __builtin_amdgcn_mfma_f32_16x16x32_bf16(Bt[n][k], At[m][k], acc[ai][bj][m][n], 0, 0, 0); } \
        __builtin_amdgcn_s_setprio(0); } while (0)
#define PG8_WAIT_V(n) asm volatile("s_waitcnt vmcnt(" #n ")" ::: "memory")
#define PG8_WAIT_L(n) asm volatile("s_waitcnt lgkmcnt(" #n ")" ::: "memory")
#define PG8_BAR __builtin_amdgcn_s_barrier()
#define PG8_SCHED __builtin_amdgcn_sched_barrier(0)
    Unit cur, nxt; int ui = 0;
    if (!S.next(0, cur)) return;
    f32x4 acc[2][2][4][2];
#pragma unroll
    for (int a = 0; a < 2; ++a)
#pragma unroll
        for (int b = 0; b < 2; ++b)
#pragma unroll
            for (int m = 0; m < 4; ++m)
#pragma unroll
                for (int n = 0; n < 2; ++n) acc[a][b][m][n] = (f32x4){0.f, 0.f, 0.f, 0.f};
    const int f8scale = 0x7f7f7f7f;
    bf16x8 At[4][2], B0[2][2], B1[2][2]; i32x8 At8[4], B08[2], B18[2];
    const char* cA = GATHER ? (const char*)g.A : g.a(cur); const char* cB = g.b(cur);
    PG8_STAGE(PG8_SB(0, 0), cB, voffB); PG8_STAGE_A(PG8_SA(0, 0), cA, 0, vA); PG8_STAGE(PG8_SB(0, 1), cB + hstepB, voffB); PG8_STAGE_A(PG8_SA(0, 1), cA, 1, vA);
    if (wr == 1) PG8_BAR;
    PG8_WAIT_V(4); PG8_BAR;
    PG8_STAGE(PG8_SB(1, 0), cB + kstep, voffB); PG8_STAGE_A(PG8_SA(1, 0), cA + kstepA, 0, vA); PG8_STAGE(PG8_SB(1, 1), cB + hstepB + kstep, voffB);
    PG8_WAIT_V(6); PG8_BAR;
    for (;;) {
        const bool has_next = S.next(ui + 1, nxt);
        const char* nA = GATHER ? cA : (has_next ? g.a(nxt) : cA); const char* nB = has_next ? g.b(nxt) : cB;
        if constexpr (GATHER) {
#pragma unroll
            for (int h = 0; h < 2; ++h)
#pragma unroll
                for (int i = 0; i < 2; ++i) nvA[h][i] = has_next ? IDX[(ui + 1) * 256 + h * HALF + RA[i]] + voffA[i] : vA[h][i];
        }
#pragma unroll 1
        for (int t = 0; t < nt; t += 2) {
            const bool last = (t == nt - 2);
            const char* a1 = cA + (size_t)(t + 1) * kstepA;
            const char* a2 = last ? nA : cA + (size_t)(t + 2) * kstepA; const char* b2 = last ? nB : cB + (size_t)(t + 2) * kstep;
            const char* a3 = a2 + kstepA; const char* b3 = b2 + kstep;
            unsigned sA[2][2];
#pragma unroll
            for (int h = 0; h < 2; ++h)
#pragma unroll
                for (int i = 0; i < 2; ++i) sA[h][i] = last ? nvA[h][i] : vA[h][i];
            PG8_LDB(B0, 0, 0); PG8_SCHED; PG8_LDA(At, 0, 0); PG8_STAGE_A(PG8_SA(1, 1), a1, 1, vA);
            PG8_WAIT_L(8); PG8_WAIT_V(10); PG8_BAR; PG8_WAIT_L(0); PG8_MMA(0, 0, At, B0); PG8_BAR; PG8_SCHED;
            PG8_LDB(B1, 0, 1); PG8_STAGE(PG8_SB(0, 0), b2, voffB);
            PG8_WAIT_V(10); PG8_BAR; PG8_WAIT_L(0); PG8_MMA(0, 1, At, B1); PG8_BAR;
            PG8_LDA(At, 0, 1); PG8_STAGE_A(PG8_SA(0, 0), a2, 0, sA);
            PG8_WAIT_V(10); PG8_BAR; PG8_WAIT_L(0); PG8_MMA(1, 0, At, B0); PG8_BAR; PG8_SCHED;
            PG8_STAGE(PG8_SB(0, 1), b2 + hstepB, voffB);
            PG8_WAIT_V(10); PG8_BAR; PG8_MMA(1, 1, At, B1); PG8_BAR;
            PG8_LDB(B0, 1, 0); PG8_SCHED; PG8_LDA(At, 1, 0); PG8_STAGE_A(PG8_SA(0, 1), a2, 1, sA);
            PG8_WAIT_L(8); PG8_WAIT_V(10); PG8_BAR; PG8_WAIT_L(0); PG8_MMA(0, 0, At, B0); PG8_BAR; PG8_SCHED;
            PG8_LDB(B1, 1, 1); PG8_STAGE(PG8_SB(1, 0), b3, voffB);
            PG8_WAIT_V(10); PG8_BAR; PG8_WAIT_L(0); PG8_MMA(0, 1, At, B1); PG8_BAR;
            PG8_LDA(At, 1, 1); PG8_STAGE_A(PG8_SA(1, 0), a3, 0, sA);
            PG8_WAIT_V(10); PG8_BAR; PG8_WAIT_L(0); PG8_MMA(1, 0, At, B0); PG8_BAR; PG8_SCHED;
            PG8_STAGE(PG8_SB(1, 1), b3 + hstepB, voffB);
            PG8_WAIT_V(10); PG8_BAR; PG8_MMA(1, 1, At, B1); PG8_BAR;
        }
        if constexpr (FP8) asm volatile("s_nop 15\n\ts_nop 15" ::: "memory");
        E(acc, cur, wr, wc, fr, fq);
        if (!has_next) break;
#pragma unroll
        for (int a = 0; a < 2; ++a)
#pragma unroll
            for (int b = 0; b < 2; ++b)
#pragma unroll
                for (int m = 0; m < 4; ++m)
#pragma unroll
                    for (int n = 0; n < 2; ++n) acc[a][b][m][n] = (f32x4){0.f, 0.f, 0.f, 0.f};
        cur = nxt; cA = nA; cB = nB; ++ui;
        if constexpr (GATHER) {
#pragma unroll
            for (int h = 0; h < 2; ++h)
#pragma unroll
                for (int i = 0; i < 2; ++i) vA[h][i] = nvA[h][i];
        }
    }
    PG8_WAIT_V(0);
    if (wr == 0) PG8_BAR;
    PG8_BAR;
#undef PG8_SA
#undef PG8_SB
#undef PG8_STAGE
#undef PG8_STAGE_GA
#undef PG8_STAGE_A
#undef PG8_LDA
#undef PG8_LDB
#undef PG8_MMA
#undef PG8_WAIT_V
#undef PG8_WAIT_L
#undef PG8_BAR
#undef PG8_SCHED
}

#define EPI_ROWS_BEGIN for (int ai = 0; ai < 2; ++ai) for (int m = 0; m < 4; ++m) { const int row = opaque(u.pm * BM + ai * HALF + wr * 64 + m * 16 + fr);
#define EPI_ROWS_END }
__device__ __forceinline__ u32x4 pack8(const f32x4 a, const f32x4 b) { u32x4 w; w.x = cvt_pk_bf16(a[0], a[1]); w.y = cvt_pk_bf16(a[2], a[3]); w.z = cvt_pk_bf16(b[0], b[1]); w.w = cvt_pk_bf16(b[2], b[3]); return w; }

struct EpiIn {
    static constexpr bool PERM = true;
    bf16_t* Z; int ldz, nz, nscale; float qscale; int split_cols; size_t split_stride; float* sm; int nsm; const float* smbias; float ascale = 1.0f;
    __device__ __forceinline__ void operator()(const f32x4 (&acc)[2][2][4][2], const Unit& u, int wr, int wc, int fr_, int fq_) const {
        const int fr = opaque(fr_), fq = opaque(fq_);
        if (u.pn < nz) {
            int colt = u.pn * BM; bf16_t* base = Z;
            if (split_cols) { const int t = colt / split_cols; base += (size_t)t * split_stride; colt -= t * split_cols; }
            const int col0 = colt + wc * 32 + 8 * fq; const float sc = ((u.pn < nscale) ? qscale : 1.0f) * ascale;
#pragma unroll
            for (int ai = 0; ai < 2; ++ai)
#pragma unroll
                for (int m = 0; m < 4; ++m) { const int row = opaque(u.pm * BM + ai * HALF + wr * 64 + m * 16 + fr); bf16_t* rowp = base + (size_t)row * ldz + col0;
#pragma unroll
                    for (int bj = 0; bj < 2; ++bj) *(u32x4*)(rowp + bj * HALF) = pack8(acc[ai][bj][m][0] * sc, acc[ai][bj][m][1] * sc); }
        } else if (u.pn == nz && sm) {
            if (wc == 0 && 8 * fq < nsm) {
                f32x4 b0 = {0.f, 0.f, 0.f, 0.f}, b1 = {0.f, 0.f, 0.f, 0.f};
                if (smbias) { b0 = *(const f32x4*)(smbias + 8 * fq); b1 = *(const f32x4*)(smbias + 8 * fq + 4); }
#pragma unroll
                for (int ai = 0; ai < 2; ++ai)
#pragma unroll
                    for (int m = 0; m < 4; ++m) { const int row = opaque(u.pm * BM + ai * HALF + wr * 64 + m * 16 + fr); float* rp = sm + (size_t)row * nsm + 8 * fq;
                        *(f32x4*)rp = acc[ai][0][m][0] * ascale + b0; *(f32x4*)(rp + 4) = acc[ai][0][m][1] * ascale + b1; }
            }
        }
    }
};
struct EpiOut {
    static constexpr bool PERM = false;
    const float* xres; float* Y;
    __device__ __forceinline__ void operator()(const f32x4 (&acc)[2][2][4][2], const Unit& u, int wr, int wc, int fr_, int fq_) const {
        const int fr = opaque(fr_), fq = opaque(fq_);
        const int col0 = u.pn * BM + wc * 32 + 4 * fq;
#pragma unroll
        for (int ai = 0; ai < 2; ++ai)
#pragma unroll
            for (int m = 0; m < 4; ++m) { const size_t off = (size_t)opaque(u.pm * BM + ai * HALF + wr * 64 + m * 16 + fr) * DM + col0;
#pragma unroll
                for (int bj = 0; bj < 2; ++bj)
#pragma unroll
                    for (int n = 0; n < 2; ++n) { const f32x4 xr = *(const f32x4*)(xres + off + bj * HALF + n * 16); *(f32x4*)(Y + off + bj * HALF + n * 16) = xr * ALPHA + acc[ai][bj][m][n]; } }
    }
};
struct EpiOutB {
    static constexpr bool PERM = true;
    const bf16_t* __restrict__ X; bf16_t* __restrict__ Y; float scale;
    __device__ __forceinline__ void operator()(const f32x4 (&acc)[2][2][4][2], const Unit& u, int wr, int wc, int fr_, int fq_) const {
        const int fr = opaque(fr_), fq = opaque(fq_);
        const int col0 = u.pn * BM + wc * 32 + 8 * fq;
#pragma unroll
        for (int ai = 0; ai < 2; ++ai) {
            const size_t off0 = (size_t)opaque(u.pm * BM + ai * HALF + wr * 64 + fr) * DM + col0;
            u32x4 xw[4][2];
#pragma unroll
            for (int m = 0; m < 4; ++m)
#pragma unroll
                for (int bj = 0; bj < 2; ++bj) xw[m][bj] = *(const u32x4*)(X + off0 + (size_t)m * 16 * DM + bj * HALF);
#pragma unroll
            for (int m = 0; m < 4; ++m)
#pragma unroll
                for (int bj = 0; bj < 2; ++bj) { const u32x4 w = xw[m][bj];
                    const f32x4 x0 = {bf_lo(w.x), bf_hi(w.x), bf_lo(w.y), bf_hi(w.y)}, x1 = {bf_lo(w.z), bf_hi(w.z), bf_lo(w.w), bf_hi(w.w)};
                    *(u32x4*)(Y + off0 + (size_t)m * 16 * DM + bj * HALF) = pack8(x0 * ALPHA + acc[ai][bj][m][0] * scale, x1 * ALPHA + acc[ai][bj][m][1] * scale); }
        }
    }
};
struct EpiSwiglu {
    static constexpr bool PERM = true;
    bf16_t* Hd;
    __device__ __forceinline__ void operator()(const f32x4 (&acc)[2][2][4][2], const Unit& u, int wr, int wc, int fr_, int fq_) const {
        const int fr = opaque(fr_), fq = opaque(fq_);
        const int col0 = u.pn * HALF + wc * 32 + 8 * fq;
#pragma unroll
        for (int ai = 0; ai < 2; ++ai)
#pragma unroll
            for (int m = 0; m < 4; ++m) { const int row = opaque(u.pm * BM + ai * HALF + wr * 64 + m * 16 + fr);
                f32x4 h0, h1;
#pragma unroll
                for (int j = 0; j < 4; ++j) { h0[j] = siluf_(acc[ai][0][m][0][j]) * acc[ai][1][m][0][j]; h1[j] = siluf_(acc[ai][0][m][1][j]) * acc[ai][1][m][1][j]; }
                *(u32x4*)(Hd + (size_t)u.pm * 262144 + (size_t)(col0 >> 6) * 16384 + (size_t)(row & 255) * 64 + (col0 & 63)) = pack8(h0, h1); }
    }
};
struct EpiSwiglu8 {
    static constexpr bool PERM = true;
    unsigned char* Hd;
    __device__ __forceinline__ void operator()(const f32x4 (&acc)[2][2][4][2], const Unit& u, int wr, int wc, int fr_, int fq_) const {
        const int fr = opaque(fr_), fq = opaque(fq_);
        const int c0 = wc * 32 + 8 * fq;
#pragma unroll
        for (int ai = 0; ai < 2; ++ai)
#pragma unroll
            for (int m = 0; m < 4; ++m) { const int r = ai * HALF + wr * 64 + m * 16 + fr;
                float h[8];
#pragma unroll
                for (int n = 0; n < 2; ++n)
#pragma unroll
                    for (int j = 0; j < 4; ++j) h[4 * n + j] = siluf_(acc[ai][0][m][n][j] * (1.0f / F8_SW1)) * acc[ai][1][m][n][j] * (F8_SH / F8_SW1);
                u32x2 o; o.x = pk4_fp8(h[0], h[1], h[2], h[3]); o.y = pk4_fp8(h[4], h[5], h[6], h[7]);
                *(u32x2*)(Hd + (size_t)u.pm * 262144 + (size_t)u.pn * 32768 + (size_t)r * 128 + c0) = o; }
    }
};
struct EpiBf16S {
    static constexpr bool PERM = true;
    bf16_t* O; int ldc; float scale;
    __device__ __forceinline__ void operator()(const f32x4 (&acc)[2][2][4][2], const Unit& u, int wr, int wc, int fr_, int fq_) const {
        const int fr = opaque(fr_), fq = opaque(fq_);
        const int col0 = u.pn * BM + wc * 32 + 8 * fq;
#pragma unroll
        for (int ai = 0; ai < 2; ++ai)
#pragma unroll
            for (int m = 0; m < 4; ++m) { const int row = opaque(u.pm * BM + ai * HALF + wr * 64 + m * 16 + fr); bf16_t* rowp = O + (size_t)row * ldc + col0;
#pragma unroll
                for (int bj = 0; bj < 2; ++bj) *(u32x4*)(rowp + bj * HALF) = pack8(acc[ai][bj][m][0] * scale, acc[ai][bj][m][1] * scale); }
    }
};
struct EpiFp8S {
    static constexpr bool PERM = true;
    unsigned char* O; int ldc; float scale;
    __device__ __forceinline__ void operator()(const f32x4 (&acc)[2][2][4][2], const Unit& u, int wr, int wc, int fr_, int fq_) const {
        const int fr = opaque(fr_), fq = opaque(fq_);
        const int col0 = u.pn * BM + wc * 32 + 8 * fq;
#pragma unroll
        for (int ai = 0; ai < 2; ++ai)
#pragma unroll
            for (int m = 0; m < 4; ++m) { const int row = opaque(u.pm * BM + ai * HALF + wr * 64 + m * 16 + fr); unsigned char* rowp = O + (size_t)row * ldc + col0;
#pragma unroll
                for (int bj = 0; bj < 2; ++bj) { const f32x4 a = acc[ai][bj][m][0] * scale, b = acc[ai][bj][m][1] * scale; u32x2 o; o.x = pk4_fp8(a[0], a[1], a[2], a[3]); o.y = pk4_fp8(b[0], b[1], b[2], b[3]);
                    *(u32x2*)(rowp + bj * HALF) = o; } }
    }
};
struct EpiBf16 {
    static constexpr bool PERM = true;
    bf16_t* O; int ldc;
    __device__ __forceinline__ void operator()(const f32x4 (&acc)[2][2][4][2], const Unit& u, int wr, int wc, int fr_, int fq_) const {
        const int fr = opaque(fr_), fq = opaque(fq_);
        const int col0 = u.pn * BM + wc * 32 + 8 * fq;
#pragma unroll
        for (int ai = 0; ai < 2; ++ai)
#pragma unroll
            for (int m = 0; m < 4; ++m) { const int row = opaque(u.pm * BM + ai * HALF + wr * 64 + m * 16 + fr); bf16_t* rowp = O + (size_t)row * ldc + col0;
#pragma unroll
                for (int bj = 0; bj < 2; ++bj) *(u32x4*)(rowp + bj * HALF) = pack8(acc[ai][bj][m][0], acc[ai][bj][m][1]); }
    }
};
struct EpiLruGate {
    static constexpr bool PERM = true;
    const bf16_t* UC; const float* ba; const float* bx; const float* lam;
    bf16_t* LA0; bf16_t* GT0; bf16_t* LA1; bf16_t* GT1;
    __device__ __forceinline__ void operator()(const f32x4 (&acc)[2][2][4][2], const Unit& u, int wr, int wc, int fr_, int fq_) const {
        const int fr = opaque(fr_), fq = opaque(fq_);
        const int dir = u.pn >> 3, ch0 = ((u.pn >> 1) & 3) * 256 + (u.pn & 1) * 128 + wc * 32 + 8 * fq;
        bf16_t* LA = dir ? LA1 : LA0; bf16_t* GT = dir ? GT1 : GT0;
        f32x4 vba[2], vbx[2], vll[2];
#pragma unroll
        for (int n = 0; n < 2; ++n) { const int cc = dir * 1024 + ch0 + 4 * n; vba[n] = *(const f32x4*)(ba + cc); vbx[n] = *(const f32x4*)(bx + cc); vll[n] = *(const f32x4*)(lam + cc);
#pragma unroll
            for (int j = 0; j < 4; ++j) vll[n][j] = 8.0f * logsigmoidf_(vll[n][j]); }
#pragma unroll
        for (int ai = 0; ai < 2; ++ai) {
            const size_t off0 = (size_t)opaque(u.pm * BM + ai * HALF + wr * 64 + fr) * 1024 + ch0;
#pragma unroll
            for (int mh = 0; mh < 2; ++mh) {
            u32x4 uw[4];
#pragma unroll
            for (int m = 2 * mh; m < 2 * mh + 2; ++m) uw[m] = *(const u32x4*)(UC + off0 + (size_t)m * 16 * 1024);
#pragma unroll
            for (int m = 2 * mh; m < 2 * mh + 2; ++m) {
                u32x4 o1; u32x2 o2;
#pragma unroll
                for (int n = 0; n < 2; ++n) {
                    const unsigned ua = uw[m][2 * n], ub = uw[m][2 * n + 1];
                    const float uv[4] = {bf_lo(ua), bf_hi(ua), bf_lo(ub), bf_hi(ub)};
                    float la[4], gt[4];
#pragma unroll
                    for (int j = 0; j < 4; ++j) { const float r = sigmoid_fast(acc[ai][0][m][n][j] + vba[n][j]), ig = sigmoid_fast(acc[ai][1][m][n][j] + vbx[n][j]);
                        const float l = r * vll[n][j]; la[j] = l; gt[j] = __builtin_amdgcn_sqrtf(fmaxf(1.0f - __expf(2.0f * l), 0.f)) * ig * uv[j]; }
                    o1[2 * n] = cvt_pk_bf16(la[0], la[1]); o1[2 * n + 1] = cvt_pk_bf16(la[2], la[3]); o2[n] = pk4_fp8(gt[0] * F8_SG, gt[1] * F8_SG, gt[2] * F8_SG, gt[3] * F8_SG); }
                *(u32x4*)(LA + off0 + (size_t)m * 16 * 1024) = o1; *(u32x2*)((unsigned char*)GT + off0 + (size_t)m * 16 * 1024) = o2; }
            __builtin_amdgcn_sched_barrier(0);
            }
        }
    }
};
#ifndef ATT_FP8
#define ATT_FP8 1
#endif
struct EpiMlaQ {
    static constexpr bool PERM = true;
    bf16_t* Q; const float* cs; const float* sn;
    __device__ __forceinline__ void st8(size_t eoff, const f32x4 a, const f32x4 b) const {
        if (ATT_FP8) { u32x2 o; o.x = pk4_fp8(a[0], a[1], a[2], a[3]); o.y = pk4_fp8(b[0], b[1], b[2], b[3]); *(u32x2*)((unsigned char*)Q + eoff) = o; }
        else *(u32x4*)(Q + eoff) = pack8(a, b);
    }
    __device__ __forceinline__ void operator()(const f32x4 (&acc)[2][2][4][2], const Unit& u, int wr, int wc, int fr_, int fq_) const {
        const int fr = opaque(fr_), fq = opaque(fq_);
        if (u.pn < 4) {
#pragma unroll
            for (int ai = 0; ai < 2; ++ai)
#pragma unroll
                for (int m = 0; m < 4; ++m) { const int row = opaque(u.pm * BM + ai * HALF + wr * 64 + m * 16 + fr);
#pragma unroll
                    for (int bj = 0; bj < 2; ++bj) { const int h = u.pn * 2 + bj; st8((size_t)row * 1536 + h * 192 + wc * 32 + 8 * fq, acc[ai][bj][m][0], acc[ai][bj][m][1]); } }
        } else {
            const int h = (u.pn - 4) * 4 + wc, i0 = 8 * fq;
#pragma unroll
            for (int ai = 0; ai < 2; ++ai) {
                const int row0 = opaque(u.pm * BM + ai * HALF + wr * 64 + fr);
                f32x4 c[4][2], s[4][2];
#pragma unroll
                for (int m = 0; m < 4; ++m)
#pragma unroll
                    for (int n = 0; n < 2; ++n) { c[m][n] = *(const f32x4*)(cs + (size_t)(row0 + 16 * m) * 32 + i0 + 4 * n); s[m][n] = *(const f32x4*)(sn + (size_t)(row0 + 16 * m) * 32 + i0 + 4 * n); }
#pragma unroll
                for (int m = 0; m < 4; ++m) { f32x4 o1[2], o2[2];
#pragma unroll
                    for (int n = 0; n < 2; ++n) { const f32x4 x1 = acc[ai][0][m][n], x2 = acc[ai][1][m][n]; o1[n] = x1 * c[m][n] - x2 * s[m][n]; o2[n] = x2 * c[m][n] + x1 * s[m][n]; }
                    const size_t qo = (size_t)(row0 + 16 * m) * 1536 + h * 192 + 128 + i0;
                    st8(qo, o1[0], o1[1]); st8(qo + 32, o2[0], o2[1]); }
            }
        }
    }
};
#ifndef ATT_PV8
#define ATT_PV8 0
#endif
struct EpiMlaKV {
    static constexpr bool PERM = true;
    static constexpr bool SWAPB1 = (ATT_FP8 && ATT_PV8);
    bf16_t* Kc; bf16_t* Vc;
    __device__ __forceinline__ void operator()(const f32x4 (&acc)[2][2][4][2], const Unit& u, int wr, int wc, int fr_, int fq_) const {
        const int fr = opaque(fr_), fq = opaque(fq_);
        const int h = u.pn, c0 = wc * 32 + 8 * fq;
#pragma unroll
        for (int ai = 0; ai < 2; ++ai)
#pragma unroll
            for (int m = 0; m < 4; ++m) { const int row = opaque(u.pm * BM + ai * HALF + wr * 64 + m * 16 + fr); const int b = row >> 11, s = row & 2047;
                const size_t r = ((size_t)(b * 8 + h) * SEQ + s);
                if (ATT_FP8) { u32x2 o; o.x = pk4_fp8(acc[ai][0][m][0][0], acc[ai][0][m][0][1], acc[ai][0][m][0][2], acc[ai][0][m][0][3]); o.y = pk4_fp8(acc[ai][0][m][1][0], acc[ai][0][m][1][1], acc[ai][0][m][1][2], acc[ai][0][m][1][3]);
                    *(u32x2*)((unsigned char*)Kc + r * 192 + c0) = o; }
                else *(u32x4*)(Kc + r * 192 + c0) = pack8(acc[ai][0][m][0], acc[ai][0][m][1]);
                if (!SWAPB1) *(u32x4*)(Vc + r * 128 + c0) = pack8(acc[ai][1][m][0], acc[ai][1][m][1]); }
        if (SWAPB1) {
#pragma unroll
            for (int n = 0; n < 2; ++n) { const int dv = wc * 32 + perm32(16 * n + fr);
#pragma unroll
                for (int ai = 0; ai < 2; ++ai)
#pragma unroll
                    for (int m = 0; m < 4; ++m) { const int row = opaque(u.pm * BM + ai * HALF + wr * 64 + m * 16 + 4 * fq); const int b = row >> 11, s0 = row & 2047;
                        const f32x4 v = acc[ai][1][m][n] * F8_SV;
                        *(unsigned*)((unsigned char*)Vc + ((size_t)((b * 8 + h) * 128 + dv)) * SEQ + s0) = pk4_fp8(v[0], v[1], v[2], v[3]); } }
        }
    }
};
}
#ifndef INP_FP8
#define INP_FP8 0
#endif
#ifndef OUT_FP8
#define OUT_FP8 0
#endif
#ifndef MOE_FP8
#define MOE_FP8 1
#endif
struct Ctx {
    LAS unsigned char* lds;
    int tid, lane, wave, G, gw, NGW;
    const void* const* in;
    float* out; unsigned char* ws;
};
#define IN_F(i) ((const float*)C.in[i])
enum { I_X = 0, I_POS, I_ML_WIN, I_ML_GB, I_ML_NG, I_ML_WOUT, I_GL_WIN, I_GL_GW, I_GL_GB, I_GL_NG, I_GL_WOUT,
       I_LR_WIN, I_LR_CW, I_LR_CB, I_LR_GAW, I_LR_GAB, I_LR_GXW, I_LR_GXB, I_LR_LAM, I_LR_WOUT,
       I_MA_WIN, I_MA_QG, I_MA_KVG, I_MA_UQ, I_MA_UKV, I_MA_WOUT, I_MOE_R, I_MOE_G, I_MOE_U, I_MOE_D, I_LN_G, I_LN_B, N_IN };

#ifndef USE_TOUCH
#define USE_TOUCH 0
#endif
__device__ __forceinline__ void touch_region(Ctx& C, const void* p, size_t bytes) {
    if (!USE_TOUCH) return;
    const u32x4* q = (const u32x4*)p; const size_t n = bytes / 16; unsigned acc = 0u;
    for (size_t i = (size_t)blockIdx.x * 512 + C.tid; i < n; i += (size_t)C.G * 512 * 4) {
        u32x4 v0 = q[i], v1 = {0u, 0u, 0u, 0u}, v2 = v1, v3 = v1;
        if (i + (size_t)C.G * 512 < n) v1 = q[i + (size_t)C.G * 512];
        if (i + (size_t)C.G * 1024 < n) v2 = q[i + (size_t)C.G * 1024];
        if (i + (size_t)C.G * 1536 < n) v3 = q[i + (size_t)C.G * 1536];
        acc ^= (v0.x ^ v1.x) ^ (v2.x ^ v3.x);
    }
    asm volatile("" :: "v"(acc));
    __syncthreads();
}
template <class RM>
__device__ __forceinline__ void tr_item(const float* W, int ldw, int nsrc, bf16_t* WT, int ldk, LAS float* scr, int k0, int n0, int lane, RM rowmap) {
    { const int n4 = (lane & 7) * 4; f32x4 w[8];
#pragma unroll
      for (int i = 0; i < 8; ++i) { const int kk = 8 * i + (lane >> 3); w[i] = (n0 + n4 < nsrc) ? *(const f32x4*)(W + (size_t)(k0 + kk) * ldw + n0 + n4) : (f32x4){0.f, 0.f, 0.f, 0.f}; }
#pragma unroll
      for (int i = 0; i < 8; ++i) { const int kk = 8 * i + (lane >> 3); LAS float* d = scr + kk * 33 + n4; d[0] = w[i][0]; d[1] = w[i][1]; d[2] = w[i][2]; d[3] = w[i][3]; } }
    LDS_WAIT(); asm volatile("" ::: "memory");
    const int c = lane & 7;
#pragma unroll
    for (int j = 0; j < 4; ++j) { const int n = (lane >> 3) + 8 * j; const LAS float* s = scr + (8 * c) * 33 + n;
        u32x4 o; o.x = cvt_pk_bf16(s[0 * 33], s[1 * 33]); o.y = cvt_pk_bf16(s[2 * 33], s[3 * 33]); o.z = cvt_pk_bf16(s[4 * 33], s[5 * 33]); o.w = cvt_pk_bf16(s[6 * 33], s[7 * 33]);
        *(u32x4*)(WT + (size_t)rowmap(n0 + n) * ldk + k0 + 8 * c) = o; }
    LDS_WAIT(); asm volatile("" ::: "memory");
}
template <class RM>
__device__ __forceinline__ void tr_item8(const float* W, int ldw, unsigned char* WT, int ldkb, LAS float* scr, int k0, int n0, int lane, float scale, RM rowmap, int nsrc = 1 << 30) {
    { const int n4 = (lane & 7) * 4; f32x4 w[8];
#pragma unroll
      for (int i = 0; i < 8; ++i) { const int kk = 8 * i + (lane >> 3); w[i] = (n0 + n4 < nsrc) ? *(const f32x4*)(W + (size_t)(k0 + kk) * ldw + n0 + n4) : (f32x4){0.f, 0.f, 0.f, 0.f}; }
#pragma unroll
      for (int i = 0; i < 8; ++i) { const int kk = 8 * i + (lane >> 3); LAS float* d = scr + kk * 33 + n4; d[0] = w[i][0]; d[1] = w[i][1]; d[2] = w[i][2]; d[3] = w[i][3]; } }
    LDS_WAIT(); asm volatile("" ::: "memory");
    const int c = lane & 7;
#pragma unroll
    for (int j = 0; j < 4; ++j) { const int n = (lane >> 3) + 8 * j; const LAS float* s = scr + (8 * c) * 33 + n;
        u32x2 o; o.x = pk4_fp8(s[0 * 33] * scale, s[1 * 33] * scale, s[2 * 33] * scale, s[3 * 33] * scale); o.y = pk4_fp8(s[4 * 33] * scale, s[5 * 33] * scale, s[6 * 33] * scale, s[7 * 33] * scale);
        *(u32x2*)(WT + (size_t)rowmap(n0 + n) * ldkb + k0 + 8 * c) = o; }
    LDS_WAIT(); asm volatile("" ::: "memory");
}
__device__ __forceinline__ void prep_moe_weights8(Ctx& C, int layer) {
    LAS float* scr = (LAS float*)(C.lds + C.wave * 16384);
    const float* wg = IN_F(I_MOE_G) + (size_t)layer * 16 * 1048576; const float* wu = IN_F(I_MOE_U) + (size_t)layer * 16 * 1048576; const float* wd = IN_F(I_MOE_D) + (size_t)layer * 16 * 1048576;
    unsigned char* W1 = C.ws + WS_WMOE; unsigned char* W2 = W1 + (size_t)16 * 2048 * 1024;
    for (int it = C.gw; it < 16 * 3 * 512; it += C.NGW) {
        const int e = it / 1536, r = it % 1536, which = r / 512, ib = r % 512, k0 = 64 * (ib / 32), n0 = 32 * (ib % 32);
        if (which < 2) tr_item8((which ? wu : wg) + (size_t)e * 1048576, 1024, W1 + (size_t)e * 2048 * 1024, 1024, scr, k0, n0, C.lane, F8_SW1, [which](int n) { return (n >> 7) * 256 + which * 128 + (n & 127); });
        else tr_item8(wd + (size_t)e * 1048576, 1024, W2 + (size_t)e * 1048576, 1024, scr, k0, n0, C.lane, F8_SW2, [](int n) { return n; });
    }
}
template <class RM>
__device__ __forceinline__ void convert_matrix(Ctx& C, const float* W, int K, int ldw, int nsrc, int npad, bf16_t* WT, int ldk, RM rowmap) {
    LAS float* scr = (LAS float*)(C.lds + C.wave * 16384);
    const int nkb = K / 64, nnb = npad / 32;
    for (int it = C.gw; it < nkb * nnb; it += C.NGW) tr_item(W, ldw, nsrc, WT, ldk, scr, 64 * (it / nnb), 32 * (it % nnb), C.lane, rowmap);
}
__device__ __forceinline__ void convert_matrix8(Ctx& C, const float* W, int K, int ldw, int N, unsigned char* WT, int ldkb, float scale, int nsrc = 1 << 30) {
    LAS float* scr = (LAS float*)(C.lds + C.wave * 16384);
    const int nkb = K / 64, nnb = N / 32;
    for (int it = C.gw; it < nkb * nnb; it += C.NGW) tr_item8(W, ldw, WT, ldkb, scr, 64 * (it / nnb), 32 * (it % nnb), C.lane, scale, [](int n) { return n; }, nsrc);
}
__device__ __forceinline__ void prep_mixer_weights(Ctx& C) {
    bf16_t* wm = (bf16_t*)(C.ws + WS_WMIX);
    auto ident = [](int n) { return n; };
    if (INP_FP8) convert_matrix8(C, IN_F(I_ML_WIN), 1024, 3088, 3328, (unsigned char*)wm + WM_ML_IN, 1024, F8_SWI, 3088); else convert_matrix(C, IN_F(I_ML_WIN), 1024, 3088, 3088, 3328, (bf16_t*)((char*)wm + WM_ML_IN), 1024, ident);
    if (OUT_FP8) convert_matrix8(C, IN_F(I_ML_WOUT), 1024, 1024, 1024, (unsigned char*)wm + WM_ML_OUT, 1024, F8_SWO); else convert_matrix(C, IN_F(I_ML_WOUT), 1024, 1024, 1024, 1024, (bf16_t*)((char*)wm + WM_ML_OUT), 1024, ident);
    if (INP_FP8) convert_matrix8(C, IN_F(I_GL_WIN), 1024, 3104, 3328, (unsigned char*)wm + WM_GL_IN, 1024, F8_SWI, 3104); else convert_matrix(C, IN_F(I_GL_WIN), 1024, 3104, 3104, 3328, (bf16_t*)((char*)wm + WM_GL_IN), 1024, ident);
    if (OUT_FP8) convert_matrix8(C, IN_F(I_GL_WOUT), 1024, 1024, 1024, (unsigned char*)wm + WM_GL_OUT, 1024, F8_SWO); else convert_matrix(C, IN_F(I_GL_WOUT), 1024, 1024, 1024, 1024, (bf16_t*)((char*)wm + WM_GL_OUT), 1024, ident);
    convert_matrix(C, IN_F(I_LR_WIN), 1024, 2048, 2048, 2048, (bf16_t*)((char*)wm + WM_LR_IN), 1024, ident);
    if (OUT_FP8) convert_matrix8(C, IN_F(I_LR_WOUT), 1024, 1024, 1024, (unsigned char*)wm + WM_LR_OUT, 1024, F8_SWO); else convert_matrix(C, IN_F(I_LR_WOUT), 1024, 1024, 1024, 1024, (bf16_t*)((char*)wm + WM_LR_OUT), 1024, ident);
    for (int sm = 0; sm < 16; ++sm) { const int which = sm >> 3, dir = (sm >> 2) & 1, blk = sm & 3;
        const float* src = (which ? IN_F(I_LR_GXW) : IN_F(I_LR_GAW)) + (size_t)(dir * 4 + blk) * 65536;
        const int rbase = dir * 2048 + blk * 512 + which * 128;
        convert_matrix(C, src, 256, 256, 256, 256, (bf16_t*)((char*)wm + WM_LR_G), 256, [rbase](int j) { return rbase + (j >> 7) * 256 + (j & 127); }); }
    convert_matrix(C, IN_F(I_MA_WIN), 1024, 704, 704, 768, (bf16_t*)((char*)wm + WM_MA_IN), 1024, ident);
    convert_matrix(C, IN_F(I_MA_UQ), 384, 1536, 1536, 1536, (bf16_t*)((char*)wm + WM_MA_UQ), 384,
                   [](int n) { const int h = n / 192, d = n - h * 192; if (d < 128) return h * 128 + d; const int i = d - 128; return 1024 + (h >> 2) * 256 + (i >> 5) * 128 + (h & 3) * 32 + (i & 31); });
    convert_matrix(C, IN_F(I_MA_UKV), 256, 2048, 2048, 2048, (bf16_t*)((char*)wm + WM_MA_UKV), 256, ident);
    convert_matrix(C, IN_F(I_MA_WOUT), 1024, 1024, 1024, 1024, (bf16_t*)((char*)wm + WM_MA_OUT), 1024, ident);
}
__device__ __forceinline__ void prep_moe_weights(Ctx& C, int layer) {
    LAS float* scr = (LAS float*)(C.lds + C.wave * 16384);
    const float* wg = IN_F(I_MOE_G) + (size_t)layer * 16 * 1048576; const float* wu = IN_F(I_MOE_U) + (size_t)layer * 16 * 1048576; const float* wd = IN_F(I_MOE_D) + (size_t)layer * 16 * 1048576;
    bf16_t* W1 = (bf16_t*)(C.ws + WS_WMOE); bf16_t* W2 = W1 + (size_t)16 * 2048 * 1024;
    for (int it = C.gw; it < 16 * 3 * 512; it += C.NGW) {
        const int e = it / 1536, r = it % 1536, which = r / 512, ib = r % 512, k0 = 64 * (ib / 32), n0 = 32 * (ib % 32);
        if (which < 2) tr_item((which ? wu : wg) + (size_t)e * 1048576, 1024, 1024, W1 + (size_t)e * 2048 * 1024, 1024, scr, k0, n0, C.lane, [which](int n) { return (n >> 7) * 256 + which * 128 + (n & 127); });
        else tr_item(wd + (size_t)e * 1048576, 1024, 1024, W2 + (size_t)e * 1048576, 1024, scr, k0, n0, C.lane, [](int n) { return n; });
    }
}
__device__ __forceinline__ void prep_xb(Ctx& C) {
    const f32x4* x = (const f32x4*)IN_F(I_X); u32x2* xb = (u32x2*)(C.ws + WS_XB);
    const size_t n4 = (size_t)NT * DM / 4;
    unsigned* x8 = (unsigned*)(C.ws + WS_XB8);
    for (size_t i = (size_t)blockIdx.x * 512 + C.tid; i < n4; i += (size_t)C.G * 512) { const f32x4 v = x[i]; u32x2 o; o.x = cvt_pk_bf16(v[0], v[1]); o.y = cvt_pk_bf16(v[2], v[3]); xb[i] = o;
        if (INP_FP8) x8[i] = pk4_fp8(v[0], v[1], v[2], v[3]); }
}
__device__ __forceinline__ void prep_rope(Ctx& C) {
    const int* pos = (const int*)C.in[I_POS]; float* cs = (float*)(C.ws + WS_ROPE); float* sn = cs + (size_t)NT * 32;
    for (size_t i = (size_t)blockIdx.x * 512 + C.tid; i < (size_t)NT * 32; i += (size_t)C.G * 512) {
        const int t = (int)(i >> 5), k = (int)(i & 31);
        const float freq = exp2f(-(float)k * (13.287712379549449f / 32.0f));
        const float ang = (float)pos[t] * freq;
        const double q = rint((double)ang * 0.15915494309189535); const float r = (float)((double)ang - q * 6.283185307179586);
        cs[i] = __cosf(r); sn[i] = __sinf(r);
    }
}

__device__ __forceinline__ void ln_row_norm(f32x4 (&v)[4], const f32x4 (&gv)[4], const f32x4 (&bv)[4]) {
    float s = 0.f;
#pragma unroll
    for (int j = 0; j < 4; ++j) s += (v[j][0] + v[j][1]) + (v[j][2] + v[j][3]);
    const float mean = wave_sum(s) * (1.f / DM); float s2 = 0.f;
#pragma unroll
    for (int j = 0; j < 4; ++j) { v[j] = v[j] - mean; s2 += (v[j][0] * v[j][0] + v[j][1] * v[j][1]) + (v[j][2] * v[j][2] + v[j][3] * v[j][3]); }
    const float rstd = 1.f / sqrtf(wave_sum(s2) * (1.f / DM) + LN_EPS);
#pragma unroll
    for (int j = 0; j < 4; ++j) v[j] = v[j] * rstd * gv[j] + bv[j];
}
__device__ __forceinline__ void router_reduce_store(const float (&p)[16], int lane, float* aff, int row) {
    float lg[16]; float mx = -3.0e38f;
#pragma unroll
    for (int e = 0; e < 16; ++e) { lg[e] = wave_sum(p[e]); mx = fmaxf(mx, lg[e]); }
    float sm = 0.f, mine = 0.f;
#pragma unroll
    for (int e = 0; e < 16; ++e) { const float ex = expf(lg[e] - mx); sm += ex; mine = (lane == e) ? ex : mine; }
    if (lane < 16) aff[((size_t)(row >> 11) * NEXP + lane) * SEQ + (row & 2047)] = mine / sm;
}
__device__ __forceinline__ float row_sum16(float v) { v += dpp_f<0xB1>(v); v += dpp_f<0x4E>(v); v += dpp_f<0x141>(v); v += dpp_f<0x140>(v); return v; }
__device__ __forceinline__ float row_max16(float v) { v = fmaxf(v, dpp_f<0xB1>(v)); v = fmaxf(v, dpp_f<0x4E>(v)); v = fmaxf(v, dpp_f<0x141>(v)); v = fmaxf(v, dpp_f<0x140>(v)); return v; }
__device__ __forceinline__ void ln1_router(Ctx& C, int layer, const bf16_t* Yb, int r0, int rs, int nr) {
    const float* g = IN_F(I_LN_G) + (size_t)(layer * 2 + 0) * DM; const float* bb = IN_F(I_LN_B) + (size_t)(layer * 2 + 0) * DM;
    const float* wr = IN_F(I_MOE_R) + (size_t)layer * DM * NEXP;
    constexpr int RP = 2064;
    LAS unsigned char* WT = C.lds;
    LAS unsigned char* XT = C.lds + 16 * RP + C.wave * (4 * RP);
    for (int i = C.tid; i < DM * NEXP; i += 512) { const int d = i >> 4, e = i & 15; *(LAS bf16_t*)(WT + e * RP + d * 2) = f2bf(wr[i]); }
    __syncthreads();
    float* aff = (float*)(C.ws + WS_SMALL + SM_AFF);
    f32x4 gv[4], bv[4];
#pragma unroll
    for (int j = 0; j < 4; ++j) { gv[j] = *(const f32x4*)(g + 4 * C.lane + 256 * j); bv[j] = *(const f32x4*)(bb + 4 * C.lane + 256 * j); }
    u32x2 n1[4], n2[4];
    { const u32x2* yr = (const u32x2*)(Yb + (size_t)r0 * DM); const u32x2* yr2 = (const u32x2*)(Yb + (size_t)(r0 + rs) * DM);
#pragma unroll
      for (int j = 0; j < 4; ++j) { n1[j] = yr[C.lane + 64 * j]; n2[j] = yr2[C.lane + 64 * j]; } }
    for (int k = 0; k < nr; ++k) { const int row = r0 + k * rs;
        f32x4 v[4];
#pragma unroll
        for (int j = 0; j < 4; ++j) { const u32x2 w = n1[j]; v[j] = (f32x4){bf_lo(w.x), bf_hi(w.x), bf_lo(w.y), bf_hi(w.y)}; n1[j] = n2[j]; }
        { const u32x2* yr = (const u32x2*)(Yb + (size_t)(r0 + (k + 2 < nr ? k + 2 : nr - 1) * rs) * DM);
#pragma unroll
            for (int j = 0; j < 4; ++j) n2[j] = yr[C.lane + 64 * j]; }
        ln_row_norm(v, gv, bv);
        u32x2* xb = (u32x2*)(C.ws + WS_XB + (size_t)row * DM * 2); u32x2 ob[4];
        LAS unsigned char* xt = XT + (k & 3) * RP + 8 * opaque(C.lane);
#pragma unroll
        for (int j = 0; j < 4; ++j) { ob[j].x = cvt_pk_bf16(v[j][0], v[j][1]); ob[j].y = cvt_pk_bf16(v[j][2], v[j][3]); xb[C.lane + 64 * j] = ob[j]; *(LAS u32x2*)(xt + 512 * j) = ob[j]; }
        if (MOE_FP8) { unsigned* x8 = (unsigned*)(C.ws + WS_XB8 + (size_t)row * DM);
#pragma unroll
            for (int j = 0; j < 4; ++j) x8[C.lane + 64 * j] = pk4_fp8(v[j][0], v[j][1], v[j][2], v[j][3]); }
        if ((k & 3) == 3) {
            const int ln = opaque(C.lane);
            const LAS unsigned char* xa = XT + (ln & 3) * RP + (ln >> 4) * 16; const LAS unsigned char* wb = WT + (ln & 15) * RP + (ln >> 4) * 16;
            f32x4 a0 = {0.f, 0.f, 0.f, 0.f}, a1 = a0, a2 = a0, a3 = a0;
#pragma unroll
            for (int s = 0; s < 32; s += 4) {
                a0 = __builtin_amdgcn_mfma_f32_16x16x32_bf16(*(const LAS bf16x8*)(xa + s * 64), *(const LAS bf16x8*)(wb + s * 64), a0, 0, 0, 0);
                a1 = __builtin_amdgcn_mfma_f32_16x16x32_bf16(*(const LAS bf16x8*)(xa + s * 64 + 64), *(const LAS bf16x8*)(wb + s * 64 + 64), a1, 0, 0, 0);
                a2 = __builtin_amdgcn_mfma_f32_16x16x32_bf16(*(const LAS bf16x8*)(xa + s * 64 + 128), *(const LAS bf16x8*)(wb + s * 64 + 128), a2, 0, 0, 0);
                a3 = __builtin_amdgcn_mfma_f32_16x16x32_bf16(*(const LAS bf16x8*)(xa + s * 64 + 192), *(const LAS bf16x8*)(wb + s * 64 + 192), a3, 0, 0, 0); }
            const f32x4 lg = (a0 + a1) + (a2 + a3);
#pragma unroll
            for (int i = 0; i < 4; ++i) { const float mx = row_max16(lg[i]), ex = __expf(lg[i] - mx), sm = row_sum16(ex); const int rr = r0 + (k - 3 + i) * rs;
                if (ln < 16) aff[((size_t)(rr >> 11) * NEXP + ln) * SEQ + (rr & 2047)] = ex * __builtin_amdgcn_rcpf(sm); }
        }
    }
    __syncthreads();
}

__device__ __forceinline__ void topk_select(Ctx& C) {
    const float* aff = (const float*)(C.ws + WS_SMALL + SM_AFF);
    int* rowtok = (int*)(C.ws + WS_SMALL + SM_IDX); short* inv = (short*)(C.ws + WS_SMALL + SM_INV);
    const int tid = C.tid, lane = C.lane, half = tid >> 8, ht = tid & 255, hw = (tid >> 6) & 3;
    LAS int* hist = (LAS int*)C.lds + half * 256; LAS unsigned* ctl = (LAS unsigned*)(C.lds + 2048) + half * 2; LAS unsigned* wtot = (LAS unsigned*)(C.lds + 2112) + half * 4;
    for (int u0 = 2 * blockIdx.x; u0 < NB * NEXP; u0 += 2 * C.G) {
        const int unit = u0 + half, b = unit >> 4, e = unit & 15;
        const u32x4 k0 = *(const u32x4*)(aff + (size_t)unit * SEQ + 8 * ht), k1 = *(const u32x4*)(aff + (size_t)unit * SEQ + 8 * ht + 4);
        const unsigned key[8] = {k0.x, k0.y, k0.z, k0.w, k1.x, k1.y, k1.z, k1.w};
        unsigned prefix = 0u, mask = 0u; int kneed = CAP;
#pragma unroll 1
        for (int pass = 0; pass < 4; ++pass) {
            const int shift = 24 - 8 * pass;
            hist[ht] = 0;
            __syncthreads();
#pragma unroll
            for (int k = 0; k < 8; ++k) if ((key[k] & mask) == prefix) __hip_atomic_fetch_add(&hist[(key[k] >> shift) & 255u], 1, __ATOMIC_RELAXED, __HIP_MEMORY_SCOPE_WORKGROUP);
            __syncthreads();
            if (hw == 0) {
                const int b0 = hist[255 - 4 * lane], b1 = hist[254 - 4 * lane], b2 = hist[253 - 4 * lane], b3 = hist[252 - 4 * lane];
                const int c4 = b0 + b1 + b2 + b3; int inc = c4;
#pragma unroll
                for (int o = 1; o < 64; o <<= 1) { const int t = __shfl_up(inc, o); if (lane >= o) inc += t; }
                const int before = inc - c4;
                if (before < kneed && kneed <= inc) {
                    int bin, above;
                    if (kneed <= before + b0) { bin = 255 - 4 * lane; above = before; }
                    else if (kneed <= before + b0 + b1) { bin = 254 - 4 * lane; above = before + b0; }
                    else if (kneed <= before + b0 + b1 + b2) { bin = 253 - 4 * lane; above = before + b0 + b1; }
                    else { bin = 252 - 4 * lane; above = before + b0 + b1 + b2; }
                    ctl[0] = prefix | ((unsigned)bin << shift); ctl[1] = (unsigned)(kneed - above);
                }
            }
            __syncthreads();
            prefix = ctl[0]; kneed = (int)ctl[1]; mask |= 255u << shift;
        }
        unsigned cnt = 0u;
#pragma unroll
        for (int k = 0; k < 8; ++k) cnt += (key[k] > prefix ? 1u : 0u) + (key[k] == prefix ? 0x10000u : 0u);
        unsigned inc = cnt;
#pragma unroll
        for (int o = 1; o < 64; o <<= 1) { const unsigned t = __shfl_up(inc, o); if (lane >= o) inc += t; }
        if (lane == 63) wtot[hw] = inc;
        __syncthreads();
        unsigned base = inc - cnt;
#pragma unroll
        for (int q = 0; q < 4; ++q) base += (q < hw) ? wtot[q] : 0u;
        int gtp = (int)(base & 0xffffu), eqp = (int)(base >> 16); unsigned short iv[8];
#pragma unroll
        for (int k = 0; k < 8; ++k) { const bool gt = key[k] > prefix, eq = key[k] == prefix; const bool sel = gt || (eq && eqp < kneed);
            const int slot = gtp + (eqp < kneed ? eqp : kneed);
            if (sel) rowtok[(e * NB + b) * CAP + slot] = b * SEQ + 8 * ht + k;
            iv[k] = sel ? (unsigned short)slot : (unsigned short)0xffffu; gtp += gt ? 1 : 0; eqp += eq ? 1 : 0; }
        u32x4 o; o.x = (unsigned)iv[0] | ((unsigned)iv[1] << 16); o.y = (unsigned)iv[2] | ((unsigned)iv[3] << 16); o.z = (unsigned)iv[4] | ((unsigned)iv[5] << 16); o.w = (unsigned)iv[6] | ((unsigned)iv[7] << 16);
        *(u32x4*)(inv + (size_t)unit * SEQ + 8 * ht) = o;
        __syncthreads();
    }
}

template <bool LAST>
__device__ __forceinline__ void moe_combine_ln2(Ctx& C, int layer) {
    const float* g = IN_F(I_LN_G) + (size_t)(layer * 2 + 1) * DM; const float* bb = IN_F(I_LN_B) + (size_t)(layer * 2 + 1) * DM;
    const float* aff = (const float*)(C.ws + WS_SMALL + SM_AFF); const short* inv = (const short*)(C.ws + WS_SMALL + SM_INV);
    const bf16_t* OUTB = (const bf16_t*)(C.ws + WS_Z);
    f32x4 gv[4], bv[4];
#pragma unroll
    for (int j = 0; j < 4; ++j) { gv[j] = *(const f32x4*)(g + 4 * C.lane + 256 * j); bv[j] = *(const f32x4*)(bb + 4 * C.lane + 256 * j); }
    u32x2 n1[4], n2[4]; int inv1 = -1, inv2 = -1; float aff1 = 0.f, aff2 = 0.f;
    { const int row = C.gw, r2 = C.gw + C.NGW; const u32x2* xr = (const u32x2*)(C.ws + WS_XB + (size_t)row * DM * 2); const u32x2* xr2 = (const u32x2*)(C.ws + WS_XB + (size_t)r2 * DM * 2);
#pragma unroll
      for (int j = 0; j < 4; ++j) { n1[j] = xr[C.lane + 64 * j]; n2[j] = xr2[C.lane + 64 * j]; }
      if (C.lane < 16) { const size_t ia = ((size_t)(row >> 11) * NEXP + C.lane) * SEQ + (row & 2047); inv1 = (int)inv[ia]; aff1 = aff[ia];
                         const size_t ib = ((size_t)(r2 >> 11) * NEXP + C.lane) * SEQ + (r2 & 2047); inv2 = (int)inv[ib]; aff2 = aff[ib]; } }
    for (int row = C.gw; row < NT; row += C.NGW) {
        u32x2* xb = (u32x2*)(C.ws + WS_XB + (size_t)row * DM * 2); const int b = row >> 11;
        f32x4 v[4];
#pragma unroll
        for (int j = 0; j < 4; ++j) { const u32x2 w = n1[j]; v[j] = (f32x4){bf_lo(w.x), bf_hi(w.x), bf_lo(w.y), bf_hi(w.y)} * ALPHA; n1[j] = n2[j]; }
        const int myinv = inv1; const float myaff = aff1; inv1 = inv2; aff1 = aff2;
        if (row + 2 * C.NGW < NT) { const int r2 = row + 2 * C.NGW; const u32x2* xr = (const u32x2*)(C.ws + WS_XB + (size_t)r2 * DM * 2);
#pragma unroll
            for (int j = 0; j < 4; ++j) n2[j] = xr[C.lane + 64 * j];
            if (C.lane < 16) { const size_t ia = ((size_t)(r2 >> 11) * NEXP + C.lane) * SEQ + (r2 & 2047); inv2 = (int)inv[ia]; aff2 = aff[ia]; } }
        unsigned long long m = __ballot(myinv >= 0);
        while (m) {
            const int e1 = __builtin_ctzll(m); m &= m - 1; const bool two = (m != 0ull); const int e2 = two ? __builtin_ctzll(m) : e1; if (two) m &= m - 1;
            const int c1 = __builtin_amdgcn_readlane(myinv, e1), c2 = __builtin_amdgcn_readlane(myinv, e2);
            const float g1 = __uint_as_float((unsigned)__builtin_amdgcn_readlane((int)__float_as_uint(myaff), e1));
            const float g2 = two ? __uint_as_float((unsigned)__builtin_amdgcn_readlane((int)__float_as_uint(myaff), e2)) : 0.f;
#if MOE_FP8
            const unsigned* o1 = (const unsigned*)((const unsigned char*)OUTB + ((size_t)(e1 * NB + b) * CAP + c1) * DM); const unsigned* o2 = (const unsigned*)((const unsigned char*)OUTB + ((size_t)(e2 * NB + b) * CAP + c2) * DM);
            unsigned w1[4], w2[4]; const float s1 = g1 * (1.0f / F8_SO), s2 = g2 * (1.0f / F8_SO);
#pragma unroll
            for (int j = 0; j < 4; ++j) { w1[j] = o1[C.lane + 64 * j]; w2[j] = o2[C.lane + 64 * j]; }
#pragma unroll
            for (int j = 0; j < 4; ++j) v[j] += unpk4_fp8(w1[j]) * s1 + unpk4_fp8(w2[j]) * s2;
#else
            const u32x2* o1 = (const u32x2*)(OUTB + ((size_t)(e1 * NB + b) * CAP + c1) * DM); const u32x2* o2 = (const u32x2*)(OUTB + ((size_t)(e2 * NB + b) * CAP + c2) * DM);
            u32x2 w1[4], w2[4];
#pragma unroll
            for (int j = 0; j < 4; ++j) { w1[j] = o1[C.lane + 64 * j]; w2[j] = o2[C.lane + 64 * j]; }
#pragma unroll
            for (int j = 0; j < 4; ++j) { v[j][0] += g1 * bf_lo(w1[j].x) + g2 * bf_lo(w2[j].x); v[j][1] += g1 * bf_hi(w1[j].x) + g2 * bf_hi(w2[j].x);
                v[j][2] += g1 * bf_lo(w1[j].y) + g2 * bf_lo(w2[j].y); v[j][3] += g1 * bf_hi(w1[j].y) + g2 * bf_hi(w2[j].y); }
#endif
        }
        float s = 0.f;
#pragma unroll
        for (int j = 0; j < 4; ++j) s += (v[j][0] + v[j][1]) + (v[j][2] + v[j][3]);
        const float mean = wave_sum(s) * (1.f / DM); float s2 = 0.f;
#pragma unroll
        for (int j = 0; j < 4; ++j) { v[j] = v[j] - mean; s2 += (v[j][0] * v[j][0] + v[j][1] * v[j][1]) + (v[j][2] * v[j][2] + v[j][3] * v[j][3]); }
        const float rstd = 1.f / sqrtf(wave_sum(s2) * (1.f / DM) + LN_EPS);
#pragma unroll
        for (int j = 0; j < 4; ++j) { v[j] = v[j] * rstd * gv[j] + bv[j];
            if (LAST) *(f32x4*)(C.out + (size_t)row * DM + 4 * C.lane + 256 * j) = v[j];
            else { u32x2 o; o.x = cvt_pk_bf16(v[j][0], v[j][1]); o.y = cvt_pk_bf16(v[j][2], v[j][3]); xb[C.lane + 64 * j] = o;
                if (INP_FP8 && layer == 0) ((unsigned*)(C.ws + WS_XB8 + (size_t)row * DM))[C.lane + 64 * j] = pk4_fp8(v[j][0], v[j][1], v[j][2], v[j][3]); } }
    }
}

template <int ACT>
__device__ __forceinline__ void headnorm_gate(Ctx& C, const bf16_t* Zo, int ldz, const bf16_t* H1, const bf16_t* H2, const float* ng, bf16_t* U, int r0, int rs, int nr) {
    static_assert(!OUT_FP8, "bf16 U only");
    const int lane = C.lane; const bool up = lane >= 32;
    f32x4 gv[2][2];
#pragma unroll
    for (int jj = 0; jj < 2; ++jj) { gv[jj][0] = *(const f32x4*)(ng + 512 * jj + 8 * lane); gv[jj][1] = *(const f32x4*)(ng + 512 * jj + 8 * lane + 4); }
    auto half_sum = [&](float v) { v += dpp_f<0xB1>(v); v += dpp_f<0x4E>(v); v += dpp_f<0x141>(v); v += dpp_f<0x140>(v);
        const float lo = rdlane_f(v, 0) + rdlane_f(v, 16), hi = rdlane_f(v, 32) + rdlane_f(v, 48); return up ? hi : lo; };
    u32x4 na[2], nb[2], no[2], ma[2], mb[2], mo[2];
    { const int row = r0, r2 = r0 + rs;
#pragma unroll
      for (int jj = 0; jj < 2; ++jj) { na[jj] = ((const u32x4*)(H1 + (size_t)row * DM))[lane + 64 * jj]; nb[jj] = ((const u32x4*)(H2 + (size_t)row * DM))[lane + 64 * jj]; no[jj] = ((const u32x4*)(Zo + (size_t)row * ldz))[lane + 64 * jj];
          ma[jj] = ((const u32x4*)(H1 + (size_t)r2 * DM))[lane + 64 * jj]; mb[jj] = ((const u32x4*)(H2 + (size_t)r2 * DM))[lane + 64 * jj]; mo[jj] = ((const u32x4*)(Zo + (size_t)r2 * ldz))[lane + 64 * jj]; } }
    for (int k = 0; k < nr; ++k) { const int row = r0 + k * rs;
        u32x4 a4[2], b4[2], o4[2];
#pragma unroll
        for (int jj = 0; jj < 2; ++jj) { a4[jj] = na[jj]; b4[jj] = nb[jj]; o4[jj] = no[jj]; na[jj] = ma[jj]; nb[jj] = mb[jj]; no[jj] = mo[jj]; }
        { const int r2 = r0 + (k + 2 < nr ? k + 2 : nr - 1) * rs;
#pragma unroll
            for (int jj = 0; jj < 2; ++jj) { ma[jj] = ((const u32x4*)(H1 + (size_t)r2 * DM))[lane + 64 * jj]; mb[jj] = ((const u32x4*)(H2 + (size_t)r2 * DM))[lane + 64 * jj]; mo[jj] = ((const u32x4*)(Zo + (size_t)r2 * ldz))[lane + 64 * jj]; } }
        u32x4* upp = (u32x4*)(U + (size_t)row * DM);
#pragma unroll
        for (int jj = 0; jj < 2; ++jj) {
            const u32x4 a = a4[jj], b = b4[jj], o = o4[jj];
            float v[8], ov[8];
#pragma unroll
            for (int q = 0; q < 4; ++q) { v[2 * q] = bf_lo(a[q]) + bf_lo(b[q]); v[2 * q + 1] = bf_hi(a[q]) + bf_hi(b[q]); ov[2 * q] = bf_lo(o[q]); ov[2 * q + 1] = bf_hi(o[q]); }
            const float mean = half_sum(((v[0] + v[1]) + (v[2] + v[3])) + ((v[4] + v[5]) + (v[6] + v[7]))) * (1.f / 256.f);
            float s2 = 0.f;
#pragma unroll
            for (int q = 0; q < 8; ++q) { v[q] -= mean; s2 += v[q] * v[q]; }
            const float rstd = 1.f / sqrtf(half_sum(s2) * (1.f / 256.f) + LN_EPS);
            float r[8];
#pragma unroll
            for (int q = 0; q < 8; ++q) { const float hn = v[q] * rstd * gv[jj][q >> 2][q & 3]; r[q] = (ACT == 0 ? sigmoidf_(ov[q]) : siluf_(ov[q])) * hn; }
            u32x4 w; w.x = cvt_pk_bf16(r[0], r[1]); w.y = cvt_pk_bf16(r[2], r[3]); w.z = cvt_pk_bf16(r[4], r[5]); w.w = cvt_pk_bf16(r[6], r[7]);
            upp[lane + 64 * jj] = w;
        }
    }
}
#define KSWZ(row, colB) ((row) * 256 + ((colB) ^ (((row) & 7) << 4)))
#define SSWZ(row, colB) ((row) * 128 + ((colB) ^ ((((row) >> 1) & 7) << 4)))
__device__ __forceinline__ int crow(int r, int hi) { return (r & 3) + 8 * (r >> 2) + 4 * hi; }
__device__ __forceinline__ int v_st(int k, int c) { const int kk = (k & ~0xC) | ((k & 4) << 1) | ((k & 8) >> 1); return ((kk >> 3) * 4 + (c >> 5)) * 512 + ((kk & 7) * 32 + (c & 31)) * 2; }
__device__ __forceinline__ int v_rd_base(int lane) { return ((lane & 3) << 3) | (((lane >> 2) & 3) << 6) | (((lane >> 4) & 1) << 5) | (((lane >> 5) & 1) << 8); }
constexpr int v_rd_off(int d0, int ks, int half) { return d0 * 512 + ks * 4096 + half * 2048; }
template <int OFF> __device__ __forceinline__ s16x4 tr_read(int vb) {
    s16x4 r; asm volatile("ds_read_b64_tr_b16 %0, %1 offset:%2" : "=&v"(r) : "v"(vb), "i"(OFF) : "memory"); return r;
}
#define PKLH(L, H) (bf16x8){L[0], L[1], L[2], L[3], H[0], H[1], H[2], H[3]}
template <int D0, int KS> __device__ __forceinline__ bf16x8 tr_frag(int vb) {
    const s16x4 l = tr_read<v_rd_off(D0, KS, 0)>(vb), h = tr_read<v_rd_off(D0, KS, 1)>(vb); LDS_WAIT(); __builtin_amdgcn_sched_barrier(0); return PKLH(l, h);
}
template <int D0> __device__ __forceinline__ void tr_frag4(int vb, bf16x8& f0, bf16x8& f1, bf16x8& f2, bf16x8& f3) {
    const s16x4 l0 = tr_read<v_rd_off(D0, 0, 0)>(vb), h0 = tr_read<v_rd_off(D0, 0, 1)>(vb), l1 = tr_read<v_rd_off(D0, 1, 0)>(vb), h1 = tr_read<v_rd_off(D0, 1, 1)>(vb);
    const s16x4 l2 = tr_read<v_rd_off(D0, 2, 0)>(vb), h2 = tr_read<v_rd_off(D0, 2, 1)>(vb), l3 = tr_read<v_rd_off(D0, 3, 0)>(vb), h3 = tr_read<v_rd_off(D0, 3, 1)>(vb);
    LDS_WAIT(); __builtin_amdgcn_sched_barrier(0); f0 = PKLH(l0, h0); f1 = PKLH(l1, h1); f2 = PKLH(l2, h2); f3 = PKLH(l3, h3);
}
template <int D0> __device__ __forceinline__ void tr_frag2(int vb, bf16x8& f0, bf16x8& f1) {
    const s16x4 l0 = tr_read<v_rd_off(D0, 0, 0)>(vb), h0 = tr_read<v_rd_off(D0, 0, 1)>(vb), l1 = tr_read<v_rd_off(D0, 1, 0)>(vb), h1 = tr_read<v_rd_off(D0, 1, 1)>(vb);
    LDS_WAIT(); __builtin_amdgcn_sched_barrier(0); f0 = PKLH(l0, h0); f1 = PKLH(l1, h1);
}
__device__ __forceinline__ bf16x8 as_bf16x8(u32x4 w) { return __builtin_bit_cast(bf16x8, w); }
__device__ __forceinline__ int lds_addr(LAS unsigned char* p) { return (int)(uintptr_t)p; }

__device__ __forceinline__ void mlstm_chain(Ctx& C) {
    const bf16_t* Z = (const bf16_t*)(C.ws + WS_Z); const float* gates = (const float*)(C.ws + WS_SMALL + SM_GATES);
    LAS unsigned char* L = C.lds;
    constexpr int QS = 0, KS_ = 16384, KT = 32768, VT = 49152, SS = 81920, FA = 90112, GA = 98304;
    LAS float* RD = (LAS float*)(L + FA); LAS float* QN = RD + 64; LAS float* NV = RD + 128; LAS float* NP = RD + 256;
    LAS float* BC = (LAS float*)(L + GA); LAS float* AV = BC + 2048; LAS float* CM = BC + 4096;
    const int tid0 = C.tid, w = C.wave;
    for (int chain = blockIdx.x; chain < 256; chain += C.G) {
        const int dir = chain >> 7, b = (chain >> 2) & 31, h = chain & 3;
        bf16_t* Hout = (bf16_t*)(C.ws + WS_H) + (size_t)dir * NT * DM;
        int tid = tid0, lane = tid & 63, r32 = lane & 31, hi = lane >> 5;
#define REOPAQUE() do { tid = opaque(tid0); lane = tid & 63; r32 = lane & 31; hi = lane >> 5; } while (0)
        f32x16 Cst[4];
#pragma unroll
        for (int j = 0; j < 4; ++j) Cst[j] = (f32x16){};
        if (tid < 128) NV[tid] = 0.f;
        auto tok_of = [&](int c, int j) { const int cidx = dir ? 31 - c : c; return b * SEQ + cidx * 64 + (dir ? 63 - j : j); };
#pragma unroll 1
        for (int cc = w; cc < 32; cc += 8) {
            const size_t t = (size_t)tok_of(cc, lane) * 16; const float ig = gates[t + dir * 8 + h], fg = gates[t + dir * 8 + 4 + h];
            float bc = logsigmoidf_(fg);
#pragma unroll
            for (int o = 1; o < 64; o <<= 1) { const float x = __shfl_up(bc, o); if (lane >= o) bc += x; }
            const float a = ig - bc; float cm = a;
#pragma unroll
            for (int o = 1; o < 64; o <<= 1) { const float x = __shfl_up(cm, o); if (lane >= o) cm = fmaxf(cm, x); }
            BC[cc * 64 + lane] = bc; AV[cc * 64 + lane] = a; CM[cc * 64 + lane] = cm;
        }
        float mcar = 0.f;
        u32x4 pq[2], pk[2], pv[4];
        auto prefetch = [&](int c) {
#pragma unroll
            for (int i = 0; i < 2; ++i) { const int cid = tid + 512 * i, row = cid >> 4, cc = cid & 15; const size_t t = (size_t)tok_of(c, row) * 3072;
                pq[i] = *(const u32x4*)(Z + t + h * 128 + cc * 8); pk[i] = *(const u32x4*)(Z + t + 512 + h * 128 + cc * 8); }
#pragma unroll
            for (int i = 0; i < 4; ++i) { const int cid = tid + 512 * i, row = cid >> 5, cc = cid & 31; pv[i] = *(const u32x4*)(Z + (size_t)tok_of(c, row) * 3072 + 1024 + h * 256 + cc * 8); }
        };
        prefetch(0);
        __syncthreads();
        for (int c = 0; c < 32; ++c) {
            REOPAQUE();
            const float M63 = fmaxf(mcar, CM[c * 64 + 63]), wc = __expf(mcar - M63);
#pragma unroll
            for (int i = 0; i < 2; ++i) { const int cid = tid + 512 * i, row = cid >> 4, cc = cid & 15;
                *(LAS u32x4*)(L + QS + KSWZ(row, cc * 16)) = pq[i]; *(LAS u32x4*)(L + KS_ + KSWZ(row, cc * 16)) = pk[i];
                const float ws = __expf(AV[c * 64 + row] - M63); u32x4 kw;
                kw.x = cvt_pk_bf16(bf_lo(pk[i].x) * ws, bf_hi(pk[i].x) * ws); kw.y = cvt_pk_bf16(bf_lo(pk[i].y) * ws, bf_hi(pk[i].y) * ws);
                kw.z = cvt_pk_bf16(bf_lo(pk[i].z) * ws, bf_hi(pk[i].z) * ws); kw.w = cvt_pk_bf16(bf_lo(pk[i].w) * ws, bf_hi(pk[i].w) * ws);
                *(LAS u32x4*)(L + KT + v_st(row, cc * 8)) = kw; }
#pragma unroll
            for (int i = 0; i < 4; ++i) { const int cid = tid + 512 * i, row = cid >> 5, cc = cid & 31; *(LAS u32x4*)(L + VT + (cc >> 4) * 16384 + v_st(row, (cc & 15) * 8)) = pv[i]; }
            if (c + 1 < 32) prefetch(c + 1);
            __syncthreads();
            REOPAQUE();
            if (w < 4) {
                const int ti = w >> 1, si = w & 1;
                if (si > ti) {
#pragma unroll
                    for (int i = 0; i < 4; ++i) *(LAS u32x2*)(L + SS + SSWZ(32 * ti + r32, (32 * si + 8 * i + 4 * hi) * 2)) = (u32x2){0u, 0u};
                } else {
                    f32x16 acc = (f32x16){};
#pragma unroll
                    for (int kk = 0; kk < 8; ++kk) { const int cb = (16 * kk + 8 * hi) * 2;
                        const bf16x8 kf = *(const LAS bf16x8*)(L + KS_ + KSWZ(32 * si + r32, cb)); const bf16x8 qf = *(const LAS bf16x8*)(L + QS + KSWZ(32 * ti + r32, cb));
                        acc = __builtin_amdgcn_mfma_f32_32x32x16_bf16(kf, qf, acc, 0, 0, 0); }
                    const int t = 32 * ti + r32; const float Mt = fmaxf(mcar, CM[c * 64 + t]);
#pragma unroll
                    for (int i = 0; i < 4; ++i) { const int s0 = 32 * si + 8 * i + 4 * hi; const f32x4 a4 = *(const LAS f32x4*)(AV + c * 64 + s0);
                        float v[4];
#pragma unroll
                        for (int q = 0; q < 4; ++q) v[q] = (s0 + q <= t) ? acc[4 * i + q] * __expf(a4[q] - Mt) : 0.f;
                        u32x2 o; o.x = cvt_pk_bf16(v[0], v[1]); o.y = cvt_pk_bf16(v[2], v[3]);
                        *(LAS u32x2*)(L + SS + SSWZ(t, s0 * 2)) = o; }
                }
            } else {
                const int t = (tid - 256) >> 2, seg = tid & 3; float a = 0.f;
#pragma unroll
                for (int i = 0; i < 4; ++i) { const u32x4 qv = *(const LAS u32x4*)(L + QS + KSWZ(t, (seg * 32 + i * 8) * 2)); const LAS float* nv = NV + seg * 32 + i * 8;
                    a += bf_lo(qv.x) * nv[0] + bf_hi(qv.x) * nv[1] + bf_lo(qv.y) * nv[2] + bf_hi(qv.y) * nv[3] + bf_lo(qv.z) * nv[4] + bf_hi(qv.z) * nv[5] + bf_lo(qv.w) * nv[6] + bf_hi(qv.w) * nv[7]; }
                a += __shfl_xor(a, 1); a += __shfl_xor(a, 2);
                if (seg == 0) QN[t] = a;
            }
            __syncthreads();
            REOPAQUE();
            { const int t = tid >> 3, seg = tid & 7; const u32x4 sv = *(const LAS u32x4*)(L + SS + SSWZ(t, seg * 16));
              float rs = (bf_lo(sv.x) + bf_hi(sv.x)) + (bf_lo(sv.y) + bf_hi(sv.y)) + (bf_lo(sv.z) + bf_hi(sv.z)) + (bf_lo(sv.w) + bf_hi(sv.w));
              rs += __shfl_xor(rs, 1); rs += __shfl_xor(rs, 2); rs += __shfl_xor(rs, 4);
              if (seg == 0) { const float Mt = fmaxf(mcar, CM[c * 64 + t]); const float den = rs + __expf(mcar - Mt) * QN[t]; RD[t] = 1.0f / fmaxf(fabsf(den), __expf(-(BC[c * 64 + t] + Mt))); } }
            { const int dk = tid & 127, part = tid >> 7; float a = 0.f;
              const LAS unsigned char* kp = L + KT + part * 4096 + (dk >> 5) * 512 + (dk & 31) * 2;
#pragma unroll
              for (int i = 0; i < 16; ++i) a += bf2f(*(const LAS bf16_t*)(kp + (i >> 3) * 2048 + (i & 7) * 64));
              NP[part * 128 + dk] = a; }
            __builtin_amdgcn_sched_barrier(0);
            const int vbV = lds_addr(L + VT) + v_rd_base(lane) + (w & 3) * 512 + (w >> 2) * 16384;
            const int vbK = lds_addr(L + KT) + v_rd_base(lane);
            f32x16 Y[2] = {(f32x16){}, (f32x16){}};
#pragma unroll
            for (int jd = 0; jd < 4; ++jd)
#pragma unroll
                for (int s = 0; s < 2; ++s) {
                    u32x4 cw; cw.x = cvt_pk_bf16(Cst[jd][8 * s + 0], Cst[jd][8 * s + 1]); cw.y = cvt_pk_bf16(Cst[jd][8 * s + 2], Cst[jd][8 * s + 3]);
                    cw.z = cvt_pk_bf16(Cst[jd][8 * s + 4], Cst[jd][8 * s + 5]); cw.w = cvt_pk_bf16(Cst[jd][8 * s + 6], Cst[jd][8 * s + 7]);
                    const bf16x8 bfr = as_bf16x8(cw); const int cb = (32 * jd + 16 * s + 4 * hi) * 2;
#pragma unroll
                    for (int ti = 0; ti < 2; ++ti) { const u32x2 lo = *(const LAS u32x2*)(L + QS + KSWZ(32 * ti + r32, cb)), hi2 = *(const LAS u32x2*)(L + QS + KSWZ(32 * ti + r32, cb + 16));
                        const bf16x8 afr = as_bf16x8((u32x4){lo.x, lo.y, hi2.x, hi2.y});
                        Y[ti] = __builtin_amdgcn_mfma_f32_32x32x16_bf16(afr, bfr, Y[ti], 0, 0, 0); }
                    __builtin_amdgcn_sched_barrier(0);
                }
#pragma unroll
            for (int ti = 0; ti < 2; ++ti)
#pragma unroll
                for (int i = 0; i < 4; ++i) { const f32x4 c4 = *(const LAS f32x4*)(CM + c * 64 + 32 * ti + 8 * i + 4 * hi);
#pragma unroll
                    for (int q = 0; q < 4; ++q) Y[ti][4 * i + q] *= __expf(mcar - fmaxf(mcar, c4[q])); }
            __builtin_amdgcn_sched_barrier(0);
            bf16x8 vf0, vf1, vf2, vf3; tr_frag4<0>(vbV, vf0, vf1, vf2, vf3);
#pragma unroll
            for (int ti = 0; ti < 2; ++ti) {
                const bf16x8 a0 = *(const LAS bf16x8*)(L + SS + SSWZ(32 * ti + r32, (0 + 8 * hi) * 2)), a1 = *(const LAS bf16x8*)(L + SS + SSWZ(32 * ti + r32, (16 + 8 * hi) * 2));
                Y[ti] = __builtin_amdgcn_mfma_f32_32x32x16_bf16(a0, vf0, Y[ti], 0, 0, 0); Y[ti] = __builtin_amdgcn_mfma_f32_32x32x16_bf16(a1, vf1, Y[ti], 0, 0, 0);
                if (ti == 1) { const bf16x8 a2 = *(const LAS bf16x8*)(L + SS + SSWZ(32 + r32, (32 + 8 * hi) * 2)), a3 = *(const LAS bf16x8*)(L + SS + SSWZ(32 + r32, (48 + 8 * hi) * 2));
                    Y[1] = __builtin_amdgcn_mfma_f32_32x32x16_bf16(a2, vf2, Y[1], 0, 0, 0); Y[1] = __builtin_amdgcn_mfma_f32_32x32x16_bf16(a3, vf3, Y[1], 0, 0, 0); }
            }
            __builtin_amdgcn_sched_barrier(0);
#define ML_UPD(JD) { Cst[JD] = Cst[JD] * wc; bf16x8 k0_, k1_, k2_, k3_; tr_frag4<JD>(vbK, k0_, k1_, k2_, k3_); \
                Cst[JD] = __builtin_amdgcn_mfma_f32_32x32x16_bf16(k0_, vf0, Cst[JD], 0, 0, 0); Cst[JD] = __builtin_amdgcn_mfma_f32_32x32x16_bf16(k1_, vf1, Cst[JD], 0, 0, 0); \
                Cst[JD] = __builtin_amdgcn_mfma_f32_32x32x16_bf16(k2_, vf2, Cst[JD], 0, 0, 0); Cst[JD] = __builtin_amdgcn_mfma_f32_32x32x16_bf16(k3_, vf3, Cst[JD], 0, 0, 0); }
            ML_UPD(0) __builtin_amdgcn_sched_barrier(0); ML_UPD(1) __builtin_amdgcn_sched_barrier(0); ML_UPD(2) __builtin_amdgcn_sched_barrier(0); ML_UPD(3)
#undef ML_UPD
            __syncthreads();
            REOPAQUE();
            if (tid < 128) NV[tid] = wc * NV[tid] + (NP[tid] + NP[128 + tid]) + (NP[256 + tid] + NP[384 + tid]);
#pragma unroll
            for (int ti = 0; ti < 2; ++ti)
#pragma unroll
                for (int i = 0; i < 4; ++i) { const f32x4 r4 = *(const LAS f32x4*)(RD + 32 * ti + 8 * i + 4 * hi);
#pragma unroll
                    for (int q = 0; q < 4; ++q) { const int t = 32 * ti + 8 * i + 4 * hi + q;
                        Hout[(size_t)tok_of(c, t) * DM + h * 256 + 32 * w + r32] = f2bf(Y[ti][4 * i + q] * r4[q]); } }
            mcar = BC[c * 64 + 63] + M63;
        }
#undef REOPAQUE
        __syncthreads();
    }
}

__device__ __forceinline__ void gla_chain(Ctx& C) {
    const bf16_t* Z = (const bf16_t*)(C.ws + WS_Z); const float* glr = (const float*)(C.ws + WS_SMALL + SM_GATES);
    LAS unsigned char* L = C.lds;
    constexpr int QE = 0, KE = 8192, KG = 16384, VT = 32768, BL = 65536, FA = 81920;
    LAS float* BLf = (LAS float*)(L + BL);
    LAS float* GT = (LAS float*)(L + FA); LAS float* EG = GT + 128;
    const int tid0 = C.tid, w = C.wave;
    for (int chain = blockIdx.x; chain < 256; chain += C.G) {
        const int dir = chain >> 7, b = (chain >> 2) & 31, h = chain & 3;
        bf16_t* Hout = (bf16_t*)(C.ws + WS_H) + (size_t)dir * NT * DM;
        int tid = tid0, lane = tid & 63, r32 = lane & 31, hi = lane >> 5;
#define REOPAQUE() do { tid = opaque(tid0); lane = tid & 63; r32 = lane & 31; hi = lane >> 5; } while (0)
        bf16x8 gwf; float gbias;
        { const int dkc = h * 128 + (w & 3) * 32 + r32; const float* gwp = IN_F(I_GL_GW) + (size_t)dir * 16 * 512 + dkc; float g8[8];
#pragma unroll
          for (int j = 0; j < 8; ++j) g8[j] = gwp[(size_t)(8 * hi + j) * 512];
          u32x4 gp; gp.x = cvt_pk_bf16(g8[0], g8[1]); gp.y = cvt_pk_bf16(g8[2], g8[3]); gp.z = cvt_pk_bf16(g8[4], g8[5]); gp.w = cvt_pk_bf16(g8[6], g8[7]); gwf = as_bf16x8(gp);
          gbias = IN_F(I_GL_GB)[dir * 512 + dkc]; }
        f32x16 St[4];
#pragma unroll
        for (int j = 0; j < 4; ++j) St[j] = (f32x16){};
        struct PF { u32x4 pq, pk, pv0, pv1; f32x4 pg0, pg1; };
        PF S0, S1; S0.pg0 = S0.pg1 = S1.pg0 = S1.pg1 = (f32x4){0.f, 0.f, 0.f, 0.f};
        auto tok_of = [&](int c, int j) { const int cidx = dir ? 63 - c : c; return b * SEQ + cidx * 32 + (dir ? 31 - j : j); };
        auto prefetch = [&](int c, PF& P) {
            { const int row = tid >> 4, cc = tid & 15; const size_t t = (size_t)tok_of(c, row) * 3072; P.pq = *(const u32x4*)(Z + t + h * 128 + cc * 8); P.pk = *(const u32x4*)(Z + t + 512 + h * 128 + cc * 8); }
            { const int row = tid >> 5, cc = tid & 31; P.pv0 = *(const u32x4*)(Z + (size_t)tok_of(c, row) * 3072 + 1024 + h * 256 + cc * 8); P.pv1 = *(const u32x4*)(Z + (size_t)tok_of(c, 16 + row) * 3072 + 1024 + h * 256 + cc * 8); }
            if (w < 4) { const float* gp = glr + (size_t)tok_of(c, r32) * 32 + dir * 16 + 8 * hi; P.pg0 = *(const f32x4*)gp; P.pg1 = *(const f32x4*)(gp + 4); }
        };
        prefetch(0, S0); prefetch(1, S1);
        auto chunk = [&](const int c, PF& P) {
            REOPAQUE();
            if (w < 4) {
                u32x4 ap; ap.x = cvt_pk_bf16(P.pg0[0], P.pg0[1]); ap.y = cvt_pk_bf16(P.pg0[2], P.pg0[3]); ap.z = cvt_pk_bf16(P.pg1[0], P.pg1[1]); ap.w = cvt_pk_bf16(P.pg1[2], P.pg1[3]);
                f32x16 lg = __builtin_amdgcn_mfma_f32_32x32x16_bf16(as_bf16x8(ap), gwf, (f32x16){}, 0, 0, 0);
                float T[4];
#pragma unroll
                for (int i = 0; i < 4; ++i) { float run = 0.f;
#pragma unroll
                    for (int q = 0; q < 4; ++q) { run += logsigmoid_fast(lg[4 * i + q] + gbias) * (1.0f / 16.0f); lg[4 * i + q] = run; }
                    T[i] = run; }
                float O[4];
#pragma unroll
                for (int i = 0; i < 4; ++i) { auto rr = __builtin_amdgcn_permlane32_swap(__float_as_uint(T[i]), __float_as_uint(T[i]), false, false); O[i] = __uint_as_float(hi ? rr[0] : rr[1]); }
                float off = hi ? O[0] : 0.f;
#pragma unroll
                for (int i = 0; i < 4; ++i) {
#pragma unroll
                    for (int q = 0; q < 4; ++q) BLf[(8 * i + 4 * hi + q) * 128 + 32 * w + r32] = off + lg[4 * i + q];
                    off += T[i] + (hi ? (i < 3 ? O[i + 1] : 0.f) : O[i]); }
                if (hi == 0) { const float g = (T[0] + T[1]) + (T[2] + T[3]) + (O[0] + O[1]) + (O[2] + O[3]); GT[32 * w + r32] = g; EG[(c & 1) * 128 + 32 * w + r32] = __expf(g); }
            }
            __syncthreads();
            REOPAQUE();
            { const int row = tid >> 5, cc = tid & 31; *(LAS u32x4*)(L + VT + (cc >> 4) * 16384 + v_st(row, (cc & 15) * 8)) = P.pv0; *(LAS u32x4*)(L + VT + (cc >> 4) * 16384 + v_st(16 + row, (cc & 15) * 8)) = P.pv1; }
            { const int row = tid >> 4, cc = tid & 15; const LAS float* br = BLf + row * 128 + cc * 8; const LAS float* gp = GT + cc * 8;
              const f32x4 b0 = *(const LAS f32x4*)br, b1 = *(const LAS f32x4*)(br + 4), g0 = *(const LAS f32x4*)gp, g1 = *(const LAS f32x4*)(gp + 4);
              float bv[8] = {b0[0], b0[1], b0[2], b0[3], b1[0], b1[1], b1[2], b1[3]}, gv[8] = {g0[0], g0[1], g0[2], g0[3], g1[0], g1[1], g1[2], g1[3]};
              const u32x4 pq = P.pq, pk = P.pk;
              float qf[8] = {bf_lo(pq.x), bf_hi(pq.x), bf_lo(pq.y), bf_hi(pq.y), bf_lo(pq.z), bf_hi(pq.z), bf_lo(pq.w), bf_hi(pq.w)};
              float kf[8] = {bf_lo(pk.x), bf_hi(pk.x), bf_lo(pk.y), bf_hi(pk.y), bf_lo(pk.z), bf_hi(pk.z), bf_lo(pk.w), bf_hi(pk.w)};
              float qe[8], ke[8], kg[8];
#pragma unroll
              for (int j = 0; j < 8; ++j) { const float eb = __expf(bv[j]), ib = __builtin_amdgcn_rcpf(eb); qe[j] = qf[j] * eb; ke[j] = kf[j] * ib; kg[j] = ke[j] * __expf(gv[j]); }
              u32x4 o;
              o.x = cvt_pk_bf16(qe[0], qe[1]); o.y = cvt_pk_bf16(qe[2], qe[3]); o.z = cvt_pk_bf16(qe[4], qe[5]); o.w = cvt_pk_bf16(qe[6], qe[7]); *(LAS u32x4*)(L + QE + KSWZ(row, cc * 16)) = o;
              o.x = cvt_pk_bf16(ke[0], ke[1]); o.y = cvt_pk_bf16(ke[2], ke[3]); o.z = cvt_pk_bf16(ke[4], ke[5]); o.w = cvt_pk_bf16(ke[6], ke[7]); *(LAS u32x4*)(L + KE + KSWZ(row, cc * 16)) = o;
              o.x = cvt_pk_bf16(kg[0], kg[1]); o.y = cvt_pk_bf16(kg[2], kg[3]); o.z = cvt_pk_bf16(kg[4], kg[5]); o.w = cvt_pk_bf16(kg[6], kg[7]); *(LAS u32x4*)(L + KG + v_st(row, cc * 8)) = o; }
            if (c + 2 < 64) prefetch(c + 2, P);
            __syncthreads();
            REOPAQUE();
            const int vbV = lds_addr(L + VT) + v_rd_base(lane) + (w & 3) * 512 + (w >> 2) * 16384;
            const int vbK = lds_addr(L + KG) + v_rd_base(lane);
            f32x16 acc = (f32x16){};
#pragma unroll
            for (int kk = 0; kk < 8; ++kk) { const int cb = (16 * kk + 8 * hi) * 2;
                const bf16x8 kf = *(const LAS bf16x8*)(L + KE + KSWZ(r32, cb)); const bf16x8 qf = *(const LAS bf16x8*)(L + QE + KSWZ(r32, cb));
                acc = __builtin_amdgcn_mfma_f32_32x32x16_bf16(kf, qf, acc, 0, 0, 0); }
#pragma unroll
            for (int r = 0; r < 16; ++r) acc[r] = (crow(r, hi) <= r32) ? acc[r] : 0.f;
            bf16x8 pa0, pa1;
#define PK4(P, BASE, OUT) do { unsigned a0 = cvt_pk_bf16(P[BASE + 0], P[BASE + 1]), a1 = cvt_pk_bf16(P[BASE + 2], P[BASE + 3]);   \
    unsigned b0 = cvt_pk_bf16(P[BASE + 4], P[BASE + 5]), b1 = cvt_pk_bf16(P[BASE + 6], P[BASE + 7]);                              \
    auto r0 = __builtin_amdgcn_permlane32_swap(a0, b0, false, false); auto r1 = __builtin_amdgcn_permlane32_swap(a1, b1, false, false); \
    u32x4 wv = {r0[0], r1[0], r0[1], r1[1]}; OUT = as_bf16x8(wv); } while (0)
            PK4(acc, 0, pa0); PK4(acc, 8, pa1);
#undef PK4
            f32x16 Y = (f32x16){};
#pragma unroll
            for (int jd = 0; jd < 4; ++jd)
#pragma unroll
                for (int s = 0; s < 2; ++s) {
                    u32x4 cw; cw.x = cvt_pk_bf16(St[jd][8 * s + 0], St[jd][8 * s + 1]); cw.y = cvt_pk_bf16(St[jd][8 * s + 2], St[jd][8 * s + 3]);
                    cw.z = cvt_pk_bf16(St[jd][8 * s + 4], St[jd][8 * s + 5]); cw.w = cvt_pk_bf16(St[jd][8 * s + 6], St[jd][8 * s + 7]);
                    const int cb = (32 * jd + 16 * s + 4 * hi) * 2;
                    const u32x2 lo = *(const LAS u32x2*)(L + QE + KSWZ(r32, cb)), hi2 = *(const LAS u32x2*)(L + QE + KSWZ(r32, cb + 16));
                    Y = __builtin_amdgcn_mfma_f32_32x32x16_bf16(as_bf16x8((u32x4){lo.x, lo.y, hi2.x, hi2.y}), as_bf16x8(cw), Y, 0, 0, 0);
                }
            bf16x8 vf0, vf1; tr_frag2<0>(vbV, vf0, vf1);
            Y = __builtin_amdgcn_mfma_f32_32x32x16_bf16(pa0, vf0, Y, 0, 0, 0); Y = __builtin_amdgcn_mfma_f32_32x32x16_bf16(pa1, vf1, Y, 0, 0, 0);
#define GL_UPD(JD) { _Pragma("unroll") for (int i = 0; i < 4; ++i) { const f32x4 e4 = *(const LAS f32x4*)(EG + (c & 1) * 128 + 32 * JD + 8 * i + 4 * hi); \
                    _Pragma("unroll") for (int q = 0; q < 4; ++q) St[JD][4 * i + q] *= e4[q]; } \
                bf16x8 k0_, k1_; tr_frag2<JD>(vbK, k0_, k1_); St[JD] = __builtin_amdgcn_mfma_f32_32x32x16_bf16(k0_, vf0, St[JD], 0, 0, 0); St[JD] = __builtin_amdgcn_mfma_f32_32x32x16_bf16(k1_, vf1, St[JD], 0, 0, 0); }
            GL_UPD(0) GL_UPD(1) GL_UPD(2) GL_UPD(3)
#undef GL_UPD
#pragma unroll
            for (int r = 0; r < 16; ++r) Hout[(size_t)tok_of(c, crow(r, hi)) * DM + h * 256 + 32 * w + r32] = f2bf(Y[r]);
        };
#pragma unroll 1
        for (int c = 0; c < 64; c += 2) { chunk(c, S0); chunk(c + 1, S1); }
#undef REOPAQUE
        __syncthreads();
    }
}
__device__ __forceinline__ void lru_conv(Ctx& C, const bf16_t* UR, bf16_t* UC) {
    const float* cw = IN_F(I_LR_CW); const float* cb = IN_F(I_LR_CB);
    const int c8 = (C.tid & 127) * 8;
    f32x4 w[4][2], bias[2];
#pragma unroll
    for (int k = 0; k < 4; ++k) { w[k][0] = *(const f32x4*)(cw + (size_t)k * DM + c8); w[k][1] = *(const f32x4*)(cw + (size_t)k * DM + c8 + 4); }
    bias[0] = *(const f32x4*)(cb + c8); bias[1] = *(const f32x4*)(cb + c8 + 4);
#pragma unroll 1
    for (int seg = blockIdx.x * 4 + (C.tid >> 7); seg < NT / 16; seg += C.G * 4) {
        const int t0 = seg * 16, s0 = t0 & 2047;
        u32x4 r[19];
#pragma unroll
        for (int q = 0; q < 19; ++q) { int tt = t0 - 2 + q; tt = tt < 0 ? 0 : (tt > NT - 1 ? NT - 1 : tt); r[q] = *(const u32x4*)(UR + (size_t)tt * DM + c8); }
        if (s0 == 0) { r[0] = (u32x4){0u, 0u, 0u, 0u}; r[1] = (u32x4){0u, 0u, 0u, 0u}; }
        if (s0 == SEQ - 16) r[18] = (u32x4){0u, 0u, 0u, 0u};
#pragma unroll
        for (int j = 0; j < 16; ++j) {
            f32x4 a0 = bias[0], a1 = bias[1];
#pragma unroll
            for (int k = 0; k < 4; ++k) { const u32x4 u = r[j + k];
                a0 += w[k][0] * (f32x4){bf_lo(u.x), bf_hi(u.x), bf_lo(u.y), bf_hi(u.y)}; a1 += w[k][1] * (f32x4){bf_lo(u.z), bf_hi(u.z), bf_lo(u.w), bf_hi(u.w)}; }
            u32x4 o; o.x = cvt_pk_bf16(a0[0], a0[1]); o.y = cvt_pk_bf16(a0[2], a0[3]); o.z = cvt_pk_bf16(a1[0], a1[1]); o.w = cvt_pk_bf16(a1[2], a1[3]);
            *(u32x4*)(UC + (size_t)(t0 + j) * DM + c8) = o;
        }
    }
}
__device__ __forceinline__ void lru_scan(Ctx& C, const bf16_t* LA0, const unsigned char* GT0, const bf16_t* LA1, const unsigned char* GT1, bf16_t* GBU, bf16_t* HF) {
    static_assert(!OUT_FP8, "this scan writes U as bf16 only");
    LAS float* PF = (LAS float*)C.lds; LAS float* EF = PF + 4096; LAS float* PB = PF + 8192; LAS float* EB = PF + 12288;
    const int lane = C.lane, cg = lane & 15, sg = C.wave * 4 + (lane >> 4);
#define LRU_UNPK(w, q, lo, hi) const float lo = bf_lo((w)[q]), hi = bf_hi((w)[q])
    for (int unit = blockIdx.x; unit < NB * 8; unit += C.G) {
        const int b = unit >> 3;
        const unsigned boff = (unsigned)((((size_t)b * SEQ + sg * 64) * DM + (unit & 7) * 128 + cg * 8) * 2);
        const int so = sg * 128 + cg * 8;
#define LRU_LD(P, t) (*(const u32x4*)((const char*)(P) + (size_t)(boff + (unsigned)((t) * (DM * 2)))))
#define LRU_ST(P, t, v) (*(u32x4*)((char*)(P) + (size_t)(boff + (unsigned)((t) * (DM * 2)))) = (v))
#define LRU_LD8(P, t) (*(const u32x2*)((const unsigned char*)(P) + (size_t)((boff >> 1) + (unsigned)((t) * DM))))
#define LRU_G8(w, gf) float gf[8]; { const f32x4 lo_ = unpk4_fp8((w).x), hi_ = unpk4_fp8((w).y); gf[0] = lo_[0]; gf[1] = lo_[1]; gf[2] = lo_[2]; gf[3] = lo_[3]; gf[4] = hi_[0]; gf[5] = hi_[1]; gf[6] = hi_[2]; gf[7] = hi_[3]; }
        auto pass1 = [&](const bf16_t* LA, const unsigned char* GT, int t0, int dt, LAS float* Pd, LAS float* Ed) {
            float p[8], e[8];
#pragma unroll
            for (int c = 0; c < 8; ++c) { p[c] = 0.f; e[c] = 0.f; }
            u32x4 lA[4], lB[4]; u32x2 gA[4], gB[4];
            auto ld = [&](int k, u32x4 (&l)[4], u32x2 (&g)[4]) {
#pragma unroll
                for (int j = 0; j < 4; ++j) { const int t = t0 + dt * (4 * k + j); l[j] = LRU_LD(LA, t); g[j] = LRU_LD8(GT, t); } };
            auto cp = [&](const u32x4 (&l)[4], const u32x2 (&g)[4]) {
#pragma unroll
                for (int j = 0; j < 4; ++j) { LRU_G8(g[j], gf);
#pragma unroll
                    for (int q = 0; q < 4; ++q) { LRU_UNPK(l[j], q, l0, l1);
                        e[2 * q] = __expf(l0) * e[2 * q] + gf[2 * q]; e[2 * q + 1] = __expf(l1) * e[2 * q + 1] + gf[2 * q + 1]; p[2 * q] += l0; p[2 * q + 1] += l1; } } };
            ld(0, lA, gA);
#pragma unroll 1
            for (int k = 0; k < 16; k += 2) {
                ld(k + 1, lB, gB); __builtin_amdgcn_sched_barrier(0); cp(lA, gA);
                ld(k + 2 < 16 ? k + 2 : 15, lA, gA); __builtin_amdgcn_sched_barrier(0); cp(lB, gB); }
            *(LAS f32x4*)(Pd + so) = (f32x4){p[0], p[1], p[2], p[3]}; *(LAS f32x4*)(Pd + so + 4) = (f32x4){p[4], p[5], p[6], p[7]};
            *(LAS f32x4*)(Ed + so) = (f32x4){e[0], e[1], e[2], e[3]}; *(LAS f32x4*)(Ed + so + 4) = (f32x4){e[4], e[5], e[6], e[7]}; };
        pass1(LA0, GT0, 0, 1, PF, EF);
        pass1(LA1, GT1, 63, -1, PB, EB);
        __syncthreads();
        float hf[8], hb[8];
#pragma unroll
        for (int c = 0; c < 8; ++c) { hf[c] = 0.f; hb[c] = 0.f; }
        for (int q = 0; q < sg; ++q) { const f32x4 pa = *(const LAS f32x4*)(PF + q * 128 + cg * 8), pb = *(const LAS f32x4*)(PF + q * 128 + cg * 8 + 4), ea = *(const LAS f32x4*)(EF + q * 128 + cg * 8), eb = *(const LAS f32x4*)(EF + q * 128 + cg * 8 + 4);
#pragma unroll
            for (int c = 0; c < 4; ++c) { hf[c] = __expf(pa[c]) * hf[c] + ea[c]; hf[4 + c] = __expf(pb[c]) * hf[4 + c] + eb[c]; } }
        for (int q = 31; q > sg; --q) { const f32x4 pa = *(const LAS f32x4*)(PB + q * 128 + cg * 8), pb = *(const LAS f32x4*)(PB + q * 128 + cg * 8 + 4), ea = *(const LAS f32x4*)(EB + q * 128 + cg * 8), eb = *(const LAS f32x4*)(EB + q * 128 + cg * 8 + 4);
#pragma unroll
            for (int c = 0; c < 4; ++c) { hb[c] = __expf(pa[c]) * hb[c] + ea[c]; hb[4 + c] = __expf(pb[c]) * hb[4 + c] + eb[c]; } }
        {
            u32x4 lA[4], lB[4]; u32x2 gA[4], gB[4];
            auto ld = [&](int k, u32x4 (&l)[4], u32x2 (&g)[4]) {
#pragma unroll
                for (int j = 0; j < 4; ++j) { l[j] = LRU_LD(LA0, 4 * k + j); g[j] = LRU_LD8(GT0, 4 * k + j); } };
            auto cp = [&](int k, const u32x4 (&l)[4], const u32x2 (&g)[4]) {
#pragma unroll
                for (int j = 0; j < 4; ++j) { u32x4 o; LRU_G8(g[j], gf);
#pragma unroll
                    for (int q = 0; q < 4; ++q) { LRU_UNPK(l[j], q, l0, l1);
                        hf[2 * q] = __expf(l0) * hf[2 * q] + gf[2 * q]; hf[2 * q + 1] = __expf(l1) * hf[2 * q + 1] + gf[2 * q + 1]; o[q] = cvt_pk_bf16(hf[2 * q], hf[2 * q + 1]); }
                    LRU_ST(HF, 4 * k + j, o); } };
            ld(0, lA, gA);
#pragma unroll 1
            for (int k = 0; k < 16; k += 2) {
                ld(k + 1, lB, gB); __builtin_amdgcn_sched_barrier(0); cp(k, lA, gA);
                ld(k + 2 < 16 ? k + 2 : 15, lA, gA); __builtin_amdgcn_sched_barrier(0); cp(k + 1, lB, gB); }
        }
        {
            u32x4 lA[2], fA[2], bA[2], lB[2], fB[2], bB[2]; u32x2 gA[2], gB[2];
            auto ld = [&](int k, u32x4 (&l)[2], u32x2 (&g)[2], u32x4 (&f)[2], u32x4 (&bb)[2]) {
#pragma unroll
                for (int j = 0; j < 2; ++j) { const int t = 63 - (2 * k + j); l[j] = LRU_LD(LA1, t); g[j] = LRU_LD8(GT1, t); f[j] = LRU_LD(HF, t); bb[j] = LRU_LD(GBU, t); } };
            auto cp = [&](int k, const u32x4 (&l)[2], const u32x2 (&g)[2], const u32x4 (&f)[2], const u32x4 (&bb)[2]) {
#pragma unroll
                for (int j = 0; j < 2; ++j) { u32x4 o; LRU_G8(g[j], gf);
#pragma unroll
                    for (int q = 0; q < 4; ++q) { LRU_UNPK(l[j], q, l0, l1); LRU_UNPK(f[j], q, f0, f1); LRU_UNPK(bb[j], q, x0, x1);
                        hb[2 * q] = __expf(l0) * hb[2 * q] + gf[2 * q]; hb[2 * q + 1] = __expf(l1) * hb[2 * q + 1] + gf[2 * q + 1];
                        o[q] = cvt_pk_bf16(gelu_tanh(x0) * ((hb[2 * q] + f0) * (1.0f / F8_SG)), gelu_tanh(x1) * ((hb[2 * q + 1] + f1) * (1.0f / F8_SG))); }
                    LRU_ST(GBU, 63 - (2 * k + j), o); } };
            ld(0, lA, gA, fA, bA);
#pragma unroll 1
            for (int k = 0; k < 32; k += 2) {
                ld(k + 1, lB, gB, fB, bB); __builtin_amdgcn_sched_barrier(0); cp(k, lA, gA, fA, bA);
                ld(k + 2 < 32 ? k + 2 : 31, lA, gA, fA, bA); __builtin_amdgcn_sched_barrier(0); cp(k + 1, lB, gB, fB, bB); }
        }
        __syncthreads();
    }
#undef LRU_LD
#undef LRU_LD8
#undef LRU_G8
#undef LRU_ST
#undef LRU_UNPK
}
__device__ __forceinline__ void mla_norm_rope(Ctx& C, const bf16_t* Zm, bf16_t* CQN, bf16_t* CKVN, bf16_t* Kc, int r0, int rs, int nr) {
    const float* qg = IN_F(I_MA_QG); const float* kvg = IN_F(I_MA_KVG);
    const float* cs = (const float*)(C.ws + WS_ROPE); const float* sn = cs + (size_t)NT * 32;
    const int lane = C.lane;
    const int i0r = 4 * (lane & 7);
    const f32x4 gq0 = *(const f32x4*)(qg + 4 * lane), g1 = lane < 32 ? *(const f32x4*)(qg + 256 + 4 * lane) : *(const f32x4*)(kvg + 4 * (lane - 32)), g2 = *(const f32x4*)(kvg + 128 + 4 * (lane & 31));
    u32x2 zc[3], zn[3]; f32x4 cc, sc, cn, sn2;
    { const u32x2* zr = (const u32x2*)(Zm + (size_t)r0 * 768);
#pragma unroll
      for (int j = 0; j < 3; ++j) zc[j] = zr[lane + 64 * j];
      cc = *(const f32x4*)(cs + (size_t)r0 * 32 + i0r); sc = *(const f32x4*)(sn + (size_t)r0 * 32 + i0r); }
    for (int k = 0; k < nr; ++k) { const int row = r0 + k * rs;
        { const int rn = r0 + (k + 1 < nr ? k + 1 : nr - 1) * rs; const u32x2* zr = (const u32x2*)(Zm + (size_t)rn * 768);
#pragma unroll
          for (int j = 0; j < 3; ++j) zn[j] = zr[lane + 64 * j];
          cn = *(const f32x4*)(cs + (size_t)rn * 32 + i0r); sn2 = *(const f32x4*)(sn + (size_t)rn * 32 + i0r); }
        f32x4 v[3];
#pragma unroll
        for (int j = 0; j < 3; ++j) { const u32x2 w = zc[j]; v[j] = (f32x4){bf_lo(w.x), bf_hi(w.x), bf_lo(w.y), bf_hi(w.y)}; zc[j] = zn[j]; }
        const f32x4 c = cc, s = sc; cc = cn; sc = sn2;
        const float sq0 = (v[0][0] * v[0][0] + v[0][1] * v[0][1]) + (v[0][2] * v[0][2] + v[0][3] * v[0][3]);
        const float sq1 = (v[1][0] * v[1][0] + v[1][1] * v[1][1]) + (v[1][2] * v[1][2] + v[1][3] * v[1][3]);
        const float sq2 = (v[2][0] * v[2][0] + v[2][1] * v[2][1]) + (v[2][2] * v[2][2] + v[2][3] * v[2][3]);
        const float ssq_q = wave_sum(sq0 + (lane < 32 ? sq1 : 0.f)), ssq_kv = wave_sum((lane >= 32 ? sq1 : 0.f) + (lane < 32 ? sq2 : 0.f));
        const float rq = 1.f / sqrtf(ssq_q * (1.f / 384.f) + LN_EPS), rkv = 1.f / sqrtf(ssq_kv * (1.f / 256.f) + LN_EPS);
        { const f32x4 o = v[0] * rq * gq0; u32x2 w; w.x = cvt_pk_bf16(o[0], o[1]); w.y = cvt_pk_bf16(o[2], o[3]); *(u32x2*)(CQN + (size_t)row * 384 + 4 * lane) = w; }
        if (lane < 32) { const f32x4 o = v[1] * rq * g1; u32x2 w; w.x = cvt_pk_bf16(o[0], o[1]); w.y = cvt_pk_bf16(o[2], o[3]); *(u32x2*)(CQN + (size_t)row * 384 + 256 + 4 * lane) = w;
                         const f32x4 o2 = v[2] * rkv * g2; u32x2 w2; w2.x = cvt_pk_bf16(o2[0], o2[1]); w2.y = cvt_pk_bf16(o2[2], o2[3]); *(u32x2*)(CKVN + (size_t)row * 256 + 128 + 4 * lane) = w2; }
        else { const f32x4 o = v[1] * rkv * g1; u32x2 w; w.x = cvt_pk_bf16(o[0], o[1]); w.y = cvt_pk_bf16(o[2], o[3]); *(u32x2*)(CKVN + (size_t)row * 256 + 4 * (lane - 32)) = w; }
        f32x4 part;
#pragma unroll
        for (int q = 0; q < 4; ++q) part[q] = __shfl_xor(v[2][q], 8);
        if (lane >= 32 && lane < 48) {
            const bool second = lane >= 40; const int i0 = i0r;
            const f32x4 o = second ? (v[2] * c + part * s) : (v[2] * c - part * s);
            u32x2 w; w.x = cvt_pk_bf16(o[0], o[1]); w.y = cvt_pk_bf16(o[2], o[3]);
            const int b = row >> 11, s_ = row & 2047;
            if (ATT_FP8) { const unsigned w8 = pk4_fp8(o[0], o[1], o[2], o[3]);
#pragma unroll
                for (int h = 0; h < 8; ++h) *(unsigned*)((unsigned char*)Kc + ((size_t)(b * 8 + h) * SEQ + s_) * 192 + 128 + (second ? 32 : 0) + i0) = w8; }
            else {
#pragma unroll
            for (int h = 0; h < 8; ++h) *(u32x2*)(Kc + ((size_t)(b * 8 + h) * SEQ + s_) * 192 + 128 + (second ? 32 : 0) + i0) = w; }
        }
    }
}
namespace attn {
constexpr int DQK = 192, DV = 128, NW = 8, QBLK = 32, KVBLK = 64;
constexpr float SCALE = 0.07216878364870322f;
constexpr float THR = 8.f;
constexpr int LDQ = 8 * DQK, LDK = DQK, LDVV = DV, LDO = 1024;
constexpr int SHM_V = KVBLK * DV * 2, SHM_K = KVBLK * DQK * 2;
constexpr int SHM_ATTN = 2 * SHM_V + 2 * SHM_K + NW * 64 * 4;
#define KSWZ192(row, colB) ((row) * 384 + ((colB) ^ ((((row) >> 1) & 7) << 4)))
#define SBAR() __builtin_amdgcn_sched_barrier(0)

template <bool DEFER = true>
__device__ __forceinline__ void partialSM(f32x16& p0, f32x16& p1, float& m_reg, float& mn, float& alpha) {
    constexpr float Cc = SCALE * 1.4426950408889634f;
    float pmax = p0[0];
#pragma unroll
    for (int r = 1; r < 16; ++r) pmax = fmaxf(pmax, p0[r]);
#pragma unroll
    for (int r = 0; r < 16; ++r) pmax = fmaxf(pmax, p1[r]);
    { auto rr = __builtin_amdgcn_permlane32_swap(__float_as_uint(pmax), __float_as_uint(pmax), false, false);
      pmax = fmaxf(__uint_as_float(rr[0]), __uint_as_float(rr[1])); }
    if (__builtin_expect(__all(pmax - m_reg <= (DEFER ? THR / SCALE : 0.f)), 1)) { mn = m_reg; alpha = 1.f; }
    else { mn = fmaxf(m_reg, pmax); alpha = __builtin_amdgcn_exp2f((m_reg - mn) * Cc); m_reg = mn; }
    const float mnC = -mn * Cc;
#pragma unroll
    for (int r = 0; r < 16; ++r) p0[r] = fmaf(p0[r], Cc, mnC);
#pragma unroll
    for (int r = 0; r < 16; ++r) p1[r] = fmaf(p1[r], Cc, mnC);
#pragma unroll
    for (int r = 0; r < 16; ++r) p0[r] = __builtin_amdgcn_exp2f(p0[r]);
}
__device__ __forceinline__ void finishSM(f32x16& p0, f32x16& p1, float alpha, float& l_reg, bf16x8& pa0, bf16x8& pa1, bf16x8& pa2, bf16x8& pa3) {
#pragma unroll
    for (int r = 0; r < 16; ++r) p1[r] = __builtin_amdgcn_exp2f(p1[r]);
    float ps = 0;
#pragma unroll
    for (int r = 0; r < 16; ++r) ps += p0[r];
#pragma unroll
    for (int r = 0; r < 16; ++r) ps += p1[r];
    { auto rr = __builtin_amdgcn_permlane32_swap(__float_as_uint(ps), __float_as_uint(ps), false, false);
      ps = __uint_as_float(rr[0]) + __uint_as_float(rr[1]); }
    l_reg = l_reg * alpha + ps;
#define PK4(P, BASE, OUT) do { unsigned a0 = cvt_pk_bf16(P[BASE + 0], P[BASE + 1]), a1 = cvt_pk_bf16(P[BASE + 2], P[BASE + 3]);   \
    unsigned b0 = cvt_pk_bf16(P[BASE + 4], P[BASE + 5]), b1 = cvt_pk_bf16(P[BASE + 6], P[BASE + 7]);                              \
    auto r0 = __builtin_amdgcn_permlane32_swap(a0, b0, false, false); auto r1 = __builtin_amdgcn_permlane32_swap(a1, b1, false, false); \
    u32x4 w = {r0[0], r1[0], r0[1], r1[1]}; OUT = __builtin_bit_cast(bf16x8, w); } while (0)
    PK4(p0, 0, pa0); PK4(p0, 8, pa1); PK4(p1, 0, pa2); PK4(p1, 8, pa3);
#undef PK4
}
template <int KOFF>
__device__ __forceinline__ void qkt(f32x16& p0, f32x16& p1, const int (&kb)[4], const bf16x8* qr) {
    p0 = f32x16{}; p1 = f32x16{};
#pragma unroll
    for (int d0 = 0; d0 < 12; ++d0) { const int a = d0 >> 2, b = d0 & 3;
        const bf16x8 b0 = *(const LAS bf16x8*)(uintptr_t)(unsigned)(kb[b] + 128 * a + KOFF);
        const bf16x8 b1 = *(const LAS bf16x8*)(uintptr_t)(unsigned)(kb[b] + 128 * a + 12288 + KOFF);
        p0 = __builtin_amdgcn_mfma_f32_32x32x16_bf16(b0, qr[d0], p0, 0, 0, 0);
        p1 = __builtin_amdgcn_mfma_f32_32x32x16_bf16(b1, qr[d0], p1, 0, 0, 0); }
}
template <int D0> __device__ __forceinline__ void pv_one(f32x16& od, int vb, bf16x8 pa0, bf16x8 pa1, bf16x8 pa2, bf16x8 pa3) {
    const s16x4 l0 = tr_read<v_rd_off(D0, 0, 0)>(vb), h0 = tr_read<v_rd_off(D0, 0, 1)>(vb), l1 = tr_read<v_rd_off(D0, 1, 0)>(vb), h1 = tr_read<v_rd_off(D0, 1, 1)>(vb);
    const s16x4 l2 = tr_read<v_rd_off(D0, 2, 0)>(vb), h2 = tr_read<v_rd_off(D0, 2, 1)>(vb), l3 = tr_read<v_rd_off(D0, 3, 0)>(vb), h3 = tr_read<v_rd_off(D0, 3, 1)>(vb);
    asm volatile("s_waitcnt lgkmcnt(0)" ::: "memory"); SBAR();
    od = __builtin_amdgcn_mfma_f32_32x32x16_bf16(pa0, PKLH(l0, h0), od, 0, 0, 0);
    od = __builtin_amdgcn_mfma_f32_32x32x16_bf16(pa1, PKLH(l1, h1), od, 0, 0, 0);
    od = __builtin_amdgcn_mfma_f32_32x32x16_bf16(pa2, PKLH(l2, h2), od, 0, 0, 0);
    od = __builtin_amdgcn_mfma_f32_32x32x16_bf16(pa3, PKLH(l3, h3), od, 0, 0, 0);
}
__device__ __forceinline__ void pv_d0(f32x16* o, int vb, bf16x8 pa0, bf16x8 pa1, bf16x8 pa2, bf16x8 pa3) {
    pv_one<0>(o[0], vb, pa0, pa1, pa2, pa3); pv_one<1>(o[1], vb, pa0, pa1, pa2, pa3); pv_one<2>(o[2], vb, pa0, pa1, pa2, pa3); pv_one<3>(o[3], vb, pa0, pa1, pa2, pa3);
}
__device__ __forceinline__ void attn_unit(const bf16_t* __restrict__ Qb, const bf16_t* __restrict__ Kh, const bf16_t* __restrict__ Vh, bf16_t* __restrict__ Ob, LAS unsigned char* lds) {
    const int tid = opaque((int)threadIdx.x), wid = tid >> 6, lane = tid & 63, r32 = lane & 31, hi = lane >> 5;
    LAS unsigned char* V_lds = lds; LAS unsigned char* K_lds = lds + 2 * SHM_V;
    LAS float* wsf = (LAS float*)(lds + 2 * SHM_V + 2 * SHM_K) + wid * 64; LAS float* li_l = wsf; LAS float* al_l = wsf + 32;
    float m_reg = -1e30f, l_reg = 0; f32x16 o[4] = {}; bf16x8 qr[12];
    const bf16_t* Qw = Qb + (long)(wid * QBLK + r32) * LDQ + hi * 8;
#pragma unroll
    for (int d0 = 0; d0 < 12; ++d0) qr[d0] = *(const bf16x8*)(Qw + d0 * 16);
    const int sr = tid >> 4, sc = (tid & 15) * 8, vst0 = v_st(sr, sc), vst1 = v_st(32 + sr, sc);
    int krow[3], kch[3];
#pragma unroll
    for (int i = 0; i < 3; ++i) { const int id = tid + 512 * i; krow[i] = id / 24; kch[i] = id % 24; }
    const int vb0 = lds_addr(V_lds) + v_rd_base(lane);
    bf16x8 vs0, vs1, ks0, ks1, ks2;
#define SLOAD(k0) do { vs0 = *(const bf16x8*)(Vh + (long)((k0) + sr) * LDVV + sc); vs1 = *(const bf16x8*)(Vh + (long)((k0) + 32 + sr) * LDVV + sc); \
    ks0 = *(const bf16x8*)(Kh + (long)((k0) + krow[0]) * LDK + kch[0] * 8); ks1 = *(const bf16x8*)(Kh + (long)((k0) + krow[1]) * LDK + kch[1] * 8); ks2 = *(const bf16x8*)(Kh + (long)((k0) + krow[2]) * LDK + kch[2] * 8); } while (0)
#define SWRITE(b) do { *(LAS bf16x8*)(V_lds + (b) * SHM_V + vst0) = vs0; *(LAS bf16x8*)(V_lds + (b) * SHM_V + vst1) = vs1; \
    *(LAS bf16x8*)(K_lds + (b) * SHM_K + KSWZ192(krow[0], kch[0] * 16)) = ks0; *(LAS bf16x8*)(K_lds + (b) * SHM_K + KSWZ192(krow[1], kch[1] * 16)) = ks1; \
    *(LAS bf16x8*)(K_lds + (b) * SHM_K + KSWZ192(krow[2], kch[2] * 16)) = ks2; } while (0)
#define RESC(a) do { if (__any((a) < 1.f)) { if (hi == 0) al_l[r32] = (a); asm volatile("s_waitcnt lgkmcnt(0)" ::: "memory"); \
    _Pragma("unroll") for (int d = 0; d < 4; ++d) _Pragma("unroll") for (int r = 0; r < 16; ++r) o[d][r] *= al_l[crow(r, hi)]; } } while (0)
    int kb[4];
    { const int xr = ((r32 >> 1) & 7) << 4;
#pragma unroll
      for (int b = 0; b < 4; ++b) kb[b] = lds_addr(K_lds) + r32 * 384 + (((b << 5) | (hi << 4)) ^ xr); }
    f32x16 pA0, pA1, pB0, pB1; float mnA, mnB, alA, alB; bf16x8 pa0, pa1, pa2, pa3; constexpr int NTILES = SEQ / KVBLK;
    SLOAD(0); asm volatile("s_waitcnt vmcnt(0)" ::: "memory"); SWRITE(0); __syncthreads();
    qkt<0>(pA0, pA1, kb, qr); partialSM(pA0, pA1, m_reg, mnA, alA);
    SLOAD(KVBLK);
    asm volatile("s_waitcnt vmcnt(0)" ::: "memory"); SWRITE(1); __syncthreads();
    for (int j = 1; j + 1 < NTILES; j += 2) {
        SBAR(); qkt<SHM_K>(pB0, pB1, kb, qr);
        finishSM(pA0, pA1, alA, l_reg, pa0, pa1, pa2, pa3); SBAR();
        SLOAD((j + 1) * KVBLK); SBAR();
        pv_d0(o, vb0, pa0, pa1, pa2, pa3); partialSM(pB0, pB1, m_reg, mnB, alB);
        __syncthreads(); asm volatile("s_waitcnt vmcnt(0)" ::: "memory"); SWRITE(0);
        RESC(alB); __syncthreads();
        SBAR(); qkt<0>(pA0, pA1, kb, qr);
        finishSM(pB0, pB1, alB, l_reg, pa0, pa1, pa2, pa3); SBAR();
        SLOAD((j + 2) * KVBLK); SBAR();
        pv_d0(o, vb0 + SHM_V, pa0, pa1, pa2, pa3); partialSM(pA0, pA1, m_reg, mnA, alA);
        __syncthreads(); asm volatile("s_waitcnt vmcnt(0)" ::: "memory"); SWRITE(1);
        RESC(alA); __syncthreads();
    }
    SBAR(); qkt<SHM_K>(pB0, pB1, kb, qr);
    finishSM(pA0, pA1, alA, l_reg, pa0, pa1, pa2, pa3); SBAR();
    pv_d0(o, vb0, pa0, pa1, pa2, pa3); partialSM(pB0, pB1, m_reg, mnB, alB);
    __syncthreads(); RESC(alB);
    finishSM(pB0, pB1, alB, l_reg, pa0, pa1, pa2, pa3); SBAR();
    pv_d0(o, vb0 + SHM_V, pa0, pa1, pa2, pa3);
    if (hi == 0) li_l[r32] = l_reg; asm volatile("s_waitcnt lgkmcnt(0)" ::: "memory");
    float rli[16];
#pragma unroll
    for (int r = 0; r < 16; ++r) rli[r] = __builtin_amdgcn_rcpf(li_l[crow(r, hi)]);
    bf16_t* Ow = Ob + (long)(wid * QBLK) * LDO;
#pragma unroll
    for (int r = 0; r < 16; ++r) { const int orow = crow(r, hi);
#pragma unroll
        for (int d0 = 0; d0 < 4; ++d0) Ow[(long)orow * LDO + d0 * 32 + r32] = f2bf(o[d0][r] * rli[r]); }
    __syncthreads();
#undef SLOAD
#undef SWRITE
#undef RESC
}
constexpr int SHM_K8 = KVBLK * DQK;
#define KSWZ8(row, ch) ((row) * 192 + ((((ch)) ^ (((row) >> 2) & 3)) << 4))
template <int KOFF>
__device__ __forceinline__ void qkt8(f32x16& p0, f32x16& p1, int kbA, int kbB, const i32x8 (&q8)[3], int f8sc) {
    p0 = f32x16{}; p1 = f32x16{};
    asm volatile("s_nop 1" ::: "memory");
#pragma unroll
    for (int i = 0; i < 3; ++i) {
        const i32x4 a0 = *(const LAS i32x4*)(uintptr_t)(unsigned)(kbA + 64 * i + KOFF), a1 = *(const LAS i32x4*)(uintptr_t)(unsigned)(kbB + 64 * i + KOFF);
        const i32x4 b0 = *(const LAS i32x4*)(uintptr_t)(unsigned)(kbA + 64 * i + 6144 + KOFF), b1 = *(const LAS i32x4*)(uintptr_t)(unsigned)(kbB + 64 * i + 6144 + KOFF);
        const i32x8 k0 = __builtin_shufflevector(a0, a1, 0, 1, 2, 3, 4, 5, 6, 7), k1 = __builtin_shufflevector(b0, b1, 0, 1, 2, 3, 4, 5, 6, 7);
        asm volatile("v_mfma_scale_f32_32x32x64_f8f6f4 %0, %1, %2, %0, %3, %3 op_sel_hi:[0,0,0]" : "+v"(p0) : "v"(k0), "v"(q8[i]), "v"(f8sc));
        asm volatile("v_mfma_scale_f32_32x32x64_f8f6f4 %0, %1, %2, %0, %3, %3 op_sel_hi:[0,0,0]" : "+v"(p1) : "v"(k1), "v"(q8[i]), "v"(f8sc));
    }
    asm volatile("s_nop 15\n\ts_nop 15" : "+v"(p0), "+v"(p1));
}
__device__ __forceinline__ void attn_unit8(const unsigned char* __restrict__ Qb, const unsigned char* __restrict__ Kh, const bf16_t* __restrict__ Vh, bf16_t* __restrict__ Ob, LAS unsigned char* lds) {
    const int tid = opaque((int)threadIdx.x), wid = tid >> 6, lane = tid & 63, r32 = lane & 31, hi = lane >> 5;
    LAS unsigned char* V_lds = lds; LAS unsigned char* K_lds = lds + 2 * SHM_V;
    LAS float* wsf = (LAS float*)(lds + 2 * SHM_V + 2 * SHM_K8) + wid * 64; LAS float* li_l = wsf; LAS float* al_l = wsf + 32;
    float m_reg = -1e30f, l_reg = 0; f32x16 o[4] = {}; i32x8 q8[3]; const int f8sc = 0x7f7f7f7f;
    { const unsigned char* Qw = Qb + (size_t)(wid * QBLK + r32) * 1536 + 32 * hi;
#pragma unroll
      for (int i = 0; i < 3; ++i) { const i32x4 lo = *(const i32x4*)(Qw + 64 * i), hi4 = *(const i32x4*)(Qw + 64 * i + 16); q8[i] = __builtin_shufflevector(lo, hi4, 0, 1, 2, 3, 4, 5, 6, 7); } }
    const int sr = tid >> 4, sc = (tid & 15) * 8, vst0 = v_st(sr, sc), vst1 = v_st(32 + sr, sc);
    const int kr0 = tid / 12, kc0 = tid % 12, kr1 = (tid + 512) / 12, kc1 = (tid + 512) % 12; const bool k2 = tid < 256;
    const int vb0 = lds_addr(V_lds) + v_rd_base(lane);
    bf16x8 vs0, vs1; i32x4 ks0, ks1 = {0, 0, 0, 0};
#define SLOAD(k0) do { vs0 = *(const bf16x8*)(Vh + (long)((k0) + sr) * LDVV + sc); vs1 = *(const bf16x8*)(Vh + (long)((k0) + 32 + sr) * LDVV + sc); \
    ks0 = *(const i32x4*)(Kh + (size_t)((k0) + kr0) * 192 + kc0 * 16); if (k2) ks1 = *(const i32x4*)(Kh + (size_t)((k0) + kr1) * 192 + kc1 * 16); } while (0)
#define SWRITE(b) do { *(LAS bf16x8*)(V_lds + (b) * SHM_V + vst0) = vs0; *(LAS bf16x8*)(V_lds + (b) * SHM_V + vst1) = vs1; \
    *(LAS i32x4*)(K_lds + (b) * SHM_K8 + KSWZ8(kr0, kc0)) = ks0; if (k2) *(LAS i32x4*)(K_lds + (b) * SHM_K8 + KSWZ8(kr1, kc1)) = ks1; } while (0)
#define RESC(a) do { if (__any((a) < 1.f)) { if (hi == 0) al_l[r32] = (a); asm volatile("s_waitcnt lgkmcnt(0)" ::: "memory"); \
    _Pragma("unroll") for (int d = 0; d < 4; ++d) _Pragma("unroll") for (int r = 0; r < 16; ++r) o[d][r] *= al_l[crow(r, hi)]; } } while (0)
    const int xr = (r32 >> 2) & 3;
    const int kbA = lds_addr(K_lds) + r32 * 192 + (((2 * hi) ^ xr) << 4), kbB = lds_addr(K_lds) + r32 * 192 + (((2 * hi + 1) ^ xr) << 4);
    f32x16 pA0, pA1, pB0, pB1; float mnA, mnB, alA, alB; bf16x8 pa0, pa1, pa2, pa3; constexpr int NTILES = SEQ / KVBLK;
    SLOAD(0); asm volatile("s_waitcnt vmcnt(0)" ::: "memory"); SWRITE(0); __syncthreads();
    qkt8<0>(pA0, pA1, kbA, kbB, q8, f8sc); partialSM(pA0, pA1, m_reg, mnA, alA);
    SLOAD(KVBLK);
    asm volatile("s_waitcnt vmcnt(0)" ::: "memory"); SWRITE(1); __syncthreads();
    for (int j = 1; j + 1 < NTILES; j += 2) {
        SBAR(); qkt8<SHM_K8>(pB0, pB1, kbA, kbB, q8, f8sc);
        finishSM(pA0, pA1, alA, l_reg, pa0, pa1, pa2, pa3); SBAR();
        SLOAD((j + 1) * KVBLK); SBAR();
        pv_d0(o, vb0, pa0, pa1, pa2, pa3); partialSM(pB0, pB1, m_reg, mnB, alB);
        __syncthreads(); asm volatile("s_waitcnt vmcnt(0)" ::: "memory"); SWRITE(0);
        RESC(alB); __syncthreads();
        SBAR(); qkt8<0>(pA0, pA1, kbA, kbB, q8, f8sc);
        finishSM(pB0, pB1, alB, l_reg, pa0, pa1, pa2, pa3); SBAR();
        SLOAD((j + 2) * KVBLK); SBAR();
        pv_d0(o, vb0 + SHM_V, pa0, pa1, pa2, pa3); partialSM(pA0, pA1, m_reg, mnA, alA);
        __syncthreads(); asm volatile("s_waitcnt vmcnt(0)" ::: "memory"); SWRITE(1);
        RESC(alA); __syncthreads();
    }
    SBAR(); qkt8<SHM_K8>(pB0, pB1, kbA, kbB, q8, f8sc);
    finishSM(pA0, pA1, alA, l_reg, pa0, pa1, pa2, pa3); SBAR();
    pv_d0(o, vb0, pa0, pa1, pa2, pa3); partialSM(pB0, pB1, m_reg, mnB, alB);
    __syncthreads(); RESC(alB);
    finishSM(pB0, pB1, alB, l_reg, pa0, pa1, pa2, pa3); SBAR();
    pv_d0(o, vb0 + SHM_V, pa0, pa1, pa2, pa3);
    if (hi == 0) li_l[r32] = l_reg; asm volatile("s_waitcnt lgkmcnt(0)" ::: "memory");
    float rli[16];
#pragma unroll
    for (int r = 0; r < 16; ++r) rli[r] = __builtin_amdgcn_rcpf(li_l[crow(r, hi)]);
    bf16_t* Ow = Ob + (long)(wid * QBLK) * LDO;
#pragma unroll
    for (int r = 0; r < 16; ++r) { const int orow = crow(r, hi);
#pragma unroll
        for (int d0 = 0; d0 < 4; ++d0) Ow[(long)orow * LDO + d0 * 32 + r32] = f2bf(o[d0][r] * rli[r]); }
    __syncthreads();
#undef SLOAD
#undef SWRITE
#undef RESC
}
constexpr int SHM_V8 = KVBLK * DV;
__device__ __forceinline__ void finishSM8(f32x16& p0, f32x16& p1, float alpha, float& l_reg, i32x8& P8) {
#pragma unroll
    for (int r = 0; r < 16; ++r) p1[r] = __builtin_amdgcn_exp2f(p1[r]);
    float ps = 0;
#pragma unroll
    for (int r = 0; r < 16; ++r) ps += p0[r];
#pragma unroll
    for (int r = 0; r < 16; ++r) ps += p1[r];
    { auto rr = __builtin_amdgcn_permlane32_swap(__float_as_uint(ps), __float_as_uint(ps), false, false);
      ps = __uint_as_float(rr[0]) + __uint_as_float(rr[1]); }
    l_reg = l_reg * alpha + ps;
#pragma unroll
    for (int i = 0; i < 4; ++i) { P8[i] = (int)pk4_fp8(p0[4 * i] * F8_SP, p0[4 * i + 1] * F8_SP, p0[4 * i + 2] * F8_SP, p0[4 * i + 3] * F8_SP); P8[4 + i] = (int)pk4_fp8(p1[4 * i] * F8_SP, p1[4 * i + 1] * F8_SP, p1[4 * i + 2] * F8_SP, p1[4 * i + 3] * F8_SP); }
}
template <int VOFF>
__device__ __forceinline__ void pv8(f32x16 (&o)[4], int vbA, int vbB, const i32x8& P8, int f8sc) {
    i32x8 vf[4];
#pragma unroll
    for (int d0 = 0; d0 < 4; ++d0) { const i32x4 a = *(const LAS i32x4*)(uintptr_t)(unsigned)(vbA + d0 * 2048 + VOFF), b = *(const LAS i32x4*)(uintptr_t)(unsigned)(vbB + d0 * 2048 + VOFF); vf[d0] = __builtin_shufflevector(a, b, 0, 1, 2, 3, 4, 5, 6, 7); }
    asm volatile("s_nop 4" ::: "memory");
#pragma unroll
    for (int d0 = 0; d0 < 4; ++d0) asm volatile("v_mfma_scale_f32_32x32x64_f8f6f4 %0, %1, %2, %0, %3, %3 op_sel_hi:[0,0,0]" : "+v"(o[d0]) : "v"(P8), "v"(vf[d0]), "v"(f8sc));
    asm volatile("s_nop 15\n\ts_nop 15" : "+v"(o[0]), "+v"(o[1]), "+v"(o[2]), "+v"(o[3]));
}
__device__ __forceinline__ void attn_unit88(const unsigned char* __restrict__ Qb, const unsigned char* __restrict__ Kh, const unsigned char* __restrict__ Vt, bf16_t* __restrict__ Ob, LAS unsigned char* lds) {
    const int tid = opaque((int)threadIdx.x), wid = tid >> 6, lane = tid & 63, r32 = lane & 31, hi = lane >> 5;
    LAS unsigned char* V_lds = lds; LAS unsigned char* K_lds = lds + 2 * SHM_V8;
    LAS float* wsf = (LAS float*)(lds + 2 * SHM_V8 + 2 * SHM_K8) + wid * 64; LAS float* li_l = wsf; LAS float* al_l = wsf + 32;
    float m_reg = -1e30f, l_reg = 0; f32x16 o[4] = {}; i32x8 q8[3]; const int f8sc = 0x7f7f7f7f;
    { const unsigned char* Qw = Qb + (size_t)(wid * QBLK + r32) * 1536 + 32 * hi;
#pragma unroll
      for (int i = 0; i < 3; ++i) { const i32x4 lo = *(const i32x4*)(Qw + 64 * i), hi4 = *(const i32x4*)(Qw + 64 * i + 16); q8[i] = __builtin_shufflevector(lo, hi4, 0, 1, 2, 3, 4, 5, 6, 7); } }
    const int vdv = tid >> 2, vc = tid & 3;
    int vwa[4];
#pragma unroll
    for (int g = 0; g < 4; ++g) { const int h = g & 1, slotbase = 16 * (vc >> 1) + 4 * (2 * (vc & 1) + (g >> 1)); const int chunk = 2 * h + (slotbase >> 4); vwa[g] = vdv * 64 + ((chunk ^ ((vdv >> 2) & 3)) << 4) + (slotbase & 15); }
    const int kr0 = tid / 12, kc0 = tid % 12, kr1 = (tid + 512) / 12, kc1 = (tid + 512) % 12; const bool k2 = tid < 256;
    i32x4 vs, ks0, ks1 = {0, 0, 0, 0};
#define SLOAD(k0) do { vs = *(const i32x4*)(Vt + (size_t)vdv * SEQ + (k0) + 16 * vc); \
    ks0 = *(const i32x4*)(Kh + (size_t)((k0) + kr0) * 192 + kc0 * 16); if (k2) ks1 = *(const i32x4*)(Kh + (size_t)((k0) + kr1) * 192 + kc1 * 16); } while (0)
#define SWRITE(b) do { _Pragma("unroll") for (int g = 0; g < 4; ++g) *(LAS int*)(V_lds + (b) * SHM_V8 + vwa[g]) = vs[g]; \
    *(LAS i32x4*)(K_lds + (b) * SHM_K8 + KSWZ8(kr0, kc0)) = ks0; if (k2) *(LAS i32x4*)(K_lds + (b) * SHM_K8 + KSWZ8(kr1, kc1)) = ks1; } while (0)
#define RESC(a) do { if (__any((a) < 1.f)) { if (hi == 0) al_l[r32] = (a); asm volatile("s_waitcnt lgkmcnt(0)" ::: "memory"); \
    _Pragma("unroll") for (int d = 0; d < 4; ++d) _Pragma("unroll") for (int r = 0; r < 16; ++r) o[d][r] *= al_l[crow(r, hi)]; } } while (0)
    const int xr = (r32 >> 2) & 3;
    const int kbA = lds_addr(K_lds) + r32 * 192 + (((2 * hi) ^ xr) << 4), kbB = lds_addr(K_lds) + r32 * 192 + (((2 * hi + 1) ^ xr) << 4);
    const int vbA = lds_addr(V_lds) + r32 * 64 + (((2 * hi) ^ xr) << 4), vbB = lds_addr(V_lds) + r32 * 64 + (((2 * hi + 1) ^ xr) << 4);
    f32x16 pA0, pA1, pB0, pB1; float mnA, mnB, alA, alB; i32x8 P8; constexpr int NTILES = SEQ / KVBLK;
    SLOAD(0); asm volatile("s_waitcnt vmcnt(0)" ::: "memory"); SWRITE(0); __syncthreads();
    qkt8<0>(pA0, pA1, kbA, kbB, q8, f8sc); partialSM<false>(pA0, pA1, m_reg, mnA, alA);
    SLOAD(KVBLK);
    asm volatile("s_waitcnt vmcnt(0)" ::: "memory"); SWRITE(1); __syncthreads();
    for (int j = 1; j + 1 < NTILES; j += 2) {
        SBAR(); qkt8<SHM_K8>(pB0, pB1, kbA, kbB, q8, f8sc);
        finishSM8(pA0, pA1, alA, l_reg, P8); SBAR();
        SLOAD((j + 1) * KVBLK); SBAR();
        pv8<0>(o, vbA, vbB, P8, f8sc); partialSM<false>(pB0, pB1, m_reg, mnB, alB);
        __syncthreads(); asm volatile("s_waitcnt vmcnt(0)" ::: "memory"); SWRITE(0);
        RESC(alB); __syncthreads();
        SBAR(); qkt8<0>(pA0, pA1, kbA, kbB, q8, f8sc);
        finishSM8(pB0, pB1, alB, l_reg, P8); SBAR();
        SLOAD((j + 2) * KVBLK); SBAR();
        pv8<SHM_V8>(o, vbA, vbB, P8, f8sc); partialSM<false>(pA0, pA1, m_reg, mnA, alA);
        __syncthreads(); asm volatile("s_waitcnt vmcnt(0)" ::: "memory"); SWRITE(1);
        RESC(alA); __syncthreads();
    }
    SBAR(); qkt8<SHM_K8>(pB0, pB1, kbA, kbB, q8, f8sc);
    finishSM8(pA0, pA1, alA, l_reg, P8); SBAR();
    pv8<0>(o, vbA, vbB, P8, f8sc); partialSM<false>(pB0, pB1, m_reg, mnB, alB);
    __syncthreads(); RESC(alB);
    finishSM8(pB0, pB1, alB, l_reg, P8); SBAR();
    pv8<SHM_V8>(o, vbA, vbB, P8, f8sc);
    if (hi == 0) li_l[r32] = l_reg; asm volatile("s_waitcnt lgkmcnt(0)" ::: "memory");
    float rli[16];
#pragma unroll
    for (int r = 0; r < 16; ++r) rli[r] = __builtin_amdgcn_rcpf(li_l[crow(r, hi)]) * (1.0f / (F8_SP * F8_SV));
    bf16_t* Ow = Ob + (long)(wid * QBLK) * LDO;
#pragma unroll
    for (int r = 0; r < 16; ++r) { const int orow = crow(r, hi);
#pragma unroll
        for (int d0 = 0; d0 < 4; ++d0) Ow[(long)orow * LDO + d0 * 32 + r32] = f2bf(o[d0][r] * rli[r]); }
    __syncthreads();
#undef SLOAD
#undef SWRITE
#undef RESC
}
}
#ifndef MK_SPLIT
#define MK_SPLIT 0
#endif
#ifndef PROBE_REPEAT
#define PROBE_REPEAT -1
#endif
constexpr int N_PHASES = 34;
struct Args { const void* in[N_IN]; float* out; unsigned char* ws; };

template <int LO, int HI>
__global__ void __launch_bounds__(512, 2) fwd_kernel(Args args) {
    extern __shared__ __attribute__((aligned(16))) unsigned char lds_raw[];
    Ctx C;
    C.lds = (LAS unsigned char*)lds_raw;
    C.tid = threadIdx.x; C.lane = C.tid & 63; C.wave = __builtin_amdgcn_readfirstlane(C.tid >> 6);
    C.G = gridDim.x; C.gw = blockIdx.x * 8 + C.wave; C.NGW = C.G * 8;
    C.in = args.in; C.out = args.out; C.ws = args.ws;
    volatile LAS unsigned* MISC = (volatile LAS unsigned*)(C.lds + LDS_MISC);
    if (C.tid < 64) MISC[C.tid] = 0u;
    __syncthreads();
    unsigned* barw = (unsigned*)(args.ws + WS_CTL) + CW_BAR;
    XcdBarrier bar; bar.bar = barw; bar.x = 0; bar.st = MISC + 8;
    if (HI - LO > 1) bar = xcd_barrier_post(barw, MISC + 8);
#define IN(k) (LO <= (k) && (k) < HI)
#define PH_BEGIN() do { C.tid = opaque((int)threadIdx.x); C.lane = C.tid & 63; ws = opaque_sptr(args.ws); C.ws = ws; C.out = (float*)opaque_sptr((unsigned char*)args.out); } while (0)
#define SEAM(k) do { if (IN(k) && IN((k) + 1)) xcd_barrier(bar); } while (0)

    unsigned char* ws = args.ws;
    const int bx = blockIdx.x;
#define XB ((bf16_t*)(ws + WS_XB))
#define Zb ((bf16_t*)(ws + WS_Z))
#define Hb ((bf16_t*)(ws + WS_H))
#define wm ((const char*)(ws + WS_WMIX))
#define gatesf ((float*)(ws + WS_SMALL + SM_GATES))
#define W1 ((bf16_t*)(ws + WS_WMOE))
#define W2 (W1 + (size_t)16 * 2048 * 1024)
#define UB ((bf16_t*)C.out)
#define YB ((bf16_t*)C.out + (size_t)NT * DM)

#define PHASE(k) if (IN(k)) for (int rep_ = 0; rep_ < ((k) == PROBE_REPEAT ? 2 : 1); ++rep_)
#define MOE_UP(eg) { pg8::GMoe g{XB, W1, 1024, 1024, 1024, (size_t)2048 * 1024 * 2, (const int*)(ws + WS_SMALL + SM_IDX)}; pg8::OffsetOrder S; S.init(128, 8, C.G, bx); S.pm_off = 128 * (eg); pg8::EpiSwiglu E{Hb}; \
        pg8::gemm_phase<true>(C.lds, g, S, E); }
#define MOE_DOWN(eg) { pg8::GMoeTA g{Hb, W2, 64, 1024, 1024, (size_t)1024 * 1024 * 2}; pg8::OffsetOrder S; S.init(128, 4, C.G, bx); S.pm_off = 128 * (eg); pg8::EpiBf16 E{Zb, 1024}; \
        pg8::gemm_phase(C.lds, g, S, E); }
#if MOE_FP8
#define MOE_PREP(l) prep_moe_weights8(C, l)
#define MOE_BLOCK(base, layer) \
    PHASE((base) + 0) { PH_BEGIN(); topk_select(C); } SEAM((base) + 0); \
    PHASE((base) + 1) { PH_BEGIN(); pg8::GMoe g{(const bf16_t*)(ws + WS_XB8), (const bf16_t*)(ws + WS_WMOE), 512, 512, 512, (size_t)2048 * 1024, (const int*)(ws + WS_SMALL + SM_IDX)}; pg8::EpiSwiglu8 E{(unsigned char*)Hb}; \
        for (int p0 = 0; p0 < 512; p0 += 2 * C.G) { pg8::OffsetOrder S; S.init((512 - p0) < 2 * C.G ? (512 - p0) : 2 * C.G, 8, C.G, bx); S.pm_off = p0; pg8::gemm_phase<true, true>(C.lds, g, S, E); }     \
        } SEAM((base) + 1); \
    PHASE((base) + 2) { PH_BEGIN(); pg8::GMoeTA8 g{(const unsigned char*)Hb, ws + WS_WMOE + (size_t)16 * 2048 * 1024, 64, 512, 512, (size_t)1024 * 1024}; pg8::StaticOrder S; S.init(512, 4, C.G, bx); pg8::EpiFp8S E{(unsigned char*)Zb, 1024, F8_SO / (F8_SH * F8_SW2)}; \
        pg8::gemm_phase<false, true>(C.lds, g, S, E); } SEAM((base) + 2); \
    PHASE((base) + 3) { PH_BEGIN(); moe_combine_ln2<(layer) == 3>(C, layer); if ((layer) < 3) MOE_PREP((layer) + 1); } SEAM((base) + 3);
#else
#define MOE_PREP(l) prep_moe_weights(C, l)
#define MOE_BLOCK(base, layer) \
    PHASE((base) + 0) { PH_BEGIN(); topk_select(C); } SEAM((base) + 0); \
    PHASE((base) + 1) { PH_BEGIN(); touch_region(C, XB, (size_t)NT * DM * 2); pg8::GMoe g{XB, W1, 1024, 1024, 1024, (size_t)2048 * 1024 * 2, (const int*)(ws + WS_SMALL + SM_IDX)}; pg8::StaticOrder S; S.init(512, 8, C.G, bx); pg8::EpiSwiglu E{Hb}; \
        pg8::gemm_phase<true>(C.lds, g, S, E); } SEAM((base) + 1); \
    PHASE((base) + 2) { PH_BEGIN(); touch_region(C, Hb, (size_t)NSEL * 1024 * 2 * 3 / 4); pg8::GMoeTA g{Hb, W2, 64, 1024, 1024, (size_t)1024 * 1024 * 2}; pg8::StaticOrder S; S.init(512, 4, C.G, bx); pg8::EpiBf16 E{Zb, 1024}; \
        pg8::gemm_phase(C.lds, g, S, E); } SEAM((base) + 2); \
    PHASE((base) + 3) { PH_BEGIN(); moe_combine_ln2<(layer) == 3>(C, layer); if ((layer) < 3) MOE_PREP((layer) + 1); } SEAM((base) + 3);

#endif

#define OUT_LN1(Aop, Wofs, layer) { pg8::GPlain g{Aop, (const bf16_t*)(wm + (Wofs)), 1024, 1024, 1024}; pg8::PanelOrder S; S.init(256, 4, C.G, bx); \
        pg8::EpiOutB E{XB, YB, 1.0f}; pg8::gemm_phase(C.lds, g, S, E); VM_WAIT(); __syncthreads(); \
        for (int pnl = bx; pnl < 256; pnl += C.G) ln1_router(C, layer, YB, pnl * 256 + C.wave, 8, 32); }
#define OUT_LN1_F8(Aop8, Wofs, layer) { pg8::GPlain g{(const bf16_t*)(Aop8), (const bf16_t*)(wm + (Wofs)), 512, 512, 512}; pg8::PanelOrder S; S.init(256, 4, C.G, bx); \
        pg8::EpiOutB E{XB, YB, 1.0f / (F8_SU * F8_SWO)}; pg8::gemm_phase<false, true>(C.lds, g, S, E); VM_WAIT(); __syncthreads(); \
        for (int pnl = bx; pnl < 256; pnl += C.G) ln1_router(C, layer, YB, pnl * 256 + C.wave, 8, 32); }
#if OUT_FP8
#define OUT_LN1_X(Aop, Wofs, layer) OUT_LN1_F8(Aop, Wofs, layer)
#else
#define OUT_LN1_X(Aop, Wofs, layer) OUT_LN1(Aop, Wofs, layer)
#endif

    PHASE(0) { PH_BEGIN(); prep_mixer_weights(C); prep_xb(C); prep_rope(C); MOE_PREP(0); }
    SEAM(0);

    PHASE(1) { PH_BEGIN(); pg8::StaticOrder S; S.init(256, 13, C.G, bx);
        if (INP_FP8) { pg8::GPlain g{(const bf16_t*)(ws + WS_XB8), (const bf16_t*)(wm + WM_ML_IN), 512, 512, 512}; pg8::EpiIn E{Zb, 3072, 12, 2, 0.08838834764831845f, 0, 0, gatesf, 16, IN_F(I_ML_GB), 1.0f / F8_SWI}; pg8::gemm_phase<false, true>(C.lds, g, S, E); }
        else { pg8::GPlain g{XB, (const bf16_t*)(wm + WM_ML_IN), 1024, 1024, 1024}; pg8::EpiIn E{Zb, 3072, 12, 2, 0.08838834764831845f, 0, 0, gatesf, 16, IN_F(I_ML_GB)}; pg8::gemm_phase(C.lds, g, S, E); } }
    SEAM(1);
    PHASE(2) { PH_BEGIN(); mlstm_chain(C); }
    SEAM(2);
    PHASE(3) { PH_BEGIN(); }
    PHASE(4) { PH_BEGIN();
        for (int pnl = bx; pnl < 256; pnl += C.G) headnorm_gate<0>(C, Zb + 2048, 3072, Hb, Hb + (size_t)NT * DM, IN_F(I_ML_NG), UB, pnl * 256 + C.wave, 8, 32);
        VM_WAIT(); __syncthreads(); OUT_LN1_X(UB, WM_ML_OUT, 0) }
    SEAM(4);
    MOE_BLOCK(5, 0)

    PHASE(9) { PH_BEGIN(); pg8::StaticOrder S; S.init(256, 13, C.G, bx);
        if (INP_FP8) { pg8::GPlain g{(const bf16_t*)(ws + WS_XB8), (const bf16_t*)(wm + WM_GL_IN), 512, 512, 512}; pg8::EpiIn E{Zb, 3072, 12, 2, 0.08838834764831845f, 0, 0, gatesf, 32, nullptr, 1.0f / F8_SWI}; pg8::gemm_phase<false, true>(C.lds, g, S, E); }
        else { pg8::GPlain g{XB, (const bf16_t*)(wm + WM_GL_IN), 1024, 1024, 1024}; pg8::EpiIn E{Zb, 3072, 12, 2, 0.08838834764831845f, 0, 0, gatesf, 32, nullptr}; pg8::gemm_phase(C.lds, g, S, E); } }
    SEAM(9);
    PHASE(10) { PH_BEGIN(); gla_chain(C); }
    SEAM(10);
    PHASE(11) { PH_BEGIN(); }
    PHASE(12) { PH_BEGIN();
        for (int pnl = bx; pnl < 256; pnl += C.G) headnorm_gate<1>(C, Zb + 2048, 3072, Hb, Hb + (size_t)NT * DM, IN_F(I_GL_NG), UB, pnl * 256 + C.wave, 8, 32);
        VM_WAIT(); __syncthreads(); OUT_LN1_X(UB, WM_GL_OUT, 1) }
    SEAM(12);
    MOE_BLOCK(13, 1)

#define GB Zb
#define UR (Zb + (size_t)NT * DM)
#define UC (Zb + (size_t)2 * NT * DM)
    PHASE(17) { PH_BEGIN(); pg8::GPlain g{XB, (const bf16_t*)(wm + WM_LR_IN), 1024, 1024, 1024}; pg8::StaticOrder S; S.init(256, 8, C.G, bx);
        pg8::EpiIn E{Zb, 1024, 8, 0, 1.f, 1024, (size_t)NT * DM, nullptr, 0, nullptr};
        pg8::gemm_phase(C.lds, g, S, E); }
    SEAM(17);
    PHASE(18) { PH_BEGIN(); lru_conv(C, UR, UC); }
    SEAM(18);
    PHASE(19) { PH_BEGIN(); pg8::GLruGate g{UC, (const bf16_t*)(wm + WM_LR_G), 1024, 256, 256}; pg8::StaticOrder S; S.init(256, 16, C.G, bx);
        pg8::EpiLruGate E{UC, IN_F(I_LR_GAB), IN_F(I_LR_GXB), IN_F(I_LR_LAM), Hb, Hb + (size_t)NT * DM, UB, UR};
        pg8::gemm_phase(C.lds, g, S, E); }
    SEAM(19);
    PHASE(20) { PH_BEGIN(); lru_scan(C, Hb, (const unsigned char*)(Hb + (size_t)NT * DM), UB, (const unsigned char*)UR, GB, UC); }
    SEAM(20);
    PHASE(21) { PH_BEGIN(); if (OUT_FP8) OUT_LN1_F8(UC, WM_LR_OUT, 2) else OUT_LN1(GB, WM_LR_OUT, 2) }
    SEAM(21);
    MOE_BLOCK(22, 2)

#define Zm (Hb + (size_t)NT * DM)
#define CQN UB
#define CKVN (UB + (size_t)NT * 384)
#define Qm Zb
#define Km (Zb + (size_t)NT * 1536)
#define Vm Hb
#define Om (Hb + (size_t)NT * DM)
    PHASE(26) { PH_BEGIN(); pg8::GPlain g{XB, (const bf16_t*)(wm + WM_MA_IN), 1024, 1024, 1024}; pg8::PanelOrder S; S.init(256, 3, C.G, bx);
        pg8::EpiIn E{Zm, 768, 3, 0, 1.f, 0, 0, nullptr, 0, nullptr};
        pg8::gemm_phase(C.lds, g, S, E); VM_WAIT(); __syncthreads();
        for (int pnl = bx; pnl < 256; pnl += C.G) mla_norm_rope(C, Zm, CQN, CKVN, Km, pnl * 256 + C.wave, 8, 32); }
    SEAM(26);
    PHASE(27) {  PH_BEGIN();
        { pg8::GPlain g{CQN, (const bf16_t*)(wm + WM_MA_UQ), 384, 384, 384}; pg8::StaticOrder S; S.init(256, 6, C.G, bx);
          pg8::EpiMlaQ E{Qm, (const float*)(ws + WS_ROPE), (const float*)(ws + WS_ROPE) + (size_t)NT * 32}; pg8::gemm_phase(C.lds, g, S, E); }
        { pg8::GPlain g{CKVN, (const bf16_t*)(wm + WM_MA_UKV), 256, 256, 256}; pg8::StaticOrder S; S.init(256, 8, C.G, bx);
          pg8::EpiMlaKV E{Km, Vm}; pg8::gemm_phase(C.lds, g, S, E); }
    }
    SEAM(27);
    PHASE(28) { PH_BEGIN();
        for (int unit = bx; unit < NB * 8 * 8; unit += C.G) { const int bh = unit >> 3, qb = unit & 7, b = bh >> 3, h = bh & 7;
            if (ATT_FP8 && ATT_PV8) attn::attn_unit88((const unsigned char*)Qm + ((size_t)(b * SEQ + qb * 256) * 8 + h) * 192, (const unsigned char*)Km + (size_t)bh * SEQ * 192, (const unsigned char*)Vm + (size_t)bh * 128 * SEQ, Om + (size_t)(b * SEQ + qb * 256) * DM + h * 128, C.lds);
            else if (ATT_FP8) attn::attn_unit8((const unsigned char*)Qm + ((size_t)(b * SEQ + qb * 256) * 8 + h) * 192, (const unsigned char*)Km + (size_t)bh * SEQ * 192, Vm + (size_t)bh * SEQ * 128, Om + (size_t)(b * SEQ + qb * 256) * DM + h * 128, C.lds);
            else attn::attn_unit(Qm + ((size_t)(b * SEQ + qb * 256) * 8 + h) * 192, Km + (size_t)bh * SEQ * 192, Vm + (size_t)bh * SEQ * 128, Om + (size_t)(b * SEQ + qb * 256) * DM + h * 128, C.lds); }
    }
    SEAM(28);
    PHASE(29) { PH_BEGIN(); OUT_LN1(Om, WM_MA_OUT, 3) }
    SEAM(29);
    MOE_BLOCK(30, 3)
#undef OUT_LN1
#undef OUT_LN1_F8
#undef OUT_LN1_X
#undef IN
#undef SEAM
#undef MOE_BLOCK
#undef MOE_UP
#undef MOE_DOWN
#undef PHASE
#undef XB
#undef Zb
#undef Hb
#undef wm
#undef gatesf
#undef W1
#undef W2
#undef UB
#undef YB
#undef GB
#undef UR
#undef UC
#undef Zm
#undef CQN
#undef CKVN
#undef Qm
#undef Km
#undef Vm
#undef Om
}

template <int P> struct SplitLaunch {
    static bool setup() { return hipFuncSetAttribute((const void*)fwd_kernel<P, P + 1>, hipFuncAttributeMaxDynamicSharedMemorySize, LDS_BYTES) == hipSuccess && SplitLaunch<P + 1>::setup(); }
    static void run(int grid, hipStream_t stream, const Args& a) { hipLaunchKernelGGL((fwd_kernel<P, P + 1>), dim3(grid), dim3(512), LDS_BYTES, stream, a); SplitLaunch<P + 1>::run(grid, stream, a); }
};
template <> struct SplitLaunch<N_PHASES> { static bool setup() { return true; } static void run(int, hipStream_t, const Args&) {} };

extern "C" void kernel_launch(void* const* d_in, const int* in_sizes, int n_in, void* d_out, int out_size, void* d_ws, size_t ws_size, hipStream_t stream) {
    static int grid = 0;
    if (grid == 0) {
        if (n_in != N_IN || out_size != NT * DM || ws_size < WS_END) { fprintf(stderr, "kernel_launch: unexpected shapes (n_in %d, out %d, ws %zu)\n", n_in, out_size, ws_size); grid = -1; return; }
        int dev = 0, cus = 0, per_cu = 0;
        if (hipGetDevice(&dev) != hipSuccess || hipDeviceGetAttribute(&cus, hipDeviceAttributeMultiprocessorCount, dev) != hipSuccess) { grid = -1; return; }
#if MK_SPLIT
        if (!SplitLaunch<0>::setup()) { fprintf(stderr, "kernel_launch: hipFuncSetAttribute failed\n"); grid = -1; return; }
#else
        if (hipFuncSetAttribute((const void*)fwd_kernel<0, N_PHASES>, hipFuncAttributeMaxDynamicSharedMemorySize, LDS_BYTES) != hipSuccess) { fprintf(stderr, "kernel_launch: hipFuncSetAttribute failed\n"); grid = -1; return; }
        if (hipOccupancyMaxActiveBlocksPerMultiprocessor(&per_cu, (const void*)fwd_kernel<0, N_PHASES>, 512, LDS_BYTES) != hipSuccess || per_cu < 1) { fprintf(stderr, "kernel_launch: occupancy query says %d\n", per_cu); }
#endif
        (void)hipGetLastError();
        grid = cus;
    }
    if (grid < 0) return;
    (void)hipMemsetAsync((char*)d_ws + WS_CTL, 0, CTL_BYTES, stream);
    Args a{};
    for (int i = 0; i < N_IN; ++i) a.in[i] = d_in[i];
    a.out = (float*)d_out; a.ws = (unsigned char*)d_ws;
#if MK_SPLIT
    SplitLaunch<0>::run(grid, stream, a);
#else
    hipLaunchKernelGGL((fwd_kernel<0, N_PHASES>), dim3(grid), dim3(512), LDS_BYTES, stream, a);
#endif
    const hipError_t le = hipPeekAtLastError();
    if (le != hipSuccess) fprintf(stderr, "kernel_launch: launch failed: %s\n", hipGetErrorName(le));
}
```

```cpp
#include <hip/hip_runtime.h>
#include <cstdio>
#include <cstdint>
#include <type_traits>

#define GAS __attribute__((address_space(1)))
#define LAS __attribute__((address_space(3)))
typedef unsigned short bf16_t;
typedef short bf16x8 __attribute__((ext_vector_type(8)));
typedef short s16x4 __attribute__((ext_vector_type(4)));
typedef float f32x2 __attribute__((ext_vector_type(2)));
typedef float f32x4 __attribute__((ext_vector_type(4)));
typedef float f32x16 __attribute__((ext_vector_type(16)));
typedef unsigned u32x2 __attribute__((ext_vector_type(2)));
typedef unsigned u32x4 __attribute__((ext_vector_type(4)));

constexpr int NB = 32, SEQ = 2048, DM = 1024, NT = NB * SEQ;
constexpr float ALPHA = 1.6817928305074290f;
constexpr float LN_EPS = 1e-5f;
constexpr int NEXP = 16, CAP = 256, NSEL = NB * NEXP * CAP;

constexpr size_t MiB = 1u << 20;
constexpr size_t WS_CTL = 0, CTL_BYTES = 1 * MiB;
constexpr size_t WS_WMIX = 1 * MiB;
constexpr size_t WS_ROPE = 33 * MiB;
constexpr size_t WS_SMALL = 49 * MiB;
constexpr size_t WS_WMOE = 65 * MiB;
constexpr size_t WS_XB = 161 * MiB;
constexpr size_t WS_Z = 289 * MiB;
constexpr size_t WS_H = 673 * MiB;
constexpr size_t WS_XB8 = 929 * MiB;
constexpr size_t WS_END = 993 * MiB;
constexpr size_t WM_ML_IN = 0;
constexpr size_t WM_ML_OUT = WM_ML_IN + (size_t)3328 * 1024 * 2;
constexpr size_t WM_GL_IN = WM_ML_OUT + (size_t)1024 * 1024 * 2;
constexpr size_t WM_GL_OUT = WM_GL_IN + (size_t)3328 * 1024 * 2;
constexpr size_t WM_LR_IN = WM_GL_OUT + (size_t)1024 * 1024 * 2;
constexpr size_t WM_LR_G = WM_LR_IN + (size_t)2048 * 1024 * 2;
constexpr size_t WM_LR_OUT = WM_LR_G + (size_t)4096 * 256 * 2;
constexpr size_t WM_MA_IN = WM_LR_OUT + (size_t)1024 * 1024 * 2;
constexpr size_t WM_MA_UQ = WM_MA_IN + (size_t)768 * 1024 * 2;
constexpr size_t WM_MA_UKV = WM_MA_UQ + (size_t)1536 * 384 * 2;
constexpr size_t WM_MA_OUT = WM_MA_UKV + (size_t)2048 * 256 * 2;
constexpr size_t WM_END = WM_MA_OUT + (size_t)1024 * 1024 * 2;
static_assert(WM_END <= 32 * MiB, "mixer weights fit");
constexpr size_t SM_GATES = 0;
constexpr size_t SM_AFF = 8 * MiB;
constexpr size_t SM_IDX = 12 * MiB;
constexpr size_t SM_INV = 13 * MiB;
constexpr int CW_BAR = 4096;

constexpr int LDS_MISC = 131072 + 16384;
constexpr int LDS_BYTES = 131072 + 16384 + 1024;

#define LDS_WAIT() asm volatile("s_waitcnt lgkmcnt(0)" ::: "memory")
#define VM_WAIT() asm volatile("s_waitcnt vmcnt(0)" ::: "memory")
typedef __bf16 bf16x2_t __attribute__((ext_vector_type(2)));
__device__ __forceinline__ unsigned cvt_pk_bf16(float lo, float hi) { bf16x2_t v = {(__bf16)lo, (__bf16)hi}; return __builtin_bit_cast(unsigned, v); }
__device__ __forceinline__ float bf_lo(unsigned w) { return __uint_as_float(w << 16); }
__device__ __forceinline__ float bf_hi(unsigned w) { return __uint_as_float(w & 0xffff0000u); }
__device__ __forceinline__ float bf2f(bf16_t b) { return __uint_as_float(((unsigned)b) << 16); }
__device__ __forceinline__ bf16_t f2bf(float f) { return (bf16_t)(cvt_pk_bf16(f, 0.f) & 0xffffu); }
__device__ __forceinline__ int opaque(int x) { asm volatile("" : "+v"(x)); return x; }
__device__ __forceinline__ unsigned char* opaque_sptr(unsigned char* p) {
    unsigned lo = __builtin_amdgcn_readfirstlane((unsigned)(uintptr_t)p), hi = __builtin_amdgcn_readfirstlane((unsigned)((uintptr_t)p >> 32));
    asm volatile("" : "+s"(lo), "+s"(hi));
    return (unsigned char*)(((uintptr_t)hi << 32) | (uintptr_t)lo);
}
template <int CTRL> __device__ __forceinline__ float dpp_f(float v) { return __int_as_float(__builtin_amdgcn_update_dpp(0, __float_as_int(v), CTRL, 0xF, 0xF, true)); }
__device__ __forceinline__ float rdlane_f(float v, int l) { return __int_as_float(__builtin_amdgcn_readlane(__float_as_int(v), l)); }
__device__ __forceinline__ float wave_sum(float v) {
    v += dpp_f<0xB1>(v); v += dpp_f<0x4E>(v); v += dpp_f<0x141>(v); v += dpp_f<0x140>(v);
    return (rdlane_f(v, 0) + rdlane_f(v, 16)) + (rdlane_f(v, 32) + rdlane_f(v, 48));
}
__device__ __forceinline__ float wave_max(float v) {
    v = fmaxf(v, dpp_f<0xB1>(v)); v = fmaxf(v, dpp_f<0x4E>(v)); v = fmaxf(v, dpp_f<0x141>(v)); v = fmaxf(v, dpp_f<0x140>(v));
    return fmaxf(fmaxf(rdlane_f(v, 0), rdlane_f(v, 16)), fmaxf(rdlane_f(v, 32), rdlane_f(v, 48)));
}
__device__ __forceinline__ float sigmoidf_(float x) { return __builtin_amdgcn_rcpf(1.0f + __expf(-x)); }
__device__ __forceinline__ float sigmoid_fast(float x) { return __builtin_amdgcn_rcpf(1.0f + __expf(-x)); }
__device__ __forceinline__ float one_minus_exp(float x) { const float ser = -x * (1.0f + x * (0.5f + x * (0.16666667f + x * 0.041666668f))); const float dir = 1.0f - __expf(x); return x > -0.125f ? ser : dir; }
__device__ __forceinline__ float logsigmoidf_(float x) { return fminf(x, 0.f) - log1pf(__expf(-fabsf(x))); }
__device__ __forceinline__ float logsigmoid_fast(float x) { return fminf(x, 0.f) - __logf(1.0f + __expf(-fabsf(x))); }
__device__ __forceinline__ float gelu_tanh(float x) { const float u = 0.7978845608028654f * (x + 0.044715f * x * x * x); const float t = 1.0f - 2.0f * __builtin_amdgcn_rcpf(__expf(2.0f * u) + 1.0f); return 0.5f * x * (1.0f + t); }
__device__ __forceinline__ float siluf_(float x) { return x * __builtin_amdgcn_rcpf(1.0f + __expf(-x)); }

typedef int i32x8 __attribute__((ext_vector_type(8)));
typedef int i32x4 __attribute__((ext_vector_type(4)));
constexpr float F8_SG = 32.0f;
constexpr float F8_SP = 256.0f, F8_SV = 8.0f;
constexpr float F8_SWI = 64.0f;
constexpr float F8_SU = 16.0f, F8_SWO = 128.0f;
constexpr float F8_SW1 = 64.0f, F8_SW2 = 128.0f, F8_SH = 8.0f, F8_SO = 32.0f;
__device__ __forceinline__ float f8clamp(float x) { return fminf(fmaxf(x, -416.0f), 416.0f); }
__device__ __forceinline__ unsigned pk4_fp8(float a, float b, float c, float d) {
    unsigned w = 0u; w = (unsigned)__builtin_amdgcn_cvt_pk_fp8_f32(f8clamp(a), f8clamp(b), (int)w, false); w = (unsigned)__builtin_amdgcn_cvt_pk_fp8_f32(f8clamp(c), f8clamp(d), (int)w, true); return w; }
__device__ __forceinline__ f32x4 unpk4_fp8(unsigned w) { const f32x2 lo = __builtin_amdgcn_cvt_pk_f32_fp8((int)w, false), hi = __builtin_amdgcn_cvt_pk_f32_fp8((int)w, true); return (f32x4){lo[0], lo[1], hi[0], hi[1]}; }
#define XB_TMO      128
#define XB_XCNT(j)  (256  + 64 * (j))
#define XB_XSUB(j)  (1280 + 64 * (j))
#define XB_XGEN(j)  (2304 + 64 * (j))
#define XB_TOP      3328
#define XB_TOPGEN   3392
#define XCD_BAR_WORDS 3456
#define XB_SPIN_CAP (1u << 20)

__device__ __forceinline__ unsigned xb_ld(unsigned* p)              { return __hip_atomic_load(p, __ATOMIC_RELAXED, __HIP_MEMORY_SCOPE_AGENT); }
__device__ __forceinline__ unsigned xb_add(unsigned* p, unsigned v) { return __hip_atomic_fetch_add(p, v, __ATOMIC_RELAXED, __HIP_MEMORY_SCOPE_AGENT); }
__device__ __forceinline__ unsigned xb_xcc_id() { return (unsigned)__builtin_amdgcn_s_getreg((3 << 11) | 20) & 0xFu; }
#define XB_SPIN(cond, bar) do { unsigned _sp = 0; while (cond) { __builtin_amdgcn_s_sleep(1); \
    if ((++_sp & 255u) == 0u) { if (xb_ld(&(bar)[XB_TMO])) break; if (_sp > XB_SPIN_CAP) { atomicAdd(&(bar)[XB_TMO], 1u); break; } } } } while (0)

struct XcdBarrier { unsigned* bar; unsigned x; volatile LAS unsigned* st; };

__device__ __forceinline__ XcdBarrier xcd_barrier_post(unsigned* bar, volatile LAS unsigned* st) {
    XcdBarrier b; b.bar = bar; b.x = xb_xcc_id(); b.st = st;
    if (threadIdx.x == 0) (void)xb_add(&bar[XB_XCNT(b.x)], 1u);
    return b;
}
__device__ __forceinline__ void xcd_barrier_complete(unsigned* bar, unsigned x, unsigned& nloc, unsigned& nx) {
    const unsigned G = gridDim.x * gridDim.y * gridDim.z;
    unsigned sum, cnt, mine, sp = 0u;
    for (;;) {
        sum = 0u; cnt = 0u; mine = 0u;
#pragma unroll
        for (unsigned j = 0; j < 16; ++j) { const unsigned c = xb_ld(&bar[XB_XCNT(j)]); sum += c; cnt += (c > 0u) ? 1u : 0u; mine = (j == x) ? c : mine; }
        if (sum == G) break;
        __builtin_amdgcn_s_sleep(1);
        if ((++sp & 255u) == 0u) { if (xb_ld(&bar[XB_TMO])) break; if (sp > XB_SPIN_CAP) { atomicAdd(&bar[XB_TMO], 1u); break; } }
    }
    nloc = mine > 0u ? mine : 1u; nx = cnt > 0u ? cnt : 1u;
}
__device__ __forceinline__ void xcd_barrier(const XcdBarrier& b) {
    asm volatile("s_waitcnt vmcnt(0)" ::: "memory");
    __syncthreads();
    if (threadIdx.x == 0) {
        unsigned* bar = b.bar;
        __builtin_amdgcn_s_waitcnt(0);
        unsigned nloc = b.st[0], nx = b.st[1];
        if (nloc == 0u) { xcd_barrier_complete(bar, b.x, nloc, nx); b.st[0] = nloc; b.st[1] = nx; }
        const unsigned old = xb_add(&bar[XB_XSUB(b.x)], 1u);
        const unsigned gen = old / nloc;
        if (old + 1u == (gen + 1u) * nloc) {
            __builtin_amdgcn_fence(__ATOMIC_RELEASE, "agent");
            asm volatile("s_waitcnt vmcnt(0)" ::: "memory");
            const unsigned og = xb_add(&bar[XB_TOP], 1u);
            const unsigned tg = og / nx;
            if (og + 1u == (tg + 1u) * nx) xb_add(&bar[XB_TOPGEN], 1u);
            else XB_SPIN(xb_ld(&bar[XB_TOPGEN]) == tg, bar);
            __builtin_amdgcn_fence(__ATOMIC_ACQUIRE, "agent");
            xb_add(&bar[XB_XGEN(b.x)], 1u);
            asm volatile("s_waitcnt vmcnt(0)" ::: "memory");
        } else {
            XB_SPIN(xb_ld(&bar[XB_XGEN(b.x)]) == gen, bar);
            __builtin_amdgcn_fence(__ATOMIC_ACQUIRE, "agent");
            asm volatile("s_waitcnt vmcnt(0)" ::: "memory");
        }
    }
    __syncthreads();
}
namespace pg8 {
constexpr int BM = 256, BK = 64, HALF = 128, HTB = HALF * BK * 2, STAGE_BYTES = 8 * HTB, NXCD = 8, WGM = 8;
__host__ __device__ __forceinline__ int lds_byte(int r, int c) { const int st = (r >> 4) * 2 + (c >> 5), rr = r & 15, cc = c & 31, ob = rr * 64 + cc * 2; return st * 1024 + (ob ^ (((ob >> 9) & 1) << 5)); }
__host__ __device__ __forceinline__ void stage_rc(int b, int& R, int& C) { const int st = b / 1024, sb = b % 1024, swz = sb ^ (((sb >> 9) & 1) << 5); R = (st >> 1) * 16 + swz / 64; C = (st & 1) * 32 + (swz % 64) / 2; }
__host__ __device__ __forceinline__ int perm32(int rho) { const int n = rho >> 4, i = rho & 15; return 8 * (i >> 2) + 4 * n + (i & 3); }

struct Unit { int pm, pn; };
struct StaticOrder {
    int nM, nN, nwg, G, c;
    __device__ void init(int nM_, int nN_, int G_, int c_) { nM = nM_; nN = nN_; nwg = nM * nN; G = G_; c = c_; }
    __device__ bool next(int i, Unit& u) const {
        const long L = (long)i * G + c; if (L >= nwg) return false;
        int wgid = (int)L; { const int q = nwg / NXCD, r = nwg % NXCD, xcd = wgid % NXCD, off = wgid / NXCD; wgid = (xcd < r ? xcd * (q + 1) : r * (q + 1) + (xcd - r) * q) + off; }
        const int nig = WGM * nN, gid = wgid / nig, fm = gid * WGM, gsz = (nM - fm) < WGM ? (nM - fm) : WGM;
        u.pm = fm + ((wgid % nig) % gsz); u.pn = (wgid % nig) / gsz; return true;
    }
};
struct OffsetOrder : StaticOrder { int pm_off;
    __device__ bool next(int i, Unit& u) const { if (!StaticOrder::next(i, u)) return false; u.pm += pm_off; return true; } };
struct PanelOrder { int nM, nN, G, c;
    __device__ void init(int nM_, int nN_, int G_, int c_) { nM = nM_; nN = nN_; G = G_; c = c_; }
    __device__ bool next(int i, Unit& u) const { const int p = c + (i / nN) * G; if (p >= nM) return false; u.pm = p; u.pn = i % nN; return true; } };
struct GPlain { const bf16_t* A; const bf16_t* Bt; int lda, ldb, K;
    __device__ __forceinline__ size_t kstep_a() const { return 128; }
    __device__ __forceinline__ const char* a(const Unit& u) const { return (const char*)A + (size_t)u.pm * BM * lda * 2; }
    __device__ __forceinline__ const char* b(const Unit& u) const { return (const char*)Bt + (size_t)u.pn * BM * ldb * 2; } };
struct GMoe { const bf16_t* A; const bf16_t* Bt; int lda, ldb, K; size_t estride;
    const int* rowtok;
    __device__ __forceinline__ size_t kstep_a() const { return 128; }
    __device__ __forceinline__ const char* a(const Unit& u) const { return (const char*)A + (size_t)u.pm * BM * lda * 2; }
    __device__ __forceinline__ const char* b(const Unit& u) const { return (const char*)Bt + (size_t)(u.pm >> 5) * estride + (size_t)u.pn * BM * ldb * 2; } };
struct GMoeTA { const bf16_t* A; const bf16_t* Bt; int lda, ldb, K; size_t estride;
    __device__ __forceinline__ size_t kstep_a() const { return 32768; }
    __device__ __forceinline__ const char* a(const Unit& u) const { return (const char*)A + (size_t)u.pm * 524288; }
    __device__ __forceinline__ const char* b(const Unit& u) const { return (const char*)Bt + (size_t)(u.pm >> 5) * estride + (size_t)u.pn * BM * ldb * 2; } };
struct GMoeTA8 { const unsigned char* A; const unsigned char* Bt; int lda, ldb, K; size_t estride;
    __device__ __forceinline__ size_t kstep_a() const { return 32768; }
    __device__ __forceinline__ const char* a(const Unit& u) const { return (const char*)A + (size_t)u.pm * 262144; }
    __device__ __forceinline__ const char* b(const Unit& u) const { return (const char*)Bt + (size_t)(u.pm >> 5) * estride + (size_t)u.pn * BM * ldb * 2; } };
struct GLruGate { const bf16_t* A; const bf16_t* Bt; int lda, ldb, K;
    __device__ __forceinline__ size_t kstep_a() const { return 128; }
    __device__ __forceinline__ const char* a(const Unit& u) const { return (const char*)A + (size_t)u.pm * BM * lda * 2 + (size_t)((u.pn >> 1) & 3) * 512; }
    __device__ __forceinline__ const char* b(const Unit& u) const { return (const char*)Bt + (size_t)u.pn * BM * ldb * 2; } };

template <class E, class = void> struct SwapB1 : std::false_type {};
template <class E> struct SwapB1<E, std::void_t<decltype(E::SWAPB1)>> : std::bool_constant<E::SWAPB1> {};
template <bool GATHER = false, bool FP8 = false, class Epi, class GD, class Sched>
__device__ __forceinline__ void gemm_phase(LAS unsigned char* lds, const GD g, const Sched& S, const Epi& E) {
    const int tid = opaque((int)threadIdx.x), wid = __builtin_amdgcn_readfirstlane(tid >> 6), lane = tid & 63, wr = wid >> 2, wc = wid & 3, fr = lane & 15, fq = lane >> 4;
    const int K = g.K, nt = K / BK;
    unsigned voffA[2], voffB[2]; int RA[2];
#pragma unroll
    for (int i = 0; i < 2; ++i) { int R, C; stage_rc(tid * 16 + i * 8192, R, C); const int Rb = Epi::PERM ? ((R & ~31) + perm32(R & 31)) : R;
        RA[i] = R; voffA[i] = GATHER ? (unsigned)C * 2u : (unsigned)(R * g.lda + C) * 2u; voffB[i] = (unsigned)(Rb * g.ldb + C) * 2u; }
    LAS unsigned* IDX = (LAS unsigned*)(lds + STAGE_BYTES);
    unsigned vA[2][2] = {{0u, 0u}, {0u, 0u}}, nvA[2][2] = {{0u, 0u}, {0u, 0u}};
    if constexpr (GATHER) {
        for (int i = 0; i < 16; ++i) { Unit uu; if (!S.next(i, uu)) break; if (tid < 256) IDX[i * 256 + tid] = (unsigned)g.rowtok[uu.pm * 256 + tid] * (unsigned)(g.lda * 2); }
        __syncthreads();
#pragma unroll
        for (int h = 0; h < 2; ++h)
#pragma unroll
            for (int i = 0; i < 2; ++i) vA[h][i] = IDX[h * HALF + RA[i]] + voffA[i];
    }
    const size_t kstep = (size_t)(BK * 2);
    const size_t kstepA = g.kstep_a();
    const size_t hstepA = (size_t)HALF * g.lda * 2, hstepB = (size_t)HALF * g.ldb * 2;
    const unsigned ldsw = (unsigned)wid * 1024u;
    const int aoff = lds_byte(wr * 64 + fr, fq * 8), boff = lds_byte(wc * 32 + fr, fq * 8);
#define PG8_SA(b, h) (((b) * 2 + (h)) * HTB)
#define PG8_SB(b, h) ((4 + (b) * 2 + (h)) * HTB)
#define PG8_STAGE(bufoff, gbase, voff) do { _Pragma("unroll") for (int _i = 0; _i < 2; ++_i) \
        __builtin_amdgcn_global_load_lds((const unsigned*)((const char*)(gbase) + (voff)[_i]), (LAS unsigned*)(lds + (bufoff) + ldsw + _i * 8192), 16, 0, 0); } while (0)
#define PG8_STAGE_GA(bufoff, gbase, VA) do { _Pragma("unroll") for (int _i = 0; _i < 2; ++_i) \
        __builtin_amdgcn_global_load_lds((const unsigned*)((const char*)(gbase) + (VA)[_i]), (LAS unsigned*)(lds + (bufoff) + ldsw + _i * 8192), 16, 0, 0); } while (0)
#define PG8_STAGE_A(bufoff, gbase, h, VA) do { if constexpr (GATHER) PG8_STAGE_GA(bufoff, gbase, (VA)[h]); else PG8_STAGE(bufoff, (gbase) + (h) * hstepA, voffA); } while (0)
#define PG8_LDA(dst, b, h) do { if constexpr (FP8) { _Pragma("unroll") for (int m = 0; m < 4; ++m) { const i32x4 _lo = *(const LAS i32x4*)(lds + PG8_SA(b, h) + aoff + m * 2048), _hi = *(const LAS i32x4*)(lds + PG8_SA(b, h) + aoff + m * 2048 + 1024); \
            dst##8[m] = __builtin_shufflevector(_lo, _hi, 0, 1, 2, 3, 4, 5, 6, 7); } } \
        else { _Pragma("unroll") for (int m = 0; m < 4; ++m) _Pragma("unroll") for (int k = 0; k < 2; ++k) dst[m][k] = *(const LAS bf16x8*)(lds + PG8_SA(b, h) + aoff + m * 2048 + k * 1024); } } while (0)
#define PG8_LDB(dst, b, h) do { if constexpr (FP8) { _Pragma("unroll") for (int n = 0; n < 2; ++n) { const i32x4 _lo = *(const LAS i32x4*)(lds + PG8_SB(b, h) + boff + n * 2048), _hi = *(const LAS i32x4*)(lds + PG8_SB(b, h) + boff + n * 2048 + 1024); \
            dst##8[n] = __builtin_shufflevector(_lo, _hi, 0, 1, 2, 3, 4, 5, 6, 7); } } \
        else { _Pragma("unroll") for (int n = 0; n < 2; ++n) _Pragma("unroll") for (int k = 0; k < 2; ++k) dst[n][k] = *(const LAS bf16x8*)(lds + PG8_SB(b, h) + boff + n * 2048 + k * 1024); } } while (0)
#define PG8_MMA(ai, bj, At, Bt) do { __builtin_amdgcn_s_setprio(1); \
        if constexpr (FP8) { _Pragma("unroll") for (int m = 0; m < 4; ++m) _Pragma("unroll") for (int n = 0; n < 2; ++n) \
            asm volatile("v_mfma_scale_f32_16x16x128_f8f6f4 %0, %1, %2, %0, %3, %3 op_sel_hi:[0,0,0]" : "+v"(acc[ai][bj][m][n]) : "v"(Bt##8[n]), "v"(At##8[m]), "v"(f8scale)); } \
        else if constexpr (SwapB1<Epi>::value && (bj) == 1) { _Pragma("unroll") for (int m = 0; m < 4; ++m) _Pragma("unroll") for (int n = 0; n < 2; ++n) _Pragma("unroll") for (int k = 0; k < 2; ++k) \
            acc[ai][bj][m][n] = __builtin_amdgcn_mfma_f32_16x16x32_bf16(At[m][k], Bt[n][k], acc[ai][bj][m][n], 0, 0, 0); } \
        else { _Pragma("unroll") for (int m = 0; m < 4; ++m) _Pragma("unroll") for (int n = 0; n < 2; ++n) _Pragma("unroll") for (int k = 0; k < 2; ++k) \
            acc[ai][bj][m][n] = __builtin_amdgcn_mfma_f32_16x16x32_bf16(Bt[n][k], At[m][k], acc[ai][bj][m][n], 0, 0, 0); } \
        __builtin_amdgcn_s_setprio(0); } while (0)
#define PG8_WAIT_V(n) asm volatile("s_waitcnt vmcnt(" #n ")" ::: "memory")
#define PG8_WAIT_L(n) asm volatile("s_waitcnt lgkmcnt(" #n ")" ::: "memory")
#define PG8_BAR __builtin_amdgcn_s_barrier()
#define PG8_SCHED __builtin_amdgcn_sched_barrier(0)
    Unit cur, nxt; int ui = 0;
    if (!S.next(0, cur)) return;
    f32x4 acc[2][2][4][2];
#pragma unroll
    for (int a = 0; a < 2; ++a)
#pragma unroll
        for (int b = 0; b < 2; ++b)
#pragma unroll
            for (int m = 0; m < 4; ++m)
#pragma unroll
                for (int n = 0; n < 2; ++n) acc[a][b][m][n] = (f32x4){0.f, 0.f, 0.f, 0.f};
    const int f8scale = 0x7f7f7f7f;
    bf16x8 At[4][2], B0[2][2], B1[2][2]; i32x8 At8[4], B08[2], B18[2];
    const char* cA = GATHER ? (const char*)g.A : g.a(cur); const char* cB = g.b(cur);
    PG8_STAGE(PG8_SB(0, 0), cB, voffB); PG8_STAGE_A(PG8_SA(0, 0), cA, 0, vA); PG8_STAGE(PG8_SB(0, 1), cB + hstepB, voffB); PG8_STAGE_A(PG8_SA(0, 1), cA, 1, vA);
    if (wr == 1) PG8_BAR;
    PG8_WAIT_V(4); PG8_BAR;
    PG8_STAGE(PG8_SB(1, 0), cB + kstep, voffB); PG8_STAGE_A(PG8_SA(1, 0), cA + kstepA, 0, vA); PG8_STAGE(PG8_SB(1, 1), cB + hstepB + kstep, voffB);
    PG8_WAIT_V(6); PG8_BAR;
    for (;;) {
        const bool has_next = S.next(ui + 1, nxt);
        const char* nA = GATHER ? cA : (has_next ? g.a(nxt) : cA); const char* nB = has_next ? g.b(nxt) : cB;
        if constexpr (GATHER) {
#pragma unroll
            for (int h = 0; h < 2; ++h)
#pragma unroll
                for (int i = 0; i < 2; ++i) nvA[h][i] = has_next ? IDX[(ui + 1) * 256 + h * HALF + RA[i]] + voffA[i] : vA[h][i];
        }
#pragma unroll 1
        for (int t = 0; t < nt; t += 2) {
            const bool last = (t == nt - 2);
            const char* a1 = cA + (size_t)(t + 1) * kstepA;
            const char* a2 = last ? nA : cA + (size_t)(t + 2) * kstepA; const char* b2 = last ? nB : cB + (size_t)(t + 2) * kstep;
            const char* a3 = a2 + kstepA; const char* b3 = b2 + kstep;
            unsigned sA[2][2];
#pragma unroll
            for (int h = 0; h < 2; ++h)
#pragma unroll
                for (int i = 0; i < 2; ++i) sA[h][i] = last ? nvA[h][i] : vA[h][i];
            PG8_LDB(B0, 0, 0); PG8_SCHED; PG8_LDA(At, 0, 0); PG8_STAGE_A(PG8_SA(1, 1), a1, 1, vA);
            PG8_WAIT_L(8); PG8_WAIT_V(10); PG8_BAR; PG8_WAIT_L(0); PG8_MMA(0, 0, At, B0); PG8_BAR; PG8_SCHED;
            PG8_LDB(B1, 0, 1); PG8_STAGE(PG8_SB(0, 0), b2, voffB);
            PG8_WAIT_V(10); PG8_BAR; PG8_WAIT_L(0); PG8_MMA(0, 1, At, B1); PG8_BAR;
            PG8_LDA(At, 0, 1); PG8_STAGE_A(PG8_SA(0, 0), a2, 0, sA);
            PG8_WAIT_V(10); PG8_BAR; PG8_WAIT_L(0); PG8_MMA(1, 0, At, B0); PG8_BAR; PG8_SCHED;
            PG8_STAGE(PG8_SB(0, 1), b2 + hstepB, voffB);
            PG8_WAIT_V(10); PG8_BAR; PG8_MMA(1, 1, At, B1); PG8_BAR;
            PG8_LDB(B0, 1, 0); PG8_SCHED; PG8_LDA(At, 1, 0); PG8_STAGE_A(PG8_SA(0, 1), a2, 1, sA);
            PG8_WAIT_L(8); PG8_WAIT_V(10); PG8_BAR; PG8_WAIT_L(0); PG8_MMA(0, 0, At, B0); PG8_BAR; PG8_SCHED;
            PG8_LDB(B1, 1, 1); PG8_STAGE(PG8_SB(1, 0), b3, voffB);
            PG8_WAIT_V(10); PG8_BAR; PG8_WAIT_L(0); PG8_MMA(0, 1, At, B1); PG8_BAR;
            PG8_LDA(At, 1, 1); PG8_STAGE_A(PG8_SA(1, 0), a3, 0, sA);
            PG8_WAIT_V(10); PG8_BAR; PG8_WAIT_L(0); PG8_MMA(1, 0, At, B0); PG8_BAR; PG8_SCHED;
            PG8_STAGE(PG8_SB(1, 1), b3 + hstepB, voffB);
            PG8_WAIT_V(10); PG8_BAR; PG8_MMA(1, 1, At, B1); PG8_BAR;
        }
        if constexpr (FP8) asm volatile("s_nop 15\n\ts_nop 15" ::: "memory");
        E(acc, cur, wr, wc, fr, fq);
        if (!has_next) break;
#pragma unroll
        for (int a = 0; a < 2; ++a)
#pragma unroll
            for (int b = 0; b < 2; ++b)
#pragma unroll
                for (int m = 0; m < 4; ++m)
#pragma unroll
                    for (int n = 0; n < 2; ++n) acc[a][b][m][n] = (f32x4){0.f, 0.f, 0.f, 0.f};
        cur = nxt; cA = nA; cB = nB; ++ui;
        if constexpr (GATHER) {
#pragma unroll
            for (int h = 0; h < 2; ++h)
#pragma unroll
                for (int i = 0; i < 2; ++i) vA[h][i] = nvA[h][i];
        }
    }
    PG8_WAIT_V(0);
    if (wr == 0) PG8_BAR;
    PG8_BAR;
#undef PG8_SA
#undef PG8_SB
#undef PG8_STAGE
#undef PG8_STAGE_GA
#undef PG8_STAGE_A
#undef PG8_LDA
#undef PG8_LDB
#undef PG8_MMA
#undef PG8_WAIT_V
#undef PG8_WAIT_L
#undef PG8_BAR
#undef PG8_SCHED
}

#define EPI_ROWS_BEGIN for (int ai = 0; ai < 2; ++ai) for (int m = 0; m < 4; ++m) { const int row = opaque(u.pm * BM + ai * HALF + wr * 64 + m * 16 + fr);
#define EPI_ROWS_END }
__device__ __forceinline__ u32x4 pack8(const f32x4 a, const f32x4 b) { u32x4 w; w.x = cvt_pk_bf16(a[0], a[1]); w.y = cvt_pk_bf16(a[2], a[3]); w.z = cvt_pk_bf16(b[0], b[1]); w.w = cvt_pk_bf16(b[2], b[3]); return w; }

struct EpiIn {
    static constexpr bool PERM = true;
    bf16_t* Z; int ldz, nz, nscale; float qscale; int split_cols; size_t split_stride; float* sm; int nsm; const float* smbias; float ascale = 1.0f;
    __device__ __forceinline__ void operator()(const f32x4 (&acc)[2][2][4][2], const Unit& u, int wr, int wc, int fr_, int fq_) const {
        const int fr = opaque(fr_), fq = opaque(fq_);
        if (u.pn < nz) {
            int colt = u.pn * BM; bf16_t* base = Z;
            if (split_cols) { const int t = colt / split_cols; base += (size_t)t * split_stride; colt -= t * split_cols; }
            const int col0 = colt + wc * 32 + 8 * fq; const float sc = ((u.pn < nscale) ? qscale : 1.0f) * ascale;
#pragma unroll
            for (int ai = 0; ai < 2; ++ai)
#pragma unroll
                for (int m = 0; m < 4; ++m) { const int row = opaque(u.pm * BM + ai * HALF + wr * 64 + m * 16 + fr); bf16_t* rowp = base + (size_t)row * ldz + col0;
#pragma unroll
                    for (int bj = 0; bj < 2; ++bj) *(u32x4*)(rowp + bj * HALF) = pack8(acc[ai][bj][m][0] * sc, acc[ai][bj][m][1] * sc); }
        } else if (u.pn == nz && sm) {
            if (wc == 0 && 8 * fq < nsm) {
                f32x4 b0 = {0.f, 0.f, 0.f, 0.f}, b1 = {0.f, 0.f, 0.f, 0.f};
                if (smbias) { b0 = *(const f32x4*)(smbias + 8 * fq); b1 = *(const f32x4*)(smbias + 8 * fq + 4); }
#pragma unroll
                for (int ai = 0; ai < 2; ++ai)
#pragma unroll
                    for (int m = 0; m < 4; ++m) { const int row = opaque(u.pm * BM + ai * HALF + wr * 64 + m * 16 + fr); float* rp = sm + (size_t)row * nsm + 8 * fq;
                        *(f32x4*)rp = acc[ai][0][m][0] * ascale + b0; *(f32x4*)(rp + 4) = acc[ai][0][m][1] * ascale + b1; }
            }
        }
    }
};
struct EpiOut {
    static constexpr bool PERM = false;
    const float* xres; float* Y;
    __device__ __forceinline__ void operator()(const f32x4 (&acc)[2][2][4][2], const Unit& u, int wr, int wc, int fr_, int fq_) const {
        const int fr = opaque(fr_), fq = opaque(fq_);
        const int col0 = u.pn * BM + wc * 32 + 4 * fq;
#pragma unroll
        for (int ai = 0; ai < 2; ++ai)
#pragma unroll
            for (int m = 0; m < 4; ++m) { const size_t off = (size_t)opaque(u.pm * BM + ai * HALF + wr * 64 + m * 16 + fr) * DM + col0;
#pragma unroll
                for (int bj = 0; bj < 2; ++bj)
#pragma unroll
                    for (int n = 0; n < 2; ++n) { const f32x4 xr = *(const f32x4*)(xres + off + bj * HALF + n * 16); *(f32x4*)(Y + off + bj * HALF + n * 16) = xr * ALPHA + acc[ai][bj][m][n]; } }
    }
};
struct EpiOutB {
    static constexpr bool PERM = true;
    const bf16_t* __restrict__ X; bf16_t* __restrict__ Y; float scale;
    __device__ __forceinline__ void operator()(const f32x4 (&acc)[2][2][4][2], const Unit& u, int wr, int wc, int fr_, int fq_) const {
        const int fr = opaque(fr_), fq = opaque(fq_);
        const int col0 = u.pn * BM + wc * 32 + 8 * fq;
#pragma unroll
        for (int ai = 0; ai < 2; ++ai) {
            const size_t off0 = (size_t)opaque(u.pm * BM + ai * HALF + wr * 64 + fr) * DM + col0;
            u32x4 xw[4][2];
#pragma unroll
            for (int m = 0; m < 4; ++m)
#pragma unroll
                for (int bj = 0; bj < 2; ++bj) xw[m][bj] = *(const u32x4*)(X + off0 + (size_t)m * 16 * DM + bj * HALF);
#pragma unroll
            for (int m = 0; m < 4; ++m)
#pragma unroll
                for (int bj = 0; bj < 2; ++bj) { const u32x4 w = xw[m][bj];
                    const f32x4 x0 = {bf_lo(w.x), bf_hi(w.x), bf_lo(w.y), bf_hi(w.y)}, x1 = {bf_lo(w.z), bf_hi(w.z), bf_lo(w.w), bf_hi(w.w)};
                    *(u32x4*)(Y + off0 + (size_t)m * 16 * DM + bj * HALF) = pack8(x0 * ALPHA + acc[ai][bj][m][0] * scale, x1 * ALPHA + acc[ai][bj][m][1] * scale); }
        }
    }
};
struct EpiSwiglu {
    static constexpr bool PERM = true;
    bf16_t* Hd;
    __device__ __forceinline__ void operator()(const f32x4 (&acc)[2][2][4][2], const Unit& u, int wr, int wc, int fr_, int fq_) const {
        const int fr = opaque(fr_), fq = opaque(fq_);
        const int col0 = u.pn * HALF + wc * 32 + 8 * fq;
#pragma unroll
        for (int ai = 0; ai < 2; ++ai)
#pragma unroll
            for (int m = 0; m < 4; ++m) { const int row = opaque(u.pm * BM + ai * HALF + wr * 64 + m * 16 + fr);
                f32x4 h0, h1;
#pragma unroll
                for (int j = 0; j < 4; ++j) { h0[j] = siluf_(acc[ai][0][m][0][j]) * acc[ai][1][m][0][j]; h1[j] = siluf_(acc[ai][0][m][1][j]) * acc[ai][1][m][1][j]; }
                *(u32x4*)(Hd + (size_t)u.pm * 262144 + (size_t)(col0 >> 6) * 16384 + (size_t)(row & 255) * 64 + (col0 & 63)) = pack8(h0, h1); }
    }
};
struct EpiSwiglu8 {
    static constexpr bool PERM = true;
    unsigned char* Hd;
    __device__ __forceinline__ void operator()(const f32x4 (&acc)[2][2][4][2], const Unit& u, int wr, int wc, int fr_, int fq_) const {
        const int fr = opaque(fr_), fq = opaque(fq_);
        const int c0 = wc * 32 + 8 * fq;
#pragma unroll
        for (int ai = 0; ai < 2; ++ai)
#pragma unroll
            for (int m = 0; m < 4; ++m) { const int r = ai * HALF + wr * 64 + m * 16 + fr;
                float h[8];
#pragma unroll
                for (int n = 0; n < 2; ++n)
#pragma unroll
                    for (int j = 0; j < 4; ++j) h[4 * n + j] = siluf_(acc[ai][0][m][n][j] * (1.0f / F8_SW1)) * acc[ai][1][m][n][j] * (F8_SH / F8_SW1);
                u32x2 o; o.x = pk4_fp8(h[0], h[1], h[2], h[3]); o.y = pk4_fp8(h[4], h[5], h[6], h[7]);
                *(u32x2*)(Hd + (size_t)u.pm * 262144 + (size_t)u.pn * 32768 + (size_t)r * 128 + c0) = o; }
    }
};
struct EpiBf16S {
    static constexpr bool PERM = true;
    bf16_t* O; int ldc; float scale;
    __device__ __forceinline__ void operator()(const f32x4 (&acc)[2][2][4][2], const Unit& u, int wr, int wc, int fr_, int fq_) const {
        const int fr = opaque(fr_), fq = opaque(fq_);
        const int col0 = u.pn * BM + wc * 32 + 8 * fq;
#pragma unroll
        for (int ai = 0; ai < 2; ++ai)
#pragma unroll
            for (int m = 0; m < 4; ++m) { const int row = opaque(u.pm * BM + ai * HALF + wr * 64 + m * 16 + fr); bf16_t* rowp = O + (size_t)row * ldc + col0;
#pragma unroll
                for (int bj = 0; bj < 2; ++bj) *(u32x4*)(rowp + bj * HALF) = pack8(acc[ai][bj][m][0] * scale, acc[ai][bj][m][1] * scale); }
    }
};
struct EpiFp8S {
    static constexpr bool PERM = true;
    unsigned char* O; int ldc; float scale;
    __device__ __forceinline__ void operator()(const f32x4 (&acc)[2][2][4][2], const Unit& u, int wr, int wc, int fr_, int fq_) const {
        const int fr = opaque(fr_), fq = opaque(fq_);
        const int col0 = u.pn * BM + wc * 32 + 8 * fq;
#pragma unroll
        for (int ai = 0; ai < 2; ++ai)
#pragma unroll
            for (int m = 0; m < 4; ++m) { const int row = opaque(u.pm * BM + ai * HALF + wr * 64 + m * 16 + fr); unsigned char* rowp = O + (size_t)row * ldc + col0;
#pragma unroll
                for (int bj = 0; bj < 2; ++bj) { const f32x4 a = acc[ai][bj][m][0] * scale, b = acc[ai][bj][m][1] * scale; u32x2 o; o.x = pk4_fp8(a[0], a[1], a[2], a[3]); o.y = pk4_fp8(b[0], b[1], b[2], b[3]);
                    *(u32x2*)(rowp + bj * HALF) = o; } }
    }
};
struct EpiBf16 {
    static constexpr bool PERM = true;
    bf16_t* O; int ldc;
    __device__ __forceinline__ void operator()(const f32x4 (&acc)[2][2][4][2], const Unit& u, int wr, int wc, int fr_, int fq_) const {
        const int fr = opaque(fr_), fq = opaque(fq_);
        const int col0 = u.pn * BM + wc * 32 + 8 * fq;
#pragma unroll
        for (int ai = 0; ai < 2; ++ai)
#pragma unroll
            for (int m = 0; m < 4; ++m) { const int row = opaque(u.pm * BM + ai * HALF + wr * 64 + m * 16 + fr); bf16_t* rowp = O + (size_t)row * ldc + col0;
#pragma unroll
                for (int bj = 0; bj < 2; ++bj) *(u32x4*)(rowp + bj * HALF) = pack8(acc[ai][bj][m][0], acc[ai][bj][m][1]); }
    }
};
struct EpiLruGate {
    static constexpr bool PERM = true;
    const bf16_t* UC; const float* ba; const float* bx; const float* lam;
    bf16_t* LA0; bf16_t* GT0; bf16_t* LA1; bf16_t* GT1;
    __device__ __forceinline__ void operator()(const f32x4 (&acc)[2][2][4][2], const Unit& u, int wr, int wc, int fr_, int fq_) const {
        const int fr = opaque(fr_), fq = opaque(fq_);
        const int dir = u.pn >> 3, ch0 = ((u.pn >> 1) & 3) * 256 + (u.pn & 1) * 128 + wc * 32 + 8 * fq;
        bf16_t* LA = dir ? LA1 : LA0; bf16_t* GT = dir ? GT1 : GT0;
        f32x4 vba[2], vbx[2], vll[2];
#pragma unroll
        for (int n = 0; n < 2; ++n) { const int cc = dir * 1024 + ch0 + 4 * n; vba[n] = *(const f32x4*)(ba + cc); vbx[n] = *(const f32x4*)(bx + cc); vll[n] = *(const f32x4*)(lam + cc);
#pragma unroll
            for (int j = 0; j < 4; ++j) vll[n][j] = 8.0f * logsigmoidf_(vll[n][j]); }
#pragma unroll
        for (int ai = 0; ai < 2; ++ai) {
            const size_t off0 = (size_t)opaque(u.pm * BM + ai * HALF + wr * 64 + fr) * 1024 + ch0;
#pragma unroll
            for (int mh = 0; mh < 2; ++mh) {
            u32x4 uw[4];
#pragma unroll
            for (int m = 2 * mh; m < 2 * mh + 2; ++m) uw[m] = *(const u32x4*)(UC + off0 + (size_t)m * 16 * 1024);
#pragma unroll
            for (int m = 2 * mh; m < 2 * mh + 2; ++m) {
                u32x4 o1; u32x2 o2;
#pragma unroll
                for (int n = 0; n < 2; ++n) {
                    const unsigned ua = uw[m][2 * n], ub = uw[m][2 * n + 1];
                    const float uv[4] = {bf_lo(ua), bf_hi(ua), bf_lo(ub), bf_hi(ub)};
                    float la[4], gt[4];
#pragma unroll
                    for (int j = 0; j < 4; ++j) { const float r = sigmoid_fast(acc[ai][0][m][n][j] + vba[n][j]), ig = sigmoid_fast(acc[ai][1][m][n][j] + vbx[n][j]);
                        const float l = r * vll[n][j]; la[j] = l; gt[j] = __builtin_amdgcn_sqrtf(fmaxf(1.0f - __expf(2.0f * l), 0.f)) * ig * uv[j]; }
                    o1[2 * n] = cvt_pk_bf16(la[0], la[1]); o1[2 * n + 1] = cvt_pk_bf16(la[2], la[3]); o2[n] = pk4_fp8(gt[0] * F8_SG, gt[1] * F8_SG, gt[2] * F8_SG, gt[3] * F8_SG); }
                *(u32x4*)(LA + off0 + (size_t)m * 16 * 1024) = o1; *(u32x2*)((unsigned char*)GT + off0 + (size_t)m * 16 * 1024) = o2; }
            __builtin_amdgcn_sched_barrier(0);
            }
        }
    }
};
#ifndef ATT_FP8
#define ATT_FP8 1
#endif
struct EpiMlaQ {
    static constexpr bool PERM = true;
    bf16_t* Q; const float* cs; const float* sn;
    __device__ __forceinline__ void st8(size_t eoff, const f32x4 a, const f32x4 b) const {
        if (ATT_FP8) { u32x2 o; o.x = pk4_fp8(a[0], a[1], a[2], a[3]); o.y = pk4_fp8(b[0], b[1], b[2], b[3]); *(u32x2*)((unsigned char*)Q + eoff) = o; }
        else *(u32x4*)(Q + eoff) = pack8(a, b);
    }
    __device__ __forceinline__ void operator()(const f32x4 (&acc)[2][2][4][2], const Unit& u, int wr, int wc, int fr_, int fq_) const {
        const int fr = opaque(fr_), fq = opaque(fq_);
        if (u.pn < 4) {
#pragma unroll
            for (int ai = 0; ai < 2; ++ai)
#pragma unroll
                for (int m = 0; m < 4; ++m) { const int row = opaque(u.pm * BM + ai * HALF + wr * 64 + m * 16 + fr);
#pragma unroll
                    for (int bj = 0; bj < 2; ++bj) { const int h = u.pn * 2 + bj; st8((size_t)row * 1536 + h * 192 + wc * 32 + 8 * fq, acc[ai][bj][m][0], acc[ai][bj][m][1]); } }
        } else {
            const int h = (u.pn - 4) * 4 + wc, i0 = 8 * fq;
#pragma unroll
            for (int ai = 0; ai < 2; ++ai) {
                const int row0 = opaque(u.pm * BM + ai * HALF + wr * 64 + fr);
                f32x4 c[4][2], s[4][2];
#pragma unroll
                for (int m = 0; m < 4; ++m)
#pragma unroll
                    for (int n = 0; n < 2; ++n) { c[m][n] = *(const f32x4*)(cs + (size_t)(row0 + 16 * m) * 32 + i0 + 4 * n); s[m][n] = *(const f32x4*)(sn + (size_t)(row0 + 16 * m) * 32 + i0 + 4 * n); }
#pragma unroll
                for (int m = 0; m < 4; ++m) { f32x4 o1[2], o2[2];
#pragma unroll
                    for (int n = 0; n < 2; ++n) { const f32x4 x1 = acc[ai][0][m][n], x2 = acc[ai][1][m][n]; o1[n] = x1 * c[m][n] - x2 * s[m][n]; o2[n] = x2 * c[m][n] + x1 * s[m][n]; }
                    const size_t qo = (size_t)(row0 + 16 * m) * 1536 + h * 192 + 128 + i0;
                    st8(qo, o1[0], o1[1]); st8(qo + 32, o2[0], o2[1]); }
            }
        }
    }
};
#ifndef ATT_PV8
#define ATT_PV8 0
#endif
struct EpiMlaKV {
    static constexpr bool PERM = true;
    static constexpr bool SWAPB1 = (ATT_FP8 && ATT_PV8);
    bf16_t* Kc; bf16_t* Vc;
    __device__ __forceinline__ void operator()(const f32x4 (&acc)[2][2][4][2], const Unit& u, int wr, int wc, int fr_, int fq_) const {
        const int fr = opaque(fr_), fq = opaque(fq_);
        const int h = u.pn, c0 = wc * 32 + 8 * fq;
#pragma unroll
        for (int ai = 0; ai < 2; ++ai)
#pragma unroll
            for (int m = 0; m < 4; ++m) { const int row = opaque(u.pm * BM + ai * HALF + wr * 64 + m * 16 + fr); const int b = row >> 11, s = row & 2047;
                const size_t r = ((size_t)(b * 8 + h) * SEQ + s);
                if (ATT_FP8) { u32x2 o; o.x = pk4_fp8(acc[ai][0][m][0][0], acc[ai][0][m][0][1], acc[ai][0][m][0][2], acc[ai][0][m][0][3]); o.y = pk4_fp8(acc[ai][0][m][1][0], acc[ai][0][m][1][1], acc[ai][0][m][1][2], acc[ai][0][m][1][3]);
                    *(u32x2*)((unsigned char*)Kc + r * 192 + c0) = o; }
                else *(u32x4*)(Kc + r * 192 + c0) = pack8(acc[ai][0][m][0], acc[ai][0][m][1]);
                if (!SWAPB1) *(u32x4*)(Vc + r * 128 + c0) = pack8(acc[ai][1][m][0], acc[ai][1][m][1]); }
        if (SWAPB1) {
#pragma unroll
            for (int n = 0; n < 2; ++n) { const int dv = wc * 32 + perm32(16 * n + fr);
#pragma unroll
                for (int ai = 0; ai < 2; ++ai)
#pragma unroll
                    for (int m = 0; m < 4; ++m) { const int row = opaque(u.pm * BM + ai * HALF + wr * 64 + m * 16 + 4 * fq); const int b = row >> 11, s0 = row & 2047;
                        const f32x4 v = acc[ai][1][m][n] * F8_SV;
                        *(unsigned*)((unsigned char*)Vc + ((size_t)((b * 8 + h) * 128 + dv)) * SEQ + s0) = pk4_fp8(v[0], v[1], v[2], v[3]); } }
        }
    }
};
}
#ifndef INP_FP8
#define INP_FP8 0
#endif
#ifndef OUT_FP8
#define OUT_FP8 0
#endif
#ifndef MOE_FP8
#define MOE_FP8 1
#endif
struct Ctx {
    LAS unsigned char* lds;
    int tid, lane, wave, G, gw, NGW;
    const void* const* in;
    float* out; unsigned char* ws;
};
#define IN_F(i) ((const float*)C.in[i])
enum { I_X = 0, I_POS, I_ML_WIN, I_ML_GB, I_ML_NG, I_ML_WOUT, I_GL_WIN, I_GL_GW, I_GL_GB, I_GL_NG, I_GL_WOUT,
       I_LR_WIN, I_LR_CW, I_LR_CB, I_LR_GAW, I_LR_GAB, I_LR_GXW, I_LR_GXB, I_LR_LAM, I_LR_WOUT,
       I_MA_WIN, I_MA_QG, I_MA_KVG, I_MA_UQ, I_MA_UKV, I_MA_WOUT, I_MOE_R, I_MOE_G, I_MOE_U, I_MOE_D, I_LN_G, I_LN_B, N_IN };

#ifndef USE_TOUCH
#define USE_TOUCH 0
#endif
__device__ __forceinline__ void touch_region(Ctx& C, const void* p, size_t bytes) {
    if (!USE_TOUCH) return;
    const u32x4* q = (const u32x4*)p; const size_t n = bytes / 16; unsigned acc = 0u;
    for (size_t i = (size_t)blockIdx.x * 512 + C.tid; i < n; i += (size_t)C.G * 512 * 4) {
        u32x4 v0 = q[i], v1 = {0u, 0u, 0u, 0u}, v2 = v1, v3 = v1;
        if (i + (size_t)C.G * 512 < n) v1 = q[i + (size_t)C.G * 512];
        if (i + (size_t)C.G * 1024 < n) v2 = q[i + (size_t)C.G * 1024];
        if (i + (size_t)C.G * 1536 < n) v3 = q[i + (size_t)C.G * 1536];
        acc ^= (v0.x ^ v1.x) ^ (v2.x ^ v3.x);
    }
    asm volatile("" :: "v"(acc));
    __syncthreads();
}
template <class RM>
__device__ __forceinline__ void tr_item(const float* W, int ldw, int nsrc, bf16_t* WT, int ldk, LAS float* scr, int k0, int n0, int lane, RM rowmap) {
    { const int n4 = (lane & 7) * 4; f32x4 w[8];
#pragma unroll
      for (int i = 0; i < 8; ++i) { const int kk = 8 * i + (lane >> 3); w[i] = (n0 + n4 < nsrc) ? *(const f32x4*)(W + (size_t)(k0 + kk) * ldw + n0 + n4) : (f32x4){0.f, 0.f, 0.f, 0.f}; }
#pragma unroll
      for (int i = 0; i < 8; ++i) { const int kk = 8 * i + (lane >> 3); LAS float* d = scr + kk * 33 + n4; d[0] = w[i][0]; d[1] = w[i][1]; d[2] = w[i][2]; d[3] = w[i][3]; } }
    LDS_WAIT(); asm volatile("" ::: "memory");
    const int c = lane & 7;
#pragma unroll
    for (int j = 0; j < 4; ++j) { const int n = (lane >> 3) + 8 * j; const LAS float* s = scr + (8 * c) * 33 + n;
        u32x4 o; o.x = cvt_pk_bf16(s[0 * 33], s[1 * 33]); o.y = cvt_pk_bf16(s[2 * 33], s[3 * 33]); o.z = cvt_pk_bf16(s[4 * 33], s[5 * 33]); o.w = cvt_pk_bf16(s[6 * 33], s[7 * 33]);
        *(u32x4*)(WT + (size_t)rowmap(n0 + n) * ldk + k0 + 8 * c) = o; }
    LDS_WAIT(); asm volatile("" ::: "memory");
}
template <class RM>
__device__ __forceinline__ void tr_item8(const float* W, int ldw, unsigned char* WT, int ldkb, LAS float* scr, int k0, int n0, int lane, float scale, RM rowmap, int nsrc = 1 << 30) {
    { const int n4 = (lane & 7) * 4; f32x4 w[8];
#pragma unroll
      for (int i = 0; i < 8; ++i) { const int kk = 8 * i + (lane >> 3); w[i] = (n0 + n4 < nsrc) ? *(const f32x4*)(W + (size_t)(k0 + kk) * ldw + n0 + n4) : (f32x4){0.f, 0.f, 0.f, 0.f}; }
#pragma unroll
      for (int i = 0; i < 8; ++i) { const int kk = 8 * i + (lane >> 3); LAS float* d = scr + kk * 33 + n4; d[0] = w[i][0]; d[1] = w[i][1]; d[2] = w[i][2]; d[3] = w[i][3]; } }
    LDS_WAIT(); asm volatile("" ::: "memory");
    const int c = lane & 7;
#pragma unroll
    for (int j = 0; j < 4; ++j) { const int n = (lane >> 3) + 8 * j; const LAS float* s = scr + (8 * c) * 33 + n;
        u32x2 o; o.x = pk4_fp8(s[0 * 33] * scale, s[1 * 33] * scale, s[2 * 33] * scale, s[3 * 33] * scale); o.y = pk4_fp8(s[4 * 33] * scale, s[5 * 33] * scale, s[6 * 33] * scale, s[7 * 33] * scale);
        *(u32x2*)(WT + (size_t)rowmap(n0 + n) * ldkb + k0 + 8 * c) = o; }
    LDS_WAIT(); asm volatile("" ::: "memory");
}
__device__ __forceinline__ void prep_moe_weights8(Ctx& C, int layer) {
    LAS float* scr = (LAS float*)(C.lds + C.wave * 16384);
    const float* wg = IN_F(I_MOE_G) + (size_t)layer * 16 * 1048576; const float* wu = IN_F(I_MOE_U) + (size_t)layer * 16 * 1048576; const float* wd = IN_F(I_MOE_D) + (size_t)layer * 16 * 1048576;
    unsigned char* W1 = C.ws + WS_WMOE; unsigned char* W2 = W1 + (size_t)16 * 2048 * 1024;
    for (int it = C.gw; it < 16 * 3 * 512; it += C.NGW) {
        const int e = it / 1536, r = it % 1536, which = r / 512, ib = r % 512, k0 = 64 * (ib / 32), n0 = 32 * (ib % 32);
        if (which < 2) tr_item8((which ? wu : wg) + (size_t)e * 1048576, 1024, W1 + (size_t)e * 2048 * 1024, 1024, scr, k0, n0, C.lane, F8_SW1, [which](int n) { return (n >> 7) * 256 + which * 128 + (n & 127); });
        else tr_item8(wd + (size_t)e * 1048576, 1024, W2 + (size_t)e * 1048576, 1024, scr, k0, n0, C.lane, F8_SW2, [](int n) { return n; });
    }
}
template <class RM>
__device__ __forceinline__ void convert_matrix(Ctx& C, const float* W, int K, int ldw, int nsrc, int npad, bf16_t* WT, int ldk, RM rowmap) {
    LAS float* scr = (LAS float*)(C.lds + C.wave * 16384);
    const int nkb = K / 64, nnb = npad / 32;
    for (int it = C.gw; it < nkb * nnb; it += C.NGW) tr_item(W, ldw, nsrc, WT, ldk, scr, 64 * (it / nnb), 32 * (it % nnb), C.lane, rowmap);
}
__device__ __forceinline__ void convert_matrix8(Ctx& C, const float* W, int K, int ldw, int N, unsigned char* WT, int ldkb, float scale, int nsrc = 1 << 30) {
    LAS float* scr = (LAS float*)(C.lds + C.wave * 16384);
    const int nkb = K / 64, nnb = N / 32;
    for (int it = C.gw; it < nkb * nnb; it += C.NGW) tr_item8(W, ldw, WT, ldkb, scr, 64 * (it / nnb), 32 * (it % nnb), C.lane, scale, [](int n) { return n; }, nsrc);
}
__device__ __forceinline__ void prep_mixer_weights(Ctx& C) {
    bf16_t* wm = (bf16_t*)(C.ws + WS_WMIX);
    auto ident = [](int n) { return n; };
    if (INP_FP8) convert_matrix8(C, IN_F(I_ML_WIN), 1024, 3088, 3328, (unsigned char*)wm + WM_ML_IN, 1024, F8_SWI, 3088); else convert_matrix(C, IN_F(I_ML_WIN), 1024, 3088, 3088, 3328, (bf16_t*)((char*)wm + WM_ML_IN), 1024, ident);
    if (OUT_FP8) convert_matrix8(C, IN_F(I_ML_WOUT), 1024, 1024, 1024, (unsigned char*)wm + WM_ML_OUT, 1024, F8_SWO); else convert_matrix(C, IN_F(I_ML_WOUT), 1024, 1024, 1024, 1024, (bf16_t*)((char*)wm + WM_ML_OUT), 1024, ident);
    if (INP_FP8) convert_matrix8(C, IN_F(I_GL_WIN), 1024, 3104, 3328, (unsigned char*)wm + WM_GL_IN, 1024, F8_SWI, 3104); else convert_matrix(C, IN_F(I_GL_WIN), 1024, 3104, 3104, 3328, (bf16_t*)((char*)wm + WM_GL_IN), 1024, ident);
    if (OUT_FP8) convert_matrix8(C, IN_F(I_GL_WOUT), 1024, 1024, 1024, (unsigned char*)wm + WM_GL_OUT, 1024, F8_SWO); else convert_matrix(C, IN_F(I_GL_WOUT), 1024, 1024, 1024, 1024, (bf16_t*)((char*)wm + WM_GL_OUT), 1024, ident);
    convert_matrix(C, IN_F(I_LR_WIN), 1024, 2048, 2048, 2048, (bf16_t*)((char*)wm + WM_LR_IN), 1024, ident);
    if (OUT_FP8) convert_matrix8(C, IN_F(I_LR_WOUT), 1024, 1024, 1024, (unsigned char*)wm + WM_LR_OUT, 1024, F8_SWO); else convert_matrix(C, IN_F(I_LR_WOUT), 1024, 1024, 1024, 1024, (bf16_t*)((char*)wm + WM_LR_OUT), 1024, ident);
    for (int sm = 0; sm < 16; ++sm) { const int which = sm >> 3, dir = (sm >> 2) & 1, blk = sm & 3;
        const float* src = (which ? IN_F(I_LR_GXW) : IN_F(I_LR_GAW)) + (size_t)(dir * 4 + blk) * 65536;
        const int rbase = dir * 2048 + blk * 512 + which * 128;
        convert_matrix(C, src, 256, 256, 256, 256, (bf16_t*)((char*)wm + WM_LR_G), 256, [rbase](int j) { return rbase + (j >> 7) * 256 + (j & 127); }); }
    convert_matrix(C, IN_F(I_MA_WIN), 1024, 704, 704, 768, (bf16_t*)((char*)wm + WM_MA_IN), 1024, ident);
    convert_matrix(C, IN_F(I_MA_UQ), 384, 1536, 1536, 1536, (bf16_t*)((char*)wm + WM_MA_UQ), 384,
                   [](int n) { const int h = n / 192, d = n - h * 192; if (d < 128) return h * 128 + d; const int i = d - 128; return 1024 + (h >> 2) * 256 + (i >> 5) * 128 + (h & 3) * 32 + (i & 31); });
    convert_matrix(C, IN_F(I_MA_UKV), 256, 2048, 2048, 2048, (bf16_t*)((char*)wm + WM_MA_UKV), 256, ident);
    convert_matrix(C, IN_F(I_MA_WOUT), 1024, 1024, 1024, 1024, (bf16_t*)((char*)wm + WM_MA_OUT), 1024, ident);
}
__device__ __forceinline__ void prep_moe_weights(Ctx& C, int layer) {
    LAS float* scr = (LAS float*)(C.lds + C.wave * 16384);
    const float* wg = IN_F(I_MOE_G) + (size_t)layer * 16 * 1048576; const float* wu = IN_F(I_MOE_U) + (size_t)layer * 16 * 1048576; const float* wd = IN_F(I_MOE_D) + (size_t)layer * 16 * 1048576;
    bf16_t* W1 = (bf16_t*)(C.ws + WS_WMOE); bf16_t* W2 = W1 + (size_t)16 * 2048 * 1024;
    for (int it = C.gw; it < 16 * 3 * 512; it += C.NGW) {
        const int e = it / 1536, r = it % 1536, which = r / 512, ib = r % 512, k0 = 64 * (ib / 32), n0 = 32 * (ib % 32);
        if (which < 2) tr_item((which ? wu : wg) + (size_t)e * 1048576, 1024, 1024, W1 + (size_t)e * 2048 * 1024, 1024, scr, k0, n0, C.lane, [which](int n) { return (n >> 7) * 256 + which * 128 + (n & 127); });
        else tr_item(wd + (size_t)e * 1048576, 1024, 1024, W2 + (size_t)e * 1048576, 1024, scr, k0, n0, C.lane, [](int n) { return n; });
    }
}
__device__ __forceinline__ void prep_xb(Ctx& C) {
    const f32x4* x = (const f32x4*)IN_F(I_X); u32x2* xb = (u32x2*)(C.ws + WS_XB);
    const size_t n4 = (size_t)NT * DM / 4;
    unsigned* x8 = (unsigned*)(C.ws + WS_XB8);
    for (size_t i = (size_t)blockIdx.x * 512 + C.tid; i < n4; i += (size_t)C.G * 512) { const f32x4 v = x[i]; u32x2 o; o.x = cvt_pk_bf16(v[0], v[1]); o.y = cvt_pk_bf16(v[2], v[3]); xb[i] = o;
        if (INP_FP8) x8[i] = pk4_fp8(v[0], v[1], v[2], v[3]); }
}
__device__ __forceinline__ void prep_rope(Ctx& C) {
    const int* pos = (const int*)C.in[I_POS]; float* cs = (float*)(C.ws + WS_ROPE); float* sn = cs + (size_t)NT * 32;
    for (size_t i = (size_t)blockIdx.x * 512 + C.tid; i < (size_t)NT * 32; i += (size_t)C.G * 512) {
        const int t = (int)(i >> 5), k = (int)(i & 31);
        const float freq = exp2f(-(float)k * (13.287712379549449f / 32.0f));
        const float ang = (float)pos[t] * freq;
        const double q = rint((double)ang * 0.15915494309189535); const float r = (float)((double)ang - q * 6.283185307179586);
        cs[i] = __cosf(r); sn[i] = __sinf(r);
    }
}

__device__ __forceinline__ void ln_row_norm(f32x4 (&v)[4], const f32x4 (&gv)[4], const f32x4 (&bv)[4]) {
    float s = 0.f;
#pragma unroll
    for (int j = 0; j < 4; ++j) s += (v[j][0] + v[j][1]) + (v[j][2] + v[j][3]);
    const float mean = wave_sum(s) * (1.f / DM); float s2 = 0.f;
#pragma unroll
    for (int j = 0; j < 4; ++j) { v[j] = v[j] - mean; s2 += (v[j][0] * v[j][0] + v[j][1] * v[j][1]) + (v[j][2] * v[j][2] + v[j][3] * v[j][3]); }
    const float rstd = 1.f / sqrtf(wave_sum(s2) * (1.f / DM) + LN_EPS);
#pragma unroll
    for (int j = 0; j < 4; ++j) v[j] = v[j] * rstd * gv[j] + bv[j];
}
__device__ __forceinline__ void router_reduce_store(const float (&p)[16], int lane, float* aff, int row) {
    float lg[16]; float mx = -3.0e38f;
#pragma unroll
    for (int e = 0; e < 16; ++e) { lg[e] = wave_sum(p[e]); mx = fmaxf(mx, lg[e]); }
    float sm = 0.f, mine = 0.f;
#pragma unroll
    for (int e = 0; e < 16; ++e) { const float ex = expf(lg[e] - mx); sm += ex; mine = (lane == e) ? ex : mine; }
    if (lane < 16) aff[((size_t)(row >> 11) * NEXP + lane) * SEQ + (row & 2047)] = mine / sm;
}
__device__ __forceinline__ float row_sum16(float v) { v += dpp_f<0xB1>(v); v += dpp_f<0x4E>(v); v += dpp_f<0x141>(v); v += dpp_f<0x140>(v); return v; }
__device__ __forceinline__ float row_max16(float v) { v = fmaxf(v, dpp_f<0xB1>(v)); v = fmaxf(v, dpp_f<0x4E>(v)); v = fmaxf(v, dpp_f<0x141>(v)); v = fmaxf(v, dpp_f<0x140>(v)); return v; }
__device__ __forceinline__ void ln1_router(Ctx& C, int layer, const bf16_t* Yb, int r0, int rs, int nr) {
    const float* g = IN_F(I_LN_G) + (size_t)(layer * 2 + 0) * DM; const float* bb = IN_F(I_LN_B) + (size_t)(layer * 2 + 0) * DM;
    const float* wr = IN_F(I_MOE_R) + (size_t)layer * DM * NEXP;
    constexpr int RP = 2064;
    LAS unsigned char* WT = C.lds;
    LAS unsigned char* XT = C.lds + 16 * RP + C.wave * (4 * RP);
    for (int i = C.tid; i < DM * NEXP; i += 512) { const int d = i >> 4, e = i & 15; *(LAS bf16_t*)(WT + e * RP + d * 2) = f2bf(wr[i]); }
    __syncthreads();
    float* aff = (float*)(C.ws + WS_SMALL + SM_AFF);
    f32x4 gv[4], bv[4];
#pragma unroll
    for (int j = 0; j < 4; ++j) { gv[j] = *(const f32x4*)(g + 4 * C.lane + 256 * j); bv[j] = *(const f32x4*)(bb + 4 * C.lane + 256 * j); }
    u32x2 n1[4], n2[4];
    { const u32x2* yr = (const u32x2*)(Yb + (size_t)r0 * DM); const u32x2* yr2 = (const u32x2*)(Yb + (size_t)(r0 + rs) * DM);
#pragma unroll
      for (int j = 0; j < 4; ++j) { n1[j] = yr[C.lane + 64 * j]; n2[j] = yr2[C.lane + 64 * j]; } }
    for (int k = 0; k < nr; ++k) { const int row = r0 + k * rs;
        f32x4 v[4];
#pragma unroll
        for (int j = 0; j < 4; ++j) { const u32x2 w = n1[j]; v[j] = (f32x4){bf_lo(w.x), bf_hi(w.x), bf_lo(w.y), bf_hi(w.y)}; n1[j] = n2[j]; }
        { const u32x2* yr = (const u32x2*)(Yb + (size_t)(r0 + (k + 2 < nr ? k + 2 : nr - 1) * rs) * DM);
#pragma unroll
            for (int j = 0; j < 4; ++j) n2[j] = yr[C.lane + 64 * j]; }
        ln_row_norm(v, gv, bv);
        u32x2* xb = (u32x2*)(C.ws + WS_XB + (size_t)row * DM * 2); u32x2 ob[4];
        LAS unsigned char* xt = XT + (k & 3) * RP + 8 * opaque(C.lane);
#pragma unroll
        for (int j = 0; j < 4; ++j) { ob[j].x = cvt_pk_bf16(v[j][0], v[j][1]); ob[j].y = cvt_pk_bf16(v[j][2], v[j][3]); xb[C.lane + 64 * j] = ob[j]; *(LAS u32x2*)(xt + 512 * j) = ob[j]; }
        if (MOE_FP8) { unsigned* x8 = (unsigned*)(C.ws + WS_XB8 + (size_t)row * DM);
#pragma unroll
            for (int j = 0; j < 4; ++j) x8[C.lane + 64 * j] = pk4_fp8(v[j][0], v[j][1], v[j][2], v[j][3]); }
        if ((k & 3) == 3) {
            const int ln = opaque(C.lane);
            const LAS unsigned char* xa = XT + (ln & 3) * RP + (ln >> 4) * 16; const LAS unsigned char* wb = WT + (ln & 15) * RP + (ln >> 4) * 16;
            f32x4 a0 = {0.f, 0.f, 0.f, 0.f}, a1 = a0, a2 = a0, a3 = a0;
#pragma unroll
            for (int s = 0; s < 32; s += 4) {
                a0 = __builtin_amdgcn_mfma_f32_16x16x32_bf16(*(const LAS bf16x8*)(xa + s * 64), *(const LAS bf16x8*)(wb + s * 64), a0, 0, 0, 0);
                a1 = __builtin_amdgcn_mfma_f32_16x16x32_bf16(*(const LAS bf16x8*)(xa + s * 64 + 64), *(const LAS bf16x8*)(wb + s * 64 + 64), a1, 0, 0, 0);
                a2 = __builtin_amdgcn_mfma_f32_16x16x32_bf16(*(const LAS bf16x8*)(xa + s * 64 + 128), *(const LAS bf16x8*)(wb + s * 64 + 128), a2, 0, 0, 0);
                a3 = __builtin_amdgcn_mfma_f32_16x16x32_bf16(*(const LAS bf16x8*)(xa + s * 64 + 192), *(const LAS bf16x8*)(wb + s * 64 + 192), a3, 0, 0, 0); }
            const f32x4 lg = (a0 + a1) + (a2 + a3);
#pragma unroll
            for (int i = 0; i < 4; ++i) { const float mx = row_max16(lg[i]), ex = __expf(lg[i] - mx), sm = row_sum16(ex); const int rr = r0 + (k - 3 + i) * rs;
                if (ln < 16) aff[((size_t)(rr >> 11) * NEXP + ln) * SEQ + (rr & 2047)] = ex * __builtin_amdgcn_rcpf(sm); }
        }
    }
    __syncthreads();
}

__device__ __forceinline__ void topk_select(Ctx& C) {
    const float* aff = (const float*)(C.ws + WS_SMALL + SM_AFF);
    int* rowtok = (int*)(C.ws + WS_SMALL + SM_IDX); short* inv = (short*)(C.ws + WS_SMALL + SM_INV);
    const int tid = C.tid, lane = C.lane, half = tid >> 8, ht = tid & 255, hw = (tid >> 6) & 3;
    LAS int* hist = (LAS int*)C.lds + half * 256; LAS unsigned* ctl = (LAS unsigned*)(C.lds + 2048) + half * 2; LAS unsigned* wtot = (LAS unsigned*)(C.lds + 2112) + half * 4;
    for (int u0 = 2 * blockIdx.x; u0 < NB * NEXP; u0 += 2 * C.G) {
        const int unit = u0 + half, b = unit >> 4, e = unit & 15;
        const u32x4 k0 = *(const u32x4*)(aff + (size_t)unit * SEQ + 8 * ht), k1 = *(const u32x4*)(aff + (size_t)unit * SEQ + 8 * ht + 4);
        const unsigned key[8] = {k0.x, k0.y, k0.z, k0.w, k1.x, k1.y, k1.z, k1.w};
        unsigned prefix = 0u, mask = 0u; int kneed = CAP;
#pragma unroll 1
        for (int pass = 0; pass < 4; ++pass) {
            const int shift = 24 - 8 * pass;
            hist[ht] = 0;
            __syncthreads();
#pragma unroll
            for (int k = 0; k < 8; ++k) if ((key[k] & mask) == prefix) __hip_atomic_fetch_add(&hist[(key[k] >> shift) & 255u], 1, __ATOMIC_RELAXED, __HIP_MEMORY_SCOPE_WORKGROUP);
            __syncthreads();
            if (hw == 0) {
                const int b0 = hist[255 - 4 * lane], b1 = hist[254 - 4 * lane], b2 = hist[253 - 4 * lane], b3 = hist[252 - 4 * lane];
                const int c4 = b0 + b1 + b2 + b3; int inc = c4;
#pragma unroll
                for (int o = 1; o < 64; o <<= 1) { const int t = __shfl_up(inc, o); if (lane >= o) inc += t; }
                const int before = inc - c4;
                if (before < kneed && kneed <= inc) {
                    int bin, above;
                    if (kneed <= before + b0) { bin = 255 - 4 * lane; above = before; }
                    else if (kneed <= before + b0 + b1) { bin = 254 - 4 * lane; above = before + b0; }
                    else if (kneed <= before + b0 + b1 + b2) { bin = 253 - 4 * lane; above = before + b0 + b1; }
                    else { bin = 252 - 4 * lane; above = before + b0 + b1 + b2; }
                    ctl[0] = prefix | ((unsigned)bin << shift); ctl[1] = (unsigned)(kneed - above);
                }
            }
            __syncthreads();
            prefix = ctl[0]; kneed = (int)ctl[1]; mask |= 255u << shift;
        }
        unsigned cnt = 0u;
#pragma unroll
        for (int k = 0; k < 8; ++k) cnt += (key[k] > prefix ? 1u : 0u) + (key[k] == prefix ? 0x10000u : 0u);
        unsigned inc = cnt;
#pragma unroll
        for (int o = 1; o < 64; o <<= 1) { const unsigned t = __shfl_up(inc, o); if (lane >= o) inc += t; }
        if (lane == 63) wtot[hw] = inc;
        __syncthreads();
        unsigned base = inc - cnt;
#pragma unroll
        for (int q = 0; q < 4; ++q) base += (q < hw) ? wtot[q] : 0u;
        int gtp = (int)(base & 0xffffu), eqp = (int)(base >> 16); unsigned short iv[8];
#pragma unroll
        for (int k = 0; k < 8; ++k) { const bool gt = key[k] > prefix, eq = key[k] == prefix; const bool sel = gt || (eq && eqp < kneed);
            const int slot = gtp + (eqp < kneed ? eqp : kneed);
            if (sel) rowtok[(e * NB + b) * CAP + slot] = b * SEQ + 8 * ht + k;
            iv[k] = sel ? (unsigned short)slot : (unsigned short)0xffffu; gtp += gt ? 1 : 0; eqp += eq ? 1 : 0; }
        u32x4 o; o.x = (unsigned)iv[0] | ((unsigned)iv[1] << 16); o.y = (unsigned)iv[2] | ((unsigned)iv[3] << 16); o.z = (unsigned)iv[4] | ((unsigned)iv[5] << 16); o.w = (unsigned)iv[6] | ((unsigned)iv[7] << 16);
        *(u32x4*)(inv + (size_t)unit * SEQ + 8 * ht) = o;
        __syncthreads();
    }
}

template <bool LAST>
__device__ __forceinline__ void moe_combine_ln2(Ctx& C, int layer) {
    const float* g = IN_F(I_LN_G) + (size_t)(layer * 2 + 1) * DM; const float* bb = IN_F(I_LN_B) + (size_t)(layer * 2 + 1) * DM;
    const float* aff = (const float*)(C.ws + WS_SMALL + SM_AFF); const short* inv = (const short*)(C.ws + WS_SMALL + SM_INV);
    const bf16_t* OUTB = (const bf16_t*)(C.ws + WS_Z);
    f32x4 gv[4], bv[4];
#pragma unroll
    for (int j = 0; j < 4; ++j) { gv[j] = *(const f32x4*)(g + 4 * C.lane + 256 * j); bv[j] = *(const f32x4*)(bb + 4 * C.lane + 256 * j); }
    u32x2 n1[4], n2[4]; int inv1 = -1, inv2 = -1; float aff1 = 0.f, aff2 = 0.f;
    { const int row = C.gw, r2 = C.gw + C.NGW; const u32x2* xr = (const u32x2*)(C.ws + WS_XB + (size_t)row * DM * 2); const u32x2* xr2 = (const u32x2*)(C.ws + WS_XB + (size_t)r2 * DM * 2);
#pragma unroll
      for (int j = 0; j < 4; ++j) { n1[j] = xr[C.lane + 64 * j]; n2[j] = xr2[C.lane + 64 * j]; }
      if (C.lane < 16) { const size_t ia = ((size_t)(row >> 11) * NEXP + C.lane) * SEQ + (row & 2047); inv1 = (int)inv[ia]; aff1 = aff[ia];
                         const size_t ib = ((size_t)(r2 >> 11) * NEXP + C.lane) * SEQ + (r2 & 2047); inv2 = (int)inv[ib]; aff2 = aff[ib]; } }
    for (int row = C.gw; row < NT; row += C.NGW) {
        u32x2* xb = (u32x2*)(C.ws + WS_XB + (size_t)row * DM * 2); const int b = row >> 11;
        f32x4 v[4];
#pragma unroll
        for (int j = 0; j < 4; ++j) { const u32x2 w = n1[j]; v[j] = (f32x4){bf_lo(w.x), bf_hi(w.x), bf_lo(w.y), bf_hi(w.y)} * ALPHA; n1[j] = n2[j]; }
        const int myinv = inv1; const float myaff = aff1; inv1 = inv2; aff1 = aff2;
        if (row + 2 * C.NGW < NT) { const int r2 = row + 2 * C.NGW; const u32x2* xr = (const u32x2*)(C.ws + WS_XB + (size_t)r2 * DM * 2);
#pragma unroll
            for (int j = 0; j < 4; ++j) n2[j] = xr[C.lane + 64 * j];
            if (C.lane < 16) { const size_t ia = ((size_t)(r2 >> 11) * NEXP + C.lane) * SEQ + (r2 & 2047); inv2 = (int)inv[ia]; aff2 = aff[ia]; } }
        unsigned long long m = __ballot(myinv >= 0);
        while (m) {
            const int e1 = __builtin_ctzll(m); m &= m - 1; const bool two = (m != 0ull); const int e2 = two ? __builtin_ctzll(m) : e1; if (two) m &= m - 1;
            const int c1 = __builtin_amdgcn_readlane(myinv, e1), c2 = __builtin_amdgcn_readlane(myinv, e2);
            const float g1 = __uint_as_float((unsigned)__builtin_amdgcn_readlane((int)__float_as_uint(myaff), e1));
            const float g2 = two ? __uint_as_float((unsigned)__builtin_amdgcn_readlane((int)__float_as_uint(myaff), e2)) : 0.f;
#if MOE_FP8
            const unsigned* o1 = (const unsigned*)((const unsigned char*)OUTB + ((size_t)(e1 * NB + b) * CAP + c1) * DM); const unsigned* o2 = (const unsigned*)((const unsigned char*)OUTB + ((size_t)(e2 * NB + b) * CAP + c2) * DM);
            unsigned w1[4], w2[4]; const float s1 = g1 * (1.0f / F8_SO), s2 = g2 * (1.0f / F8_SO);
#pragma unroll
            for (int j = 0; j < 4; ++j) { w1[j] = o1[C.lane + 64 * j]; w2[j] = o2[C.lane + 64 * j]; }
#pragma unroll
            for (int j = 0; j < 4; ++j) v[j] += unpk4_fp8(w1[j]) * s1 + unpk4_fp8(w2[j]) * s2;
#else
            const u32x2* o1 = (const u32x2*)(OUTB + ((size_t)(e1 * NB + b) * CAP + c1) * DM); const u32x2* o2 = (const u32x2*)(OUTB + ((size_t)(e2 * NB + b) * CAP + c2) * DM);
            u32x2 w1[4], w2[4];
#pragma unroll
            for (int j = 0; j < 4; ++j) { w1[j] = o1[C.lane + 64 * j]; w2[j] = o2[C.lane + 64 * j]; }
#pragma unroll
            for (int j = 0; j < 4; ++j) { v[j][0] += g1 * bf_lo(w1[j].x) + g2 * bf_lo(w2[j].x); v[j][1] += g1 * bf_hi(w1[j].x) + g2 * bf_hi(w2[j].x);
                v[j][2] += g1 * bf_lo(w1[j].y) + g2 * bf_lo(w2[j].y); v[j][3] += g1 * bf_hi(w1[j].y) + g2 * bf_hi(w2[j].y); }
#endif
        }
        float s = 0.f;
#pragma unroll
        for (int j = 0; j < 4; ++j) s += (v[j][0] + v[j][1]) + (v[j][2] + v[j][3]);
        const float mean = wave_sum(s) * (1.f / DM); float s2 = 0.f;
#pragma unroll
        for (int j = 0; j < 4; ++j) { v[j] = v[j] - mean; s2 += (v[j][0] * v[j][0] + v[j][1] * v[j][1]) + (v[j][2] * v[j][2] + v[j][3] * v[j][3]); }
        const float rstd = 1.f / sqrtf(wave_sum(s2) * (1.f / DM) + LN_EPS);
#pragma unroll
        for (int j = 0; j < 4; ++j) { v[j] = v[j] * rstd * gv[j] + bv[j];
            if (LAST) *(f32x4*)(C.out + (size_t)row * DM + 4 * C.lane + 256 * j) = v[j];
            else { u32x2 o; o.x = cvt_pk_bf16(v[j][0], v[j][1]); o.y = cvt_pk_bf16(v[j][2], v[j][3]); xb[C.lane + 64 * j] = o;
                if (INP_FP8 && layer == 0) ((unsigned*)(C.ws + WS_XB8 + (size_t)row * DM))[C.lane + 64 * j] = pk4_fp8(v[j][0], v[j][1], v[j][2], v[j][3]); } }
    }
}

template <int ACT>
__device__ __forceinline__ void headnorm_gate(Ctx& C, const bf16_t* Zo, int ldz, const bf16_t* H1, const bf16_t* H2, const float* ng, bf16_t* U, int r0, int rs, int nr) {
    static_assert(!OUT_FP8, "bf16 U only");
    const int lane = C.lane; const bool up = lane >= 32;
    f32x4 gv[2][2];
#pragma unroll
    for (int jj = 0; jj < 2; ++jj) { gv[jj][0] = *(const f32x4*)(ng + 512 * jj + 8 * lane); gv[jj][1] = *(const f32x4*)(ng + 512 * jj + 8 * lane + 4); }
    auto half_sum = [&](float v) { v += dpp_f<0xB1>(v); v += dpp_f<0x4E>(v); v += dpp_f<0x141>(v); v += dpp_f<0x140>(v);
        const float lo = rdlane_f(v, 0) + rdlane_f(v, 16), hi = rdlane_f(v, 32) + rdlane_f(v, 48); return up ? hi : lo; };
    u32x4 na[2], nb[2], no[2], ma[2], mb[2], mo[2];
    { const int row = r0, r2 = r0 + rs;
#pragma unroll
      for (int jj = 0; jj < 2; ++jj) { na[jj] = ((const u32x4*)(H1 + (size_t)row * DM))[lane + 64 * jj]; nb[jj] = ((const u32x4*)(H2 + (size_t)row * DM))[lane + 64 * jj]; no[jj] = ((const u32x4*)(Zo + (size_t)row * ldz))[lane + 64 * jj];
          ma[jj] = ((const u32x4*)(H1 + (size_t)r2 * DM))[lane + 64 * jj]; mb[jj] = ((const u32x4*)(H2 + (size_t)r2 * DM))[lane + 64 * jj]; mo[jj] = ((const u32x4*)(Zo + (size_t)r2 * ldz))[lane + 64 * jj]; } }
    for (int k = 0; k < nr; ++k) { const int row = r0 + k * rs;
        u32x4 a4[2], b4[2], o4[2];
#pragma unroll
        for (int jj = 0; jj < 2; ++jj) { a4[jj] = na[jj]; b4[jj] = nb[jj]; o4[jj] = no[jj]; na[jj] = ma[jj]; nb[jj] = mb[jj]; no[jj] = mo[jj]; }
        { const int r2 = r0 + (k + 2 < nr ? k + 2 : nr - 1) * rs;
#pragma unroll
            for (int jj = 0; jj < 2; ++jj) { ma[jj] = ((const u32x4*)(H1 + (size_t)r2 * DM))[lane + 64 * jj]; mb[jj] = ((const u32x4*)(H2 + (size_t)r2 * DM))[lane + 64 * jj]; mo[jj] = ((const u32x4*)(Zo + (size_t)r2 * ldz))[lane + 64 * jj]; } }
        u32x4* upp = (u32x4*)(U + (size_t)row * DM);
#pragma unroll
        for (int jj = 0; jj < 2; ++jj) {
            const u32x4 a = a4[jj], b = b4[jj], o = o4[jj];
            float v[8], ov[8];
#pragma unroll
            for (int q = 0; q < 4; ++q) { v[2 * q] = bf_lo(a[q]) + bf_lo(b[q]); v[2 * q + 1] = bf_hi(a[q]) + bf_hi(b[q]); ov[2 * q] = bf_lo(o[q]); ov[2 * q + 1] = bf_hi(o[q]); }
            const float mean = half_sum(((v[0] + v[1]) + (v[2] + v[3])) + ((v[4] + v[5]) + (v[6] + v[7]))) * (1.f / 256.f);
            float s2 = 0.f;
#pragma unroll
            for (int q = 0; q < 8; ++q) { v[q] -= mean; s2 += v[q] * v[q]; }
            const float rstd = 1.f / sqrtf(half_sum(s2) * (1.f / 256.f) + LN_EPS);
            float r[8];
#pragma unroll
            for (int q = 0; q < 8; ++q) { const float hn = v[q] * rstd * gv[jj][q >> 2][q & 3]; r[q] = (ACT == 0 ? sigmoidf_(ov[q]) : siluf_(ov[q])) * hn; }
            u32x4 w; w.x = cvt_pk_bf16(r[0], r[1]); w.y = cvt_pk_bf16(r[2], r[3]); w.z = cvt_pk_bf16(r[4], r[5]); w.w = cvt_pk_bf16(r[6], r[7]);
            upp[lane + 64 * jj] = w;
        }
    }
}
#define KSWZ(row, colB) ((row) * 256 + ((colB) ^ (((row) & 7) << 4)))
#define SSWZ(row, colB) ((row) * 128 + ((colB) ^ ((((row) >> 1) & 7) << 4)))
__device__ __forceinline__ int crow(int r, int hi) { return (r & 3) + 8 * (r >> 2) + 4 * hi; }
__device__ __forceinline__ int v_st(int k, int c) { const int kk = (k & ~0xC) | ((k & 4) << 1) | ((k & 8) >> 1); return ((kk >> 3) * 4 + (c >> 5)) * 512 + ((kk & 7) * 32 + (c & 31)) * 2; }
__device__ __forceinline__ int v_rd_base(int lane) { return ((lane & 3) << 3) | (((lane >> 2) & 3) << 6) | (((lane >> 4) & 1) << 5) | (((lane >> 5) & 1) << 8); }
constexpr int v_rd_off(int d0, int ks, int half) { return d0 * 512 + ks * 4096 + half * 2048; }
template <int OFF> __device__ __forceinline__ s16x4 tr_read(int vb) {
    s16x4 r; asm volatile("ds_read_b64_tr_b16 %0, %1 offset:%2" : "=&v"(r) : "v"(vb), "i"(OFF) : "memory"); return r;
}
#define PKLH(L, H) (bf16x8){L[0], L[1], L[2], L[3], H[0], H[1], H[2], H[3]}
template <int D0, int KS> __device__ __forceinline__ bf16x8 tr_frag(int vb) {
    const s16x4 l = tr_read<v_rd_off(D0, KS, 0)>(vb), h = tr_read<v_rd_off(D0, KS, 1)>(vb); LDS_WAIT(); __builtin_amdgcn_sched_barrier(0); return PKLH(l, h);
}
template <int D0> __device__ __forceinline__ void tr_frag4(int vb, bf16x8& f0, bf16x8& f1, bf16x8& f2, bf16x8& f3) {
    const s16x4 l0 = tr_read<v_rd_off(D0, 0, 0)>(vb), h0 = tr_read<v_rd_off(D0, 0, 1)>(vb), l1 = tr_read<v_rd_off(D0, 1, 0)>(vb), h1 = tr_read<v_rd_off(D0, 1, 1)>(vb);
    const s16x4 l2 = tr_read<v_rd_off(D0, 2, 0)>(vb), h2 = tr_read<v_rd_off(D0, 2, 1)>(vb), l3 = tr_read<v_rd_off(D0, 3, 0)>(vb), h3 = tr_read<v_rd_off(D0, 3, 1)>(vb);
    LDS_WAIT(); __builtin_amdgcn_sched_barrier(0); f0 = PKLH(l0, h0); f1 = PKLH(l1, h1); f2 = PKLH(l2, h2); f3 = PKLH(l3, h3);
}
template <int D0> __device__ __forceinline__ void tr_frag2(int vb, bf16x8& f0, bf16x8& f1) {
    const s16x4 l0 = tr_read<v_rd_off(D0, 0, 0)>(vb), h0 = tr_read<v_rd_off(D0, 0, 1)>(vb), l1 = tr_read<v_rd_off(D0, 1, 0)>(vb), h1 = tr_read<v_rd_off(D0, 1, 1)>(vb);
    LDS_WAIT(); __builtin_amdgcn_sched_barrier(0); f0 = PKLH(l0, h0); f1 = PKLH(l1, h1);
}
__device__ __forceinline__ bf16x8 as_bf16x8(u32x4 w) { return __builtin_bit_cast(bf16x8, w); }
__device__ __forceinline__ int lds_addr(LAS unsigned char* p) { return (int)(uintptr_t)p; }

__device__ __forceinline__ void mlstm_chain(Ctx& C) {
    const bf16_t* Z = (const bf16_t*)(C.ws + WS_Z); const float* gates = (const float*)(C.ws + WS_SMALL + SM_GATES);
    LAS unsigned char* L = C.lds;
    constexpr int QS = 0, KS_ = 16384, KT = 32768, VT = 49152, SS = 81920, FA = 90112, GA = 98304;
    LAS float* RD = (LAS float*)(L + FA); LAS float* QN = RD + 64; LAS float* NV = RD + 128; LAS float* NP = RD + 256;
    LAS float* BC = (LAS float*)(L + GA); LAS float* AV = BC + 2048; LAS float* CM = BC + 4096;
    const int tid0 = C.tid, w = C.wave;
    for (int chain = blockIdx.x; chain < 256; chain += C.G) {
        const int dir = chain >> 7, b = (chain >> 2) & 31, h = chain & 3;
        bf16_t* Hout = (bf16_t*)(C.ws + WS_H) + (size_t)dir * NT * DM;
        int tid = tid0, lane = tid & 63, r32 = lane & 31, hi = lane >> 5;
#define REOPAQUE() do { tid = opaque(tid0); lane = tid & 63; r32 = lane & 31; hi = lane >> 5; } while (0)
        f32x16 Cst[4];
#pragma unroll
        for (int j = 0; j < 4; ++j) Cst[j] = (f32x16){};
        if (tid < 128) NV[tid] = 0.f;
        auto tok_of = [&](int c, int j) { const int cidx = dir ? 31 - c : c; return b * SEQ + cidx * 64 + (dir ? 63 - j : j); };
#pragma unroll 1
        for (int cc = w; cc < 32; cc += 8) {
            const size_t t = (size_t)tok_of(cc, lane) * 16; const float ig = gates[t + dir * 8 + h], fg = gates[t + dir * 8 + 4 + h];
            float bc = logsigmoidf_(fg);
#pragma unroll
            for (int o = 1; o < 64; o <<= 1) { const float x = __shfl_up(bc, o); if (lane >= o) bc += x; }
            const float a = ig - bc; float cm = a;
#pragma unroll
            for (int o = 1; o < 64; o <<= 1) { const float x = __shfl_up(cm, o); if (lane >= o) cm = fmaxf(cm, x); }
            BC[cc * 64 + lane] = bc; AV[cc * 64 + lane] = a; CM[cc * 64 + lane] = cm;
        }
        float mcar = 0.f;
        u32x4 pq[2], pk[2], pv[4];
        auto prefetch = [&](int c) {
#pragma unroll
            for (int i = 0; i < 2; ++i) { const int cid = tid + 512 * i, row = cid >> 4, cc = cid & 15; const size_t t = (size_t)tok_of(c, row) * 3072;
                pq[i] = *(const u32x4*)(Z + t + h * 128 + cc * 8); pk[i] = *(const u32x4*)(Z + t + 512 + h * 128 + cc * 8); }
#pragma unroll
            for (int i = 0; i < 4; ++i) { const int cid = tid + 512 * i, row = cid >> 5, cc = cid & 31; pv[i] = *(const u32x4*)(Z + (size_t)tok_of(c, row) * 3072 + 1024 + h * 256 + cc * 8); }
        };
        prefetch(0);
        __syncthreads();
        for (int c = 0; c < 32; ++c) {
            REOPAQUE();
            const float M63 = fmaxf(mcar, CM[c * 64 + 63]), wc = __expf(mcar - M63);
#pragma unroll
            for (int i = 0; i < 2; ++i) { const int cid = tid + 512 * i, row = cid >> 4, cc = cid & 15;
                *(LAS u32x4*)(L + QS + KSWZ(row, cc * 16)) = pq[i]; *(LAS u32x4*)(L + KS_ + KSWZ(row, cc * 16)) = pk[i];
                const float ws = __expf(AV[c * 64 + row] - M63); u32x4 kw;
                kw.x = cvt_pk_bf16(bf_lo(pk[i].x) * ws, bf_hi(pk[i].x) * ws); kw.y = cvt_pk_bf16(bf_lo(pk[i].y) * ws, bf_hi(pk[i].y) * ws);
                kw.z = cvt_pk_bf16(bf_lo(pk[i].z) * ws, bf_hi(pk[i].z) * ws); kw.w = cvt_pk_bf16(bf_lo(pk[i].w) * ws, bf_hi(pk[i].w) * ws);
                *(LAS u32x4*)(L + KT + v_st(row, cc * 8)) = kw; }
#pragma unroll
            for (int i = 0; i < 4; ++i) { const int cid = tid + 512 * i, row = cid >> 5, cc = cid & 31; *(LAS u32x4*)(L + VT + (cc >> 4) * 16384 + v_st(row, (cc & 15) * 8)) = pv[i]; }
            if (c + 1 < 32) prefetch(c + 1);
            __syncthreads();
            REOPAQUE();
            if (w < 4) {
                const int ti = w >> 1, si = w & 1;
                if (si > ti) {
#pragma unroll
                    for (int i = 0; i < 4; ++i) *(LAS u32x2*)(L + SS + SSWZ(32 * ti + r32, (32 * si + 8 * i + 4 * hi) * 2)) = (u32x2){0u, 0u};
                } else {
                    f32x16 acc = (f32x16){};
#pragma unroll
                    for (int kk = 0; kk < 8; ++kk) { const int cb = (16 * kk + 8 * hi) * 2;
                        const bf16x8 kf = *(const LAS bf16x8*)(L + KS_ + KSWZ(32 * si + r32, cb)); const bf16x8 qf = *(const LAS bf16x8*)(L + QS + KSWZ(32 * ti + r32, cb));
                        acc = __builtin_amdgcn_mfma_f32_32x32x16_bf16(kf, qf, acc, 0, 0, 0); }
                    const int t = 32 * ti + r32; const float Mt = fmaxf(mcar, CM[c * 64 + t]);
#pragma unroll
                    for (int i = 0; i < 4; ++i) { const int s0 = 32 * si + 8 * i + 4 * hi; const f32x4 a4 = *(const LAS f32x4*)(AV + c * 64 + s0);
                        float v[4];
#pragma unroll
                        for (int q = 0; q < 4; ++q) v[q] = (s0 + q <= t) ? acc[4 * i + q] * __expf(a4[q] - Mt) : 0.f;
                        u32x2 o; o.x = cvt_pk_bf16(v[0], v[1]); o.y = cvt_pk_bf16(v[2], v[3]);
                        *(LAS u32x2*)(L + SS + SSWZ(t, s0 * 2)) = o; }
                }
            } else {
                const int t = (tid - 256) >> 2, seg = tid & 3; float a = 0.f;
#pragma unroll
                for (int i = 0; i < 4; ++i) { const u32x4 qv = *(const LAS u32x4*)(L + QS + KSWZ(t, (seg * 32 + i * 8) * 2)); const LAS float* nv = NV + seg * 32 + i * 8;
                    a += bf_lo(qv.x) * nv[0] + bf_hi(qv.x) * nv[1] + bf_lo(qv.y) * nv[2] + bf_hi(qv.y) * nv[3] + bf_lo(qv.z) * nv[4] + bf_hi(qv.z) * nv[5] + bf_lo(qv.w) * nv[6] + bf_hi(qv.w) * nv[7]; }
                a += __shfl_xor(a, 1); a += __shfl_xor(a, 2);
                if (seg == 0) QN[t] = a;
            }
            __syncthreads();
            REOPAQUE();
            { const int t = tid >> 3, seg = tid & 7; const u32x4 sv = *(const LAS u32x4*)(L + SS + SSWZ(t, seg * 16));
              float rs = (bf_lo(sv.x) + bf_hi(sv.x)) + (bf_lo(sv.y) + bf_hi(sv.y)) + (bf_lo(sv.z) + bf_hi(sv.z)) + (bf_lo(sv.w) + bf_hi(sv.w));
              rs += __shfl_xor(rs, 1); rs += __shfl_xor(rs, 2); rs += __shfl_xor(rs, 4);
              if (seg == 0) { const float Mt = fmaxf(mcar, CM[c * 64 + t]); const float den = rs + __expf(mcar - Mt) * QN[t]; RD[t] = 1.0f / fmaxf(fabsf(den), __expf(-(BC[c * 64 + t] + Mt))); } }
            { const int dk = tid & 127, part = tid >> 7; float a = 0.f;
              const LAS unsigned char* kp = L + KT + part * 4096 + (dk >> 5) * 512 + (dk & 31) * 2;
#pragma unroll
              for (int i = 0; i < 16; ++i) a += bf2f(*(const LAS bf16_t*)(kp + (i >> 3) * 2048 + (i & 7) * 64));
              NP[part * 128 + dk] = a; }
            __builtin_amdgcn_sched_barrier(0);
            const int vbV = lds_addr(L + VT) + v_rd_base(lane) + (w & 3) * 512 + (w >> 2) * 16384;
            const int vbK = lds_addr(L + KT) + v_rd_base(lane);
            f32x16 Y[2] = {(f32x16){}, (f32x16){}};
#pragma unroll
            for (int jd = 0; jd < 4; ++jd)
#pragma unroll
                for (int s = 0; s < 2; ++s) {
                    u32x4 cw; cw.x = cvt_pk_bf16(Cst[jd][8 * s + 0], Cst[jd][8 * s + 1]); cw.y = cvt_pk_bf16(Cst[jd][8 * s + 2], Cst[jd][8 * s + 3]);
                    cw.z = cvt_pk_bf16(Cst[jd][8 * s + 4], Cst[jd][8 * s + 5]); cw.w = cvt_pk_bf16(Cst[jd][8 * s + 6], Cst[jd][8 * s + 7]);
                    const bf16x8 bfr = as_bf16x8(cw); const int cb = (32 * jd + 16 * s + 4 * hi) * 2;
#pragma unroll
                    for (int ti = 0; ti < 2; ++ti) { const u32x2 lo = *(const LAS u32x2*)(L + QS + KSWZ(32 * ti + r32, cb)), hi2 = *(const LAS u32x2*)(L + QS + KSWZ(32 * ti + r32, cb + 16));
                        const bf16x8 afr = as_bf16x8((u32x4){lo.x, lo.y, hi2.x, hi2.y});
                        Y[ti] = __builtin_amdgcn_mfma_f32_32x32x16_bf16(afr, bfr, Y[ti], 0, 0, 0); }
                    __builtin_amdgcn_sched_barrier(0);
                }
#pragma unroll
            for (int ti = 0; ti < 2; ++ti)
#pragma unroll
                for (int i = 0; i < 4; ++i) { const f32x4 c4 = *(const LAS f32x4*)(CM + c * 64 + 32 * ti + 8 * i + 4 * hi);
#pragma unroll
                    for (int q = 0; q < 4; ++q) Y[ti][4 * i + q] *= __expf(mcar - fmaxf(mcar, c4[q])); }
            __builtin_amdgcn_sched_barrier(0);
            bf16x8 vf0, vf1, vf2, vf3; tr_frag4<0>(vbV, vf0, vf1, vf2, vf3);
#pragma unroll
            for (int ti = 0; ti < 2; ++ti) {
                const bf16x8 a0 = *(const LAS bf16x8*)(L + SS + SSWZ(32 * ti + r32, (0 + 8 * hi) * 2)), a1 = *(const LAS bf16x8*)(L + SS + SSWZ(32 * ti + r32, (16 + 8 * hi) * 2));
                Y[ti] = __builtin_amdgcn_mfma_f32_32x32x16_bf16(a0, vf0, Y[ti], 0, 0, 0); Y[ti] = __builtin_amdgcn_mfma_f32_32x32x16_bf16(a1, vf1, Y[ti], 0, 0, 0);
                if (ti == 1) { const bf16x8 a2 = *(const LAS bf16x8*)(L + SS + SSWZ(32 + r32, (32 + 8 * hi) * 2)), a3 = *(const LAS bf16x8*)(L + SS + SSWZ(32 + r32, (48 + 8 * hi) * 2));
                    Y[1] = __builtin_amdgcn_mfma_f32_32x32x16_bf16(a2, vf2, Y[1], 0, 0, 0); Y[1] = __builtin_amdgcn_mfma_f32_32x32x16_bf16(a3, vf3, Y[1], 0, 0, 0); }
            }
            __builtin_amdgcn_sched_barrier(0);
#define ML_UPD(JD) { Cst[JD] = Cst[JD] * wc; bf16x8 k0_, k1_, k2_, k3_; tr_frag4<JD>(vbK, k0_, k1_, k2_, k3_); \
                Cst[JD] = __builtin_amdgcn_mfma_f32_32x32x16_bf16(k0_, vf0, Cst[JD], 0, 0, 0); Cst[JD] = __builtin_amdgcn_mfma_f32_32x32x16_bf16(k1_, vf1, Cst[JD], 0, 0, 0); \
                Cst[JD] = __builtin_amdgcn_mfma_f32_32x32x16_bf16(k2_, vf2, Cst[JD], 0, 0, 0); Cst[JD] = __builtin_amdgcn_mfma_f32_32x32x16_bf16(k3_, vf3, Cst[JD], 0, 0, 0); }
            ML_UPD(0) __builtin_amdgcn_sched_barrier(0); ML_UPD(1) __builtin_amdgcn_sched_barrier(0); ML_UPD(2) __builtin_amdgcn_sched_barrier(0); ML_UPD(3)
#undef ML_UPD
            __syncthreads();
            REOPAQUE();
            if (tid < 128) NV[tid] = wc * NV[tid] + (NP[tid] + NP[128 + tid]) + (NP[256 + tid] + NP[384 + tid]);
#pragma unroll
            for (int ti = 0; ti < 2; ++ti)
#pragma unroll
                for (int i = 0; i < 4; ++i) { const f32x4 r4 = *(const LAS f32x4*)(RD + 32 * ti + 8 * i + 4 * hi);
#pragma unroll
                    for (int q = 0; q < 4; ++q) { const int t = 32 * ti + 8 * i + 4 * hi + q;
                        Hout[(size_t)tok_of(c, t) * DM + h * 256 + 32 * w + r32] = f2bf(Y[ti][4 * i + q] * r4[q]); } }
            mcar = BC[c * 64 + 63] + M63;
        }
#undef REOPAQUE
        __syncthreads();
    }
}

__device__ __forceinline__ void gla_chain(Ctx& C) {
    const bf16_t* Z = (const bf16_t*)(C.ws + WS_Z); const float* glr = (const float*)(C.ws + WS_SMALL + SM_GATES);
    LAS unsigned char* L = C.lds;
    constexpr int QE = 0, KE = 8192, KG = 16384, VT = 32768, BL = 65536, FA = 81920;
    LAS float* BLf = (LAS float*)(L + BL);
    LAS float* GT = (LAS float*)(L + FA); LAS float* EG = GT + 128;
    const int tid0 = C.tid, w = C.wave;
    for (int chain = blockIdx.x; chain < 256; chain += C.G) {
        const int dir = chain >> 7, b = (chain >> 2) & 31, h = chain & 3;
        bf16_t* Hout = (bf16_t*)(C.ws + WS_H) + (size_t)dir * NT * DM;
        int tid = tid0, lane = tid & 63, r32 = lane & 31, hi = lane >> 5;
#define REOPAQUE() do { tid = opaque(tid0); lane = tid & 63; r32 = lane & 31; hi = lane >> 5; } while (0)
        bf16x8 gwf; float gbias;
        { const int dkc = h * 128 + (w & 3) * 32 + r32; const float* gwp = IN_F(I_GL_GW) + (size_t)dir * 16 * 512 + dkc; float g8[8];
#pragma unroll
          for (int j = 0; j < 8; ++j) g8[j] = gwp[(size_t)(8 * hi + j) * 512];
          u32x4 gp; gp.x = cvt_pk_bf16(g8[0], g8[1]); gp.y = cvt_pk_bf16(g8[2], g8[3]); gp.z = cvt_pk_bf16(g8[4], g8[5]); gp.w = cvt_pk_bf16(g8[6], g8[7]); gwf = as_bf16x8(gp);
          gbias = IN_F(I_GL_GB)[dir * 512 + dkc]; }
        f32x16 St[4];
#pragma unroll
        for (int j = 0; j < 4; ++j) St[j] = (f32x16){};
        struct PF { u32x4 pq, pk, pv0, pv1; f32x4 pg0, pg1; };
        PF S0, S1; S0.pg0 = S0.pg1 = S1.pg0 = S1.pg1 = (f32x4){0.f, 0.f, 0.f, 0.f};
        auto tok_of = [&](int c, int j) { const int cidx = dir ? 63 - c : c; return b * SEQ + cidx * 32 + (dir ? 31 - j : j); };
        auto prefetch = [&](int c, PF& P) {
            { const int row = tid >> 4, cc = tid & 15; const size_t t = (size_t)tok_of(c, row) * 3072; P.pq = *(const u32x4*)(Z + t + h * 128 + cc * 8); P.pk = *(const u32x4*)(Z + t + 512 + h * 128 + cc * 8); }
            { const int row = tid >> 5, cc = tid & 31; P.pv0 = *(const u32x4*)(Z + (size_t)tok_of(c, row) * 3072 + 1024 + h * 256 + cc * 8); P.pv1 = *(const u32x4*)(Z + (size_t)tok_of(c, 16 + row) * 3072 + 1024 + h * 256 + cc * 8); }
            if (w < 4) { const float* gp = glr + (size_t)tok_of(c, r32) * 32 + dir * 16 + 8 * hi; P.pg0 = *(const f32x4*)gp; P.pg1 = *(const f32x4*)(gp + 4); }
        };
        prefetch(0, S0); prefetch(1, S1);
        auto chunk = [&](const int c, PF& P) {
            REOPAQUE();
            if (w < 4) {
                u32x4 ap; ap.x = cvt_pk_bf16(P.pg0[0], P.pg0[1]); ap.y = cvt_pk_bf16(P.pg0[2], P.pg0[3]); ap.z = cvt_pk_bf16(P.pg1[0], P.pg1[1]); ap.w = cvt_pk_bf16(P.pg1[2], P.pg1[3]);
                f32x16 lg = __builtin_amdgcn_mfma_f32_32x32x16_bf16(as_bf16x8(ap), gwf, (f32x16){}, 0, 0, 0);
                float T[4];
#pragma unroll
                for (int i = 0; i < 4; ++i) { float run = 0.f;
#pragma unroll
                    for (int q = 0; q < 4; ++q) { run += logsigmoid_fast(lg[4 * i + q] + gbias) * (1.0f / 16.0f); lg[4 * i + q] = run; }
                    T[i] = run; }
                float O[4];
#pragma unroll
                for (int i = 0; i < 4; ++i) { auto rr = __builtin_amdgcn_permlane32_swap(__float_as_uint(T[i]), __float_as_uint(T[i]), false, false); O[i] = __uint_as_float(hi ? rr[0] : rr[1]); }
                float off = hi ? O[0] : 0.f;
#pragma unroll
                for (int i = 0; i < 4; ++i) {
#pragma unroll
                    for (int q = 0; q < 4; ++q) BLf[(8 * i + 4 * hi + q) * 128 + 32 * w + r32] = off + lg[4 * i + q];
                    off += T[i] + (hi ? (i < 3 ? O[i + 1] : 0.f) : O[i]); }
                if (hi == 0) { const float g = (T[0] + T[1]) + (T[2] + T[3]) + (O[0] + O[1]) + (O[2] + O[3]); GT[32 * w + r32] = g; EG[(c & 1) * 128 + 32 * w + r32] = __expf(g); }
            }
            __syncthreads();
            REOPAQUE();
            { const int row = tid >> 5, cc = tid & 31; *(LAS u32x4*)(L + VT + (cc >> 4) * 16384 + v_st(row, (cc & 15) * 8)) = P.pv0; *(LAS u32x4*)(L + VT + (cc >> 4) * 16384 + v_st(16 + row, (cc & 15) * 8)) = P.pv1; }
            { const int row = tid >> 4, cc = tid & 15; const LAS float* br = BLf + row * 128 + cc * 8; const LAS float* gp = GT + cc * 8;
              const f32x4 b0 = *(const LAS f32x4*)br, b1 = *(const LAS f32x4*)(br + 4), g0 = *(const LAS f32x4*)gp, g1 = *(const LAS f32x4*)(gp + 4);
              float bv[8] = {b0[0], b0[1], b0[2], b0[3], b1[0], b1[1], b1[2], b1[3]}, gv[8] = {g0[0], g0[1], g0[2], g0[3], g1[0], g1[1], g1[2], g1[3]};
              const u32x4 pq = P.pq, pk = P.pk;
              float qf[8] = {bf_lo(pq.x), bf_hi(pq.x), bf_lo(pq.y), bf_hi(pq.y), bf_lo(pq.z), bf_hi(pq.z), bf_lo(pq.w), bf_hi(pq.w)};
              float kf[8] = {bf_lo(pk.x), bf_hi(pk.x), bf_lo(pk.y), bf_hi(pk.y), bf_lo(pk.z), bf_hi(pk.z), bf_lo(pk.w), bf_hi(pk.w)};
              float qe[8], ke[8], kg[8];
#pragma unroll
              for (int j = 0; j < 8; ++j) { const float eb = __expf(bv[j]), ib = __builtin_amdgcn_rcpf(eb); qe[j] = qf[j] * eb; ke[j] = kf[j] * ib; kg[j] = ke[j] * __expf(gv[j]); }
              u32x4 o;
              o.x = cvt_pk_bf16(qe[0], qe[1]); o.y = cvt_pk_bf16(qe[2], qe[3]); o.z = cvt_pk_bf16(qe[4], qe[5]); o.w = cvt_pk_bf16(qe[6], qe[7]); *(LAS u32x4*)(L + QE + KSWZ(row, cc * 16)) = o;
              o.x = cvt_pk_bf16(ke[0], ke[1]); o.y = cvt_pk_bf16(ke[2], ke[3]); o.z = cvt_pk_bf16(ke[4], ke[5]); o.w = cvt_pk_bf16(ke[6], ke[7]); *(LAS u32x4*)(L + KE + KSWZ(row, cc * 16)) = o;
              o.x = cvt_pk_bf16(kg[0], kg[1]); o.y = cvt_pk_bf16(kg[2], kg[3]); o.z = cvt_pk_bf16(kg[4], kg[5]); o.w = cvt_pk_bf16(kg[6], kg[7]); *(LAS u32x4*)(L + KG + v_st(row, cc * 8)) = o; }
            if (c + 2 < 64) prefetch(c + 2, P);
            __syncthreads();
            REOPAQUE();
            const int vbV = lds_addr(L + VT) + v_rd_base(lane) + (w & 3) * 512 + (w >> 2) * 16384;
            const int vbK = lds_addr(L + KG) + v_rd_base(lane);
            f32x16 acc = (f32x16){};
#pragma unroll
            for (int kk = 0; kk < 8; ++kk) { const int cb = (16 * kk + 8 * hi) * 2;
                const bf16x8 kf = *(const LAS bf16x8*)(L + KE + KSWZ(r32, cb)); const bf16x8 qf = *(const LAS bf16x8*)(L + QE + KSWZ(r32, cb));
                acc = __builtin_amdgcn_mfma_f32_32x32x16_bf16(kf, qf, acc, 0, 0, 0); }
#pragma unroll
            for (int r = 0; r < 16; ++r) acc[r] = (crow(r, hi) <= r32) ? acc[r] : 0.f;
            bf16x8 pa0, pa1;
#define PK4(P, BASE, OUT) do { unsigned a0 = cvt_pk_bf16(P[BASE + 0], P[BASE + 1]), a1 = cvt_pk_bf16(P[BASE + 2], P[BASE + 3]);   \
    unsigned b0 = cvt_pk_bf16(P[BASE + 4], P[BASE + 5]), b1 = cvt_pk_bf16(P[BASE + 6], P[BASE + 7]);                              \
    auto r0 = __builtin_amdgcn_permlane32_swap(a0, b0, false, false); auto r1 = __builtin_amdgcn_permlane32_swap(a1, b1, false, false); \
    u32x4 wv = {r0[0], r1[0], r0[1], r1[1]}; OUT = as_bf16x8(wv); } while (0)
            PK4(acc, 0, pa0); PK4(acc, 8, pa1);
#undef PK4
            f32x16 Y = (f32x16){};
#pragma unroll
            for (int jd = 0; jd < 4; ++jd)
#pragma unroll
                for (int s = 0; s < 2; ++s) {
                    u32x4 cw; cw.x = cvt_pk_bf16(St[jd][8 * s + 0], St[jd][8 * s + 1]); cw.y = cvt_pk_bf16(St[jd][8 * s + 2], St[jd][8 * s + 3]);
                    cw.z = cvt_pk_bf16(St[jd][8 * s + 4], St[jd][8 * s + 5]); cw.w = cvt_pk_bf16(St[jd][8 * s + 6], St[jd][8 * s + 7]);
                    const int cb = (32 * jd + 16 * s + 4 * hi) * 2;
                    const u32x2 lo = *(const LAS u32x2*)(L + QE + KSWZ(r32, cb)), hi2 = *(const LAS u32x2*)(L + QE + KSWZ(r32, cb + 16));
                    Y = __builtin_amdgcn_mfma_f32_32x32x16_bf16(as_bf16x8((u32x4){lo.x, lo.y, hi2.x, hi2.y}), as_bf16x8(cw), Y, 0, 0, 0);
                }
            bf16x8 vf0, vf1; tr_frag2<0>(vbV, vf0, vf1);
            Y = __builtin_amdgcn_mfma_f32_32x32x16_bf16(pa0, vf0, Y, 0, 0, 0); Y = __builtin_amdgcn_mfma_f32_32x32x16_bf16(pa1, vf1, Y, 0, 0, 0);
#define GL_UPD(JD) { _Pragma("unroll") for (int i = 0; i < 4; ++i) { const f32x4 e4 = *(const LAS f32x4*)(EG + (c & 1) * 128 + 32 * JD + 8 * i + 4 * hi); \
                    _Pragma("unroll") for (int q = 0; q < 4; ++q) St[JD][4 * i + q] *= e4[q]; } \
                bf16x8 k0_, k1_; tr_frag2<JD>(vbK, k0_, k1_); St[JD] = __builtin_amdgcn_mfma_f32_32x32x16_bf16(k0_, vf0, St[JD], 0, 0, 0); St[JD] = __builtin_amdgcn_mfma_f32_32x32x16_bf16(k1_, vf1, St[JD], 0, 0, 0); }
            GL_UPD(0) GL_UPD(1) GL_UPD(2) GL_UPD(3)
#undef GL_UPD
#pragma unroll
            for (int r = 0; r < 16; ++r) Hout[(size_t)tok_of(c, crow(r, hi)) * DM + h * 256 + 32 * w + r32] = f2bf(Y[r]);
        };
#pragma unroll 1
        for (int c = 0; c < 64; c += 2) { chunk(c, S0); chunk(c + 1, S1); }
#undef REOPAQUE
        __syncthreads();
    }
}
__device__ __forceinline__ void lru_conv(Ctx& C, const bf16_t* UR, bf16_t* UC) {
    const float* cw = IN_F(I_LR_CW); const float* cb = IN_F(I_LR_CB);
    const int c8 = (C.tid & 127) * 8;
    f32x4 w[4][2], bias[2];
#pragma unroll
    for (int k = 0; k < 4; ++k) { w[k][0] = *(const f32x4*)(cw + (size_t)k * DM + c8); w[k][1] = *(const f32x4*)(cw + (size_t)k * DM + c8 + 4); }
    bias[0] = *(const f32x4*)(cb + c8); bias[1] = *(const f32x4*)(cb + c8 + 4);
#pragma unroll 1
    for (int seg = blockIdx.x * 4 + (C.tid >> 7); seg < NT / 16; seg += C.G * 4) {
        const int t0 = seg * 16, s0 = t0 & 2047;
        u32x4 r[19];
#pragma unroll
        for (int q = 0; q < 19; ++q) { int tt = t0 - 2 + q; tt = tt < 0 ? 0 : (tt > NT - 1 ? NT - 1 : tt); r[q] = *(const u32x4*)(UR + (size_t)tt * DM + c8); }
        if (s0 == 0) { r[0] = (u32x4){0u, 0u, 0u, 0u}; r[1] = (u32x4){0u, 0u, 0u, 0u}; }
        if (s0 == SEQ - 16) r[18] = (u32x4){0u, 0u, 0u, 0u};
#pragma unroll
        for (int j = 0; j < 16; ++j) {
            f32x4 a0 = bias[0], a1 = bias[1];
#pragma unroll
            for (int k = 0; k < 4; ++k) { const u32x4 u = r[j + k];
                a0 += w[k][0] * (f32x4){bf_lo(u.x), bf_hi(u.x), bf_lo(u.y), bf_hi(u.y)}; a1 += w[k][1] * (f32x4){bf_lo(u.z), bf_hi(u.z), bf_lo(u.w), bf_hi(u.w)}; }
            u32x4 o; o.x = cvt_pk_bf16(a0[0], a0[1]); o.y = cvt_pk_bf16(a0[2], a0[3]); o.z = cvt_pk_bf16(a1[0], a1[1]); o.w = cvt_pk_bf16(a1[2], a1[3]);
            *(u32x4*)(UC + (size_t)(t0 + j) * DM + c8) = o;
        }
    }
}
__device__ __forceinline__ void lru_scan(Ctx& C, const bf16_t* LA0, const unsigned char* GT0, const bf16_t* LA1, const unsigned char* GT1, bf16_t* GBU, bf16_t* HF) {
    static_assert(!OUT_FP8, "this scan writes U as bf16 only");
    LAS float* PF = (LAS float*)C.lds; LAS float* EF = PF + 4096; LAS float* PB = PF + 8192; LAS float* EB = PF + 12288;
    const int lane = C.lane, cg = lane & 15, sg = C.wave * 4 + (lane >> 4);
#define LRU_UNPK(w, q, lo, hi) const float lo = bf_lo((w)[q]), hi = bf_hi((w)[q])
    for (int unit = blockIdx.x; unit < NB * 8; unit += C.G) {
        const int b = unit >> 3;
        const unsigned boff = (unsigned)((((size_t)b * SEQ + sg * 64) * DM + (unit & 7) * 128 + cg * 8) * 2);
        const int so = sg * 128 + cg * 8;
#define LRU_LD(P, t) (*(const u32x4*)((const char*)(P) + (size_t)(boff + (unsigned)((t) * (DM * 2)))))
#define LRU_ST(P, t, v) (*(u32x4*)((char*)(P) + (size_t)(boff + (unsigned)((t) * (DM * 2)))) = (v))
#define LRU_LD8(P, t) (*(const u32x2*)((const unsigned char*)(P) + (size_t)((boff >> 1) + (unsigned)((t) * DM))))
#define LRU_G8(w, gf) float gf[8]; { const f32x4 lo_ = unpk4_fp8((w).x), hi_ = unpk4_fp8((w).y); gf[0] = lo_[0]; gf[1] = lo_[1]; gf[2] = lo_[2]; gf[3] = lo_[3]; gf[4] = hi_[0]; gf[5] = hi_[1]; gf[6] = hi_[2]; gf[7] = hi_[3]; }
        auto pass1 = [&](const bf16_t* LA, const unsigned char* GT, int t0, int dt, LAS float* Pd, LAS float* Ed) {
            float p[8], e[8];
#pragma unroll
            for (int c = 0; c < 8; ++c) { p[c] = 0.f; e[c] = 0.f; }
            u32x4 lA[4], lB[4]; u32x2 gA[4], gB[4];
            auto ld = [&](int k, u32x4 (&l)[4], u32x2 (&g)[4]) {
#pragma unroll
                for (int j = 0; j < 4; ++j) { const int t = t0 + dt * (4 * k + j); l[j] = LRU_LD(LA, t); g[j] = LRU_LD8(GT, t); } };
            auto cp = [&](const u32x4 (&l)[4], const u32x2 (&g)[4]) {
#pragma unroll
                for (int j = 0; j < 4; ++j) { LRU_G8(g[j], gf);
#pragma unroll
                    for (int q = 0; q < 4; ++q) { LRU_UNPK(l[j], q, l0, l1);
                        e[2 * q] = __expf(l0) * e[2 * q] + gf[2 * q]; e[2 * q + 1] = __expf(l1) * e[2 * q + 1] + gf[2 * q + 1]; p[2 * q] += l0; p[2 * q + 1] += l1; } } };
            ld(0, lA, gA);
#pragma unroll 1
            for (int k = 0; k < 16; k += 2) {
                ld(k + 1, lB, gB); __builtin_amdgcn_sched_barrier(0); cp(lA, gA);
                ld(k + 2 < 16 ? k + 2 : 15, lA, gA); __builtin_amdgcn_sched_barrier(0); cp(lB, gB); }
            *(LAS f32x4*)(Pd + so) = (f32x4){p[0], p[1], p[2], p[3]}; *(LAS f32x4*)(Pd + so + 4) = (f32x4){p[4], p[5], p[6], p[7]};
            *(LAS f32x4*)(Ed + so) = (f32x4){e[0], e[1], e[2], e[3]}; *(LAS f32x4*)(Ed + so + 4) = (f32x4){e[4], e[5], e[6], e[7]}; };
        pass1(LA0, GT0, 0, 1, PF, EF);
        pass1(LA1, GT1, 63, -1, PB, EB);
        __syncthreads();
        float hf[8], hb[8];
#pragma unroll
        for (int c = 0; c < 8; ++c) { hf[c] = 0.f; hb[c] = 0.f; }
        for (int q = 0; q < sg; ++q) { const f32x4 pa = *(const LAS f32x4*)(PF + q * 128 + cg * 8), pb = *(const LAS f32x4*)(PF + q * 128 + cg * 8 + 4), ea = *(const LAS f32x4*)(EF + q * 128 + cg * 8), eb = *(const LAS f32x4*)(EF + q * 128 + cg * 8 + 4);
#pragma unroll
            for (int c = 0; c < 4; ++c) { hf[c] = __expf(pa[c]) * hf[c] + ea[c]; hf[4 + c] = __expf(pb[c]) * hf[4 + c] + eb[c]; } }
        for (int q = 31; q > sg; --q) { const f32x4 pa = *(const LAS f32x4*)(PB + q * 128 + cg * 8), pb = *(const LAS f32x4*)(PB + q * 128 + cg * 8 + 4), ea = *(const LAS f32x4*)(EB + q * 128 + cg * 8), eb = *(const LAS f32x4*)(EB + q * 128 + cg * 8 + 4);
#pragma unroll
            for (int c = 0; c < 4; ++c) { hb[c] = __expf(pa[c]) * hb[c] + ea[c]; hb[4 + c] = __expf(pb[c]) * hb[4 + c] + eb[c]; } }
        {
            u32x4 lA[4], lB[4]; u32x2 gA[4], gB[4];
            auto ld = [&](int k, u32x4 (&l)[4], u32x2 (&g)[4]) {
#pragma unroll
                for (int j = 0; j < 4; ++j) { l[j] = LRU_LD(LA0, 4 * k + j); g[j] = LRU_LD8(GT0, 4 * k + j); } };
            auto cp = [&](int k, const u32x4 (&l)[4], const u32x2 (&g)[4]) {
#pragma unroll
                for (int j = 0; j < 4; ++j) { u32x4 o; LRU_G8(g[j], gf);
#pragma unroll
                    for (int q = 0; q < 4; ++q) { LRU_UNPK(l[j], q, l0, l1);
                        hf[2 * q] = __expf(l0) * hf[2 * q] + gf[2 * q]; hf[2 * q + 1] = __expf(l1) * hf[2 * q + 1] + gf[2 * q + 1]; o[q] = cvt_pk_bf16(hf[2 * q], hf[2 * q + 1]); }
                    LRU_ST(HF, 4 * k + j, o); } };
            ld(0, lA, gA);
#pragma unroll 1
            for (int k = 0; k < 16; k += 2) {
                ld(k + 1, lB, gB); __builtin_amdgcn_sched_barrier(0); cp(k, lA, gA);
                ld(k + 2 < 16 ? k + 2 : 15, lA, gA); __builtin_amdgcn_sched_barrier(0); cp(k + 1, lB, gB); }
        }
        {
            u32x4 lA[2], fA[2], bA[2], lB[2], fB[2], bB[2]; u32x2 gA[2], gB[2];
            auto ld = [&](int k, u32x4 (&l)[2], u32x2 (&g)[2], u32x4 (&f)[2], u32x4 (&bb)[2]) {
#pragma unroll
                for (int j = 0; j < 2; ++j) { const int t = 63 - (2 * k + j); l[j] = LRU_LD(LA1, t); g[j] = LRU_LD8(GT1, t); f[j] = LRU_LD(HF, t); bb[j] = LRU_LD(GBU, t); } };
            auto cp = [&](int k, const u32x4 (&l)[2], const u32x2 (&g)[2], const u32x4 (&f)[2], const u32x4 (&bb)[2]) {
#pragma unroll
                for (int j = 0; j < 2; ++j) { u32x4 o; LRU_G8(g[j], gf);
#pragma unroll
                    for (int q = 0; q < 4; ++q) { LRU_UNPK(l[j], q, l0, l1); LRU_UNPK(f[j], q, f0, f1); LRU_UNPK(bb[j], q, x0, x1);
                        hb[2 * q] = __expf(l0) * hb[2 * q] + gf[2 * q]; hb[2 * q + 1] = __expf(l1) * hb[2 * q + 1] + gf[2 * q + 1];
                        o[q] = cvt_pk_bf16(gelu_tanh(x0) * ((hb[2 * q] + f0) * (1.0f / F8_SG)), gelu_tanh(x1) * ((hb[2 * q + 1] + f1) * (1.0f / F8_SG))); }
                    LRU_ST(GBU, 63 - (2 * k + j), o); } };
            ld(0, lA, gA, fA, bA);
#pragma unroll 1
            for (int k = 0; k < 32; k += 2) {
                ld(k + 1, lB, gB, fB, bB); __builtin_amdgcn_sched_barrier(0); cp(k, lA, gA, fA, bA);
                ld(k + 2 < 32 ? k + 2 : 31, lA, gA, fA, bA); __builtin_amdgcn_sched_barrier(0); cp(k + 1, lB, gB, fB, bB); }
        }
        __syncthreads();
    }
#undef LRU_LD
#undef LRU_LD8
#undef LRU_G8
#undef LRU_ST
#undef LRU_UNPK
}
__device__ __forceinline__ void mla_norm_rope(Ctx& C, const bf16_t* Zm, bf16_t* CQN, bf16_t* CKVN, bf16_t* Kc, int r0, int rs, int nr) {
    const float* qg = IN_F(I_MA_QG); const float* kvg = IN_F(I_MA_KVG);
    const float* cs = (const float*)(C.ws + WS_ROPE); const float* sn = cs + (size_t)NT * 32;
    const int lane = C.lane;
    const int i0r = 4 * (lane & 7);
    const f32x4 gq0 = *(const f32x4*)(qg + 4 * lane), g1 = lane < 32 ? *(const f32x4*)(qg + 256 + 4 * lane) : *(const f32x4*)(kvg + 4 * (lane - 32)), g2 = *(const f32x4*)(kvg + 128 + 4 * (lane & 31));
    u32x2 zc[3], zn[3]; f32x4 cc, sc, cn, sn2;
    { const u32x2* zr = (const u32x2*)(Zm + (size_t)r0 * 768);
#pragma unroll
      for (int j = 0; j < 3; ++j) zc[j] = zr[lane + 64 * j];
      cc = *(const f32x4*)(cs + (size_t)r0 * 32 + i0r); sc = *(const f32x4*)(sn + (size_t)r0 * 32 + i0r); }
    for (int k = 0; k < nr; ++k) { const int row = r0 + k * rs;
        { const int rn = r0 + (k + 1 < nr ? k + 1 : nr - 1) * rs; const u32x2* zr = (const u32x2*)(Zm + (size_t)rn * 768);
#pragma unroll
          for (int j = 0; j < 3; ++j) zn[j] = zr[lane + 64 * j];
          cn = *(const f32x4*)(cs + (size_t)rn * 32 + i0r); sn2 = *(const f32x4*)(sn + (size_t)rn * 32 + i0r); }
        f32x4 v[3];
#pragma unroll
        for (int j = 0; j < 3; ++j) { const u32x2 w = zc[j]; v[j] = (f32x4){bf_lo(w.x), bf_hi(w.x), bf_lo(w.y), bf_hi(w.y)}; zc[j] = zn[j]; }
        const f32x4 c = cc, s = sc; cc = cn; sc = sn2;
        const float sq0 = (v[0][0] * v[0][0] + v[0][1] * v[0][1]) + (v[0][2] * v[0][2] + v[0][3] * v[0][3]);
        const float sq1 = (v[1][0] * v[1][0] + v[1][1] * v[1][1]) + (v[1][2] * v[1][2] + v[1][3] * v[1][3]);
        const float sq2 = (v[2][0] * v[2][0] + v[2][1] * v[2][1]) + (v[2][2] * v[2][2] + v[2][3] * v[2][3]);
        const float ssq_q = wave_sum(sq0 + (lane < 32 ? sq1 : 0.f)), ssq_kv = wave_sum((lane >= 32 ? sq1 : 0.f) + (lane < 32 ? sq2 : 0.f));
        const float rq = 1.f / sqrtf(ssq_q * (1.f / 384.f) + LN_EPS), rkv = 1.f / sqrtf(ssq_kv * (1.f / 256.f) + LN_EPS);
        { const f32x4 o = v[0] * rq * gq0; u32x2 w; w.x = cvt_pk_bf16(o[0], o[1]); w.y = cvt_pk_bf16(o[2], o[3]); *(u32x2*)(CQN + (size_t)row * 384 + 4 * lane) = w; }
        if (lane < 32) { const f32x4 o = v[1] * rq * g1; u32x2 w; w.x = cvt_pk_bf16(o[0], o[1]); w.y = cvt_pk_bf16(o[2], o[3]); *(u32x2*)(CQN + (size_t)row * 384 + 256 + 4 * lane) = w;
                         const f32x4 o2 = v[2] * rkv * g2; u32x2 w2; w2.x = cvt_pk_bf16(o2[0], o2[1]); w2.y = cvt_pk_bf16(o2[2], o2[3]); *(u32x2*)(CKVN + (size_t)row * 256 + 128 + 4 * lane) = w2; }
        else { const f32x4 o = v[1] * rkv * g1; u32x2 w; w.x = cvt_pk_bf16(o[0], o[1]); w.y = cvt_pk_bf16(o[2], o[3]); *(u32x2*)(CKVN + (size_t)row * 256 + 4 * (lane - 32)) = w; }
        f32x4 part;
#pragma unroll
        for (int q = 0; q < 4; ++q) part[q] = __shfl_xor(v[2][q], 8);
        if (lane >= 32 && lane < 48) {
            const bool second = lane >= 40; const int i0 = i0r;
            const f32x4 o = second ? (v[2] * c + part * s) : (v[2] * c - part * s);
            u32x2 w; w.x = cvt_pk_bf16(o[0], o[1]); w.y = cvt_pk_bf16(o[2], o[3]);
            const int b = row >> 11, s_ = row & 2047;
            if (ATT_FP8) { const unsigned w8 = pk4_fp8(o[0], o[1], o[2], o[3]);
#pragma unroll
                for (int h = 0; h < 8; ++h) *(unsigned*)((unsigned char*)Kc + ((size_t)(b * 8 + h) * SEQ + s_) * 192 + 128 + (second ? 32 : 0) + i0) = w8; }
            else {
#pragma unroll
            for (int h = 0; h < 8; ++h) *(u32x2*)(Kc + ((size_t)(b * 8 + h) * SEQ + s_) * 192 + 128 + (second ? 32 : 0) + i0) = w; }
        }
    }
}
namespace attn {
constexpr int DQK = 192, DV = 128, NW = 8, QBLK = 32, KVBLK = 64;
constexpr float SCALE = 0.07216878364870322f;
constexpr float THR = 8.f;
constexpr int LDQ = 8 * DQK, LDK = DQK, LDVV = DV, LDO = 1024;
constexpr int SHM_V = KVBLK * DV * 2, SHM_K = KVBLK * DQK * 2;
constexpr int SHM_ATTN = 2 * SHM_V + 2 * SHM_K + NW * 64 * 4;
#define KSWZ192(row, colB) ((row) * 384 + ((colB) ^ ((((row) >> 1) & 7) << 4)))
#define SBAR() __builtin_amdgcn_sched_barrier(0)

template <bool DEFER = true>
__device__ __forceinline__ void partialSM(f32x16& p0, f32x16& p1, float& m_reg, float& mn, float& alpha) {
    constexpr float Cc = SCALE * 1.4426950408889634f;
    float pmax = p0[0];
#pragma unroll
    for (int r = 1; r < 16; ++r) pmax = fmaxf(pmax, p0[r]);
#pragma unroll
    for (int r = 0; r < 16; ++r) pmax = fmaxf(pmax, p1[r]);
    { auto rr = __builtin_amdgcn_permlane32_swap(__float_as_uint(pmax), __float_as_uint(pmax), false, false);
      pmax = fmaxf(__uint_as_float(rr[0]), __uint_as_float(rr[1])); }
    if (__builtin_expect(__all(pmax - m_reg <= (DEFER ? THR / SCALE : 0.f)), 1)) { mn = m_reg; alpha = 1.f; }
    else { mn = fmaxf(m_reg, pmax); alpha = __builtin_amdgcn_exp2f((m_reg - mn) * Cc); m_reg = mn; }
    const float mnC = -mn * Cc;
#pragma unroll
    for (int r = 0; r < 16; ++r) p0[r] = fmaf(p0[r], Cc, mnC);
#pragma unroll
    for (int r = 0; r < 16; ++r) p1[r] = fmaf(p1[r], Cc, mnC);
#pragma unroll
    for (int r = 0; r < 16; ++r) p0[r] = __builtin_amdgcn_exp2f(p0[r]);
}
__device__ __forceinline__ void finishSM(f32x16& p0, f32x16& p1, float alpha, float& l_reg, bf16x8& pa0, bf16x8& pa1, bf16x8& pa2, bf16x8& pa3) {
#pragma unroll
    for (int r = 0; r < 16; ++r) p1[r] = __builtin_amdgcn_exp2f(p1[r]);
    float ps = 0;
#pragma unroll
    for (int r = 0; r < 16; ++r) ps += p0[r];
#pragma unroll
    for (int r = 0; r < 16; ++r) ps += p1[r];
    { auto rr = __builtin_amdgcn_permlane32_swap(__float_as_uint(ps), __float_as_uint(ps), false, false);
      ps = __uint_as_float(rr[0]) + __uint_as_float(rr[1]); }
    l_reg = l_reg * alpha + ps;
#define PK4(P, BASE, OUT) do { unsigned a0 = cvt_pk_bf16(P[BASE + 0], P[BASE + 1]), a1 = cvt_pk_bf16(P[BASE + 2], P[BASE + 3]);   \
    unsigned b0 = cvt_pk_bf16(P[BASE + 4], P[BASE + 5]), b1 = cvt_pk_bf16(P[BASE + 6], P[BASE + 7]);                              \
    auto r0 = __builtin_amdgcn_permlane32_swap(a0, b0, false, false); auto r1 = __builtin_amdgcn_permlane32_swap(a1, b1, false, false); \
    u32x4 w = {r0[0], r1[0], r0[1], r1[1]}; OUT = __builtin_bit_cast(bf16x8, w); } while (0)
    PK4(p0, 0, pa0); PK4(p0, 8, pa1); PK4(p1, 0, pa2); PK4(p1, 8, pa3);
#undef PK4
}
template <int KOFF>
__device__ __forceinline__ void qkt(f32x16& p0, f32x16& p1, const int (&kb)[4], const bf16x8* qr) {
    p0 = f32x16{}; p1 = f32x16{};
#pragma unroll
    for (int d0 = 0; d0 < 12; ++d0) { const int a = d0 >> 2, b = d0 & 3;
        const bf16x8 b0 = *(const LAS bf16x8*)(uintptr_t)(unsigned)(kb[b] + 128 * a + KOFF);
        const bf16x8 b1 = *(const LAS bf16x8*)(uintptr_t)(unsigned)(kb[b] + 128 * a + 12288 + KOFF);
        p0 = __builtin_amdgcn_mfma_f32_32x32x16_bf16(b0, qr[d0], p0, 0, 0, 0);
        p1 = __builtin_amdgcn_mfma_f32_32x32x16_bf16(b1, qr[d0], p1, 0, 0, 0); }
}
template <int D0> __device__ __forceinline__ void pv_one(f32x16& od, int vb, bf16x8 pa0, bf16x8 pa1, bf16x8 pa2, bf16x8 pa3) {
    const s16x4 l0 = tr_read<v_rd_off(D0, 0, 0)>(vb), h0 = tr_read<v_rd_off(D0, 0, 1)>(vb), l1 = tr_read<v_rd_off(D0, 1, 0)>(vb), h1 = tr_read<v_rd_off(D0, 1, 1)>(vb);
    const s16x4 l2 = tr_read<v_rd_off(D0, 2, 0)>(vb), h2 = tr_read<v_rd_off(D0, 2, 1)>(vb), l3 = tr_read<v_rd_off(D0, 3, 0)>(vb), h3 = tr_read<v_rd_off(D0, 3, 1)>(vb);
    asm volatile("s_waitcnt lgkmcnt(0)" ::: "memory"); SBAR();
    od = __builtin_amdgcn_mfma_f32_32x32x16_bf16(pa0, PKLH(l0, h0), od, 0, 0, 0);
    od = __builtin_amdgcn_mfma_f32_32x32x16_bf16(pa1, PKLH(l1, h1), od, 0, 0, 0);
    od = __builtin_amdgcn_mfma_f32_32x32x16_bf16(pa2, PKLH(l2, h2), od, 0, 0, 0);
    od = __builtin_amdgcn_mfma_f32_32x32x16_bf16(pa3, PKLH(l3, h3), od, 0, 0, 0);
}
__device__ __forceinline__ void pv_d0(f32x16* o, int vb, bf16x8 pa0, bf16x8 pa1, bf16x8 pa2, bf16x8 pa3) {
    pv_one<0>(o[0], vb, pa0, pa1, pa2, pa3); pv_one<1>(o[1], vb, pa0, pa1, pa2, pa3); pv_one<2>(o[2], vb, pa0, pa1, pa2, pa3); pv_one<3>(o[3], vb, pa0, pa1, pa2, pa3);
}
__device__ __forceinline__ void attn_unit(const bf16_t* __restrict__ Qb, const bf16_t* __restrict__ Kh, const bf16_t* __restrict__ Vh, bf16_t* __restrict__ Ob, LAS unsigned char* lds) {
    const int tid = opaque((int)threadIdx.x), wid = tid >> 6, lane = tid & 63, r32 = lane & 31, hi = lane >> 5;
    LAS unsigned char* V_lds = lds; LAS unsigned char* K_lds = lds + 2 * SHM_V;
    LAS float* wsf = (LAS float*)(lds + 2 * SHM_V + 2 * SHM_K) + wid * 64; LAS float* li_l = wsf; LAS float* al_l = wsf + 32;
    float m_reg = -1e30f, l_reg = 0; f32x16 o[4] = {}; bf16x8 qr[12];
    const bf16_t* Qw = Qb + (long)(wid * QBLK + r32) * LDQ + hi * 8;
#pragma unroll
    for (int d0 = 0; d0 < 12; ++d0) qr[d0] = *(const bf16x8*)(Qw + d0 * 16);
    const int sr = tid >> 4, sc = (tid & 15) * 8, vst0 = v_st(sr, sc), vst1 = v_st(32 + sr, sc);
    int krow[3], kch[3];
#pragma unroll
    for (int i = 0; i < 3; ++i) { const int id = tid + 512 * i; krow[i] = id / 24; kch[i] = id % 24; }
    const int vb0 = lds_addr(V_lds) + v_rd_base(lane);
    bf16x8 vs0, vs1, ks0, ks1, ks2;
#define SLOAD(k0) do { vs0 = *(const bf16x8*)(Vh + (long)((k0) + sr) * LDVV + sc); vs1 = *(const bf16x8*)(Vh + (long)((k0) + 32 + sr) * LDVV + sc); \
    ks0 = *(const bf16x8*)(Kh + (long)((k0) + krow[0]) * LDK + kch[0] * 8); ks1 = *(const bf16x8*)(Kh + (long)((k0) + krow[1]) * LDK + kch[1] * 8); ks2 = *(const bf16x8*)(Kh + (long)((k0) + krow[2]) * LDK + kch[2] * 8); } while (0)
#define SWRITE(b) do { *(LAS bf16x8*)(V_lds + (b) * SHM_V + vst0) = vs0; *(LAS bf16x8*)(V_lds + (b) * SHM_V + vst1) = vs1; \
    *(LAS bf16x8*)(K_lds + (b) * SHM_K + KSWZ192(krow[0], kch[0] * 16)) = ks0; *(LAS bf16x8*)(K_lds + (b) * SHM_K + KSWZ192(krow[1], kch[1] * 16)) = ks1; \
    *(LAS bf16x8*)(K_lds + (b) * SHM_K + KSWZ192(krow[2], kch[2] * 16)) = ks2; } while (0)
#define RESC(a) do { if (__any((a) < 1.f)) { if (hi == 0) al_l[r32] = (a); asm volatile("s_waitcnt lgkmcnt(0)" ::: "memory"); \
    _Pragma("unroll") for (int d = 0; d < 4; ++d) _Pragma("unroll") for (int r = 0; r < 16; ++r) o[d][r] *= al_l[crow(r, hi)]; } } while (0)
    int kb[4];
    { const int xr = ((r32 >> 1) & 7) << 4;
#pragma unroll
      for (int b = 0; b < 4; ++b) kb[b] = lds_addr(K_lds) + r32 * 384 + (((b << 5) | (hi << 4)) ^ xr); }
    f32x16 pA0, pA1, pB0, pB1; float mnA, mnB, alA, alB; bf16x8 pa0, pa1, pa2, pa3; constexpr int NTILES = SEQ / KVBLK;
    SLOAD(0); asm volatile("s_waitcnt vmcnt(0)" ::: "memory"); SWRITE(0); __syncthreads();
    qkt<0>(pA0, pA1, kb, qr); partialSM(pA0, pA1, m_reg, mnA, alA);
    SLOAD(KVBLK);
    asm volatile("s_waitcnt vmcnt(0)" ::: "memory"); SWRITE(1); __syncthreads();
    for (int j = 1; j + 1 < NTILES; j += 2) {
        SBAR(); qkt<SHM_K>(pB0, pB1, kb, qr);
        finishSM(pA0, pA1, alA, l_reg, pa0, pa1, pa2, pa3); SBAR();
        SLOAD((j + 1) * KVBLK); SBAR();
        pv_d0(o, vb0, pa0, pa1, pa2, pa3); partialSM(pB0, pB1, m_reg, mnB, alB);
        __syncthreads(); asm volatile("s_waitcnt vmcnt(0)" ::: "memory"); SWRITE(0);
        RESC(alB); __syncthreads();
        SBAR(); qkt<0>(pA0, pA1, kb, qr);
        finishSM(pB0, pB1, alB, l_reg, pa0, pa1, pa2, pa3); SBAR();
        SLOAD((j + 2) * KVBLK); SBAR();
        pv_d0(o, vb0 + SHM_V, pa0, pa1, pa2, pa3); partialSM(pA0, pA1, m_reg, mnA, alA);
        __syncthreads(); asm volatile("s_waitcnt vmcnt(0)" ::: "memory"); SWRITE(1);
        RESC(alA); __syncthreads();
    }
    SBAR(); qkt<SHM_K>(pB0, pB1, kb, qr);
    finishSM(pA0, pA1, alA, l_reg, pa0, pa1, pa2, pa3); SBAR();
    pv_d0(o, vb0, pa0, pa1, pa2, pa3); partialSM(pB0, pB1, m_reg, mnB, alB);
    __syncthreads(); RESC(alB);
    finishSM(pB0, pB1, alB, l_reg, pa0, pa1, pa2, pa3); SBAR();
    pv_d0(o, vb0 + SHM_V, pa0, pa1, pa2, pa3);
    if (hi == 0) li_l[r32] = l_reg; asm volatile("s_waitcnt lgkmcnt(0)" ::: "memory");
    float rli[16];
#pragma unroll
    for (int r = 0; r < 16; ++r) rli[r] = __builtin_amdgcn_rcpf(li_l[crow(r, hi)]);
    bf16_t* Ow = Ob + (long)(wid * QBLK) * LDO;
#pragma unroll
    for (int r = 0; r < 16; ++r) { const int orow = crow(r, hi);
#pragma unroll
        for (int d0 = 0; d0 < 4; ++d0) Ow[(long)orow * LDO + d0 * 32 + r32] = f2bf(o[d0][r] * rli[r]); }
    __syncthreads();
#undef SLOAD
#undef SWRITE
#undef RESC
}
constexpr int SHM_K8 = KVBLK * DQK;
#define KSWZ8(row, ch) ((row) * 192 + ((((ch)) ^ (((row) >> 2) & 3)) << 4))
template <int KOFF>
__device__ __forceinline__ void qkt8(f32x16& p0, f32x16& p1, int kbA, int kbB, const i32x8 (&q8)[3], int f8sc) {
    p0 = f32x16{}; p1 = f32x16{};
    asm volatile("s_nop 1" ::: "memory");
#pragma unroll
    for (int i = 0; i < 3; ++i) {
        const i32x4 a0 = *(const LAS i32x4*)(uintptr_t)(unsigned)(kbA + 64 * i + KOFF), a1 = *(const LAS i32x4*)(uintptr_t)(unsigned)(kbB + 64 * i + KOFF);
        const i32x4 b0 = *(const LAS i32x4*)(uintptr_t)(unsigned)(kbA + 64 * i + 6144 + KOFF), b1 = *(const LAS i32x4*)(uintptr_t)(unsigned)(kbB + 64 * i + 6144 + KOFF);
        const i32x8 k0 = __builtin_shufflevector(a0, a1, 0, 1, 2, 3, 4, 5, 6, 7), k1 = __builtin_shufflevector(b0, b1, 0, 1, 2, 3, 4, 5, 6, 7);
        asm volatile("v_mfma_scale_f32_32x32x64_f8f6f4 %0, %1, %2, %0, %3, %3 op_sel_hi:[0,0,0]" : "+v"(p0) : "v"(k0), "v"(q8[i]), "v"(f8sc));
        asm volatile("v_mfma_scale_f32_32x32x64_f8f6f4 %0, %1, %2, %0, %3, %3 op_sel_hi:[0,0,0]" : "+v"(p1) : "v"(k1), "v"(q8[i]), "v"(f8sc));
    }
    asm volatile("s_nop 15\n\ts_nop 15" : "+v"(p0), "+v"(p1));
}
__device__ __forceinline__ void attn_unit8(const unsigned char* __restrict__ Qb, const unsigned char* __restrict__ Kh, const bf16_t* __restrict__ Vh, bf16_t* __restrict__ Ob, LAS unsigned char* lds) {
    const int tid = opaque((int)threadIdx.x), wid = tid >> 6, lane = tid & 63, r32 = lane & 31, hi = lane >> 5;
    LAS unsigned char* V_lds = lds; LAS unsigned char* K_lds = lds + 2 * SHM_V;
    LAS float* wsf = (LAS float*)(lds + 2 * SHM_V + 2 * SHM_K8) + wid * 64; LAS float* li_l = wsf; LAS float* al_l = wsf + 32;
    float m_reg = -1e30f, l_reg = 0; f32x16 o[4] = {}; i32x8 q8[3]; const int f8sc = 0x7f7f7f7f;
    { const unsigned char* Qw = Qb + (size_t)(wid * QBLK + r32) * 1536 + 32 * hi;
#pragma unroll
      for (int i = 0; i < 3; ++i) { const i32x4 lo = *(const i32x4*)(Qw + 64 * i), hi4 = *(const i32x4*)(Qw + 64 * i + 16); q8[i] = __builtin_shufflevector(lo, hi4, 0, 1, 2, 3, 4, 5, 6, 7); } }
    const int sr = tid >> 4, sc = (tid & 15) * 8, vst0 = v_st(sr, sc), vst1 = v_st(32 + sr, sc);
    const int kr0 = tid / 12, kc0 = tid % 12, kr1 = (tid + 512) / 12, kc1 = (tid + 512) % 12; const bool k2 = tid < 256;
    const int vb0 = lds_addr(V_lds) + v_rd_base(lane);
    bf16x8 vs0, vs1; i32x4 ks0, ks1 = {0, 0, 0, 0};
#define SLOAD(k0) do { vs0 = *(const bf16x8*)(Vh + (long)((k0) + sr) * LDVV + sc); vs1 = *(const bf16x8*)(Vh + (long)((k0) + 32 + sr) * LDVV + sc); \
    ks0 = *(const i32x4*)(Kh + (size_t)((k0) + kr0) * 192 + kc0 * 16); if (k2) ks1 = *(const i32x4*)(Kh + (size_t)((k0) + kr1) * 192 + kc1 * 16); } while (0)
#define SWRITE(b) do { *(LAS bf16x8*)(V_lds + (b) * SHM_V + vst0) = vs0; *(LAS bf16x8*)(V_lds + (b) * SHM_V + vst1) = vs1; \
    *(LAS i32x4*)(K_lds + (b) * SHM_K8 + KSWZ8(kr0, kc0)) = ks0; if (k2) *(LAS i32x4*)(K_lds + (b) * SHM_K8 + KSWZ8(kr1, kc1)) = ks1; } while (0)
#define RESC(a) do { if (__any((a) < 1.f)) { if (hi == 0) al_l[r32] = (a); asm volatile("s_waitcnt lgkmcnt(0)" ::: "memory"); \
    _Pragma("unroll") for (int d = 0; d < 4; ++d) _Pragma("unroll") for (int r = 0; r < 16; ++r) o[d][r] *= al_l[crow(r, hi)]; } } while (0)
    const int xr = (r32 >> 2) & 3;
    const int kbA = lds_addr(K_lds) + r32 * 192 + (((2 * hi) ^ xr) << 4), kbB = lds_addr(K_lds) + r32 * 192 + (((2 * hi + 1) ^ xr) << 4);
    f32x16 pA0, pA1, pB0, pB1; float mnA, mnB, alA, alB; bf16x8 pa0, pa1, pa2, pa3; constexpr int NTILES = SEQ / KVBLK;
    SLOAD(0); asm volatile("s_waitcnt vmcnt(0)" ::: "memory"); SWRITE(0); __syncthreads();
    qkt8<0>(pA0, pA1, kbA, kbB, q8, f8sc); partialSM(pA0, pA1, m_reg, mnA, alA);
    SLOAD(KVBLK);
    asm volatile("s_waitcnt vmcnt(0)" ::: "memory"); SWRITE(1); __syncthreads();
    for (int j = 1; j + 1 < NTILES; j += 2) {
        SBAR(); qkt8<SHM_K8>(pB0, pB1, kbA, kbB, q8, f8sc);
        finishSM(pA0, pA1, alA, l_reg, pa0, pa1, pa2, pa3); SBAR();
        SLOAD((j + 1) * KVBLK); SBAR();
        pv_d0(o, vb0, pa0, pa1, pa2, pa3); partialSM(pB0, pB1, m_reg, mnB, alB);
        __syncthreads(); asm volatile("s_waitcnt vmcnt(0)" ::: "memory"); SWRITE(0);
        RESC(alB); __syncthreads();
        SBAR(); qkt8<0>(pA0, pA1, kbA, kbB, q8, f8sc);
        finishSM(pB0, pB1, alB, l_reg, pa0, pa1, pa2, pa3); SBAR();
        SLOAD((j + 2) * KVBLK); SBAR();
        pv_d0(o, vb0 + SHM_V, pa0, pa1, pa2, pa3); partialSM(pA0, pA1, m_reg, mnA, alA);
        __syncthreads(); asm volatile("s_waitcnt vmcnt(0)" ::: "memory"); SWRITE(1);
        RESC(alA); __syncthreads();
    }
    SBAR(); qkt8<SHM_K8>(pB0, pB1, kbA, kbB, q8, f8sc);
    finishSM(pA0, pA1, alA, l_reg, pa0, pa1, pa2, pa3); SBAR();
    pv_d0(o, vb0, pa0, pa1, pa2, pa3); partialSM(pB0, pB1, m_reg, mnB, alB);
    __syncthreads(); RESC(alB);
    finishSM(pB0, pB1, alB, l_reg, pa0, pa1, pa2, pa3); SBAR();
    pv_d0(o, vb0 + SHM_V, pa0, pa1, pa2, pa3);
    if (hi == 0) li_l[r32] = l_reg; asm volatile("s_waitcnt lgkmcnt(0)" ::: "memory");
    float rli[16];
#pragma unroll
    for (int r = 0; r < 16; ++r) rli[r] = __builtin_amdgcn_rcpf(li_l[crow(r, hi)]);
    bf16_t* Ow = Ob + (long)(wid * QBLK) * LDO;
#pragma unroll
    for (int r = 0; r < 16; ++r) { const int orow = crow(r, hi);
#pragma unroll
        for (int d0 = 0; d0 < 4; ++d0) Ow[(long)orow * LDO + d0 * 32 + r32] = f2bf(o[d0][r] * rli[r]); }
    __syncthreads();
#undef SLOAD
#undef SWRITE
#undef RESC
}
constexpr int SHM_V8 = KVBLK * DV;
__device__ __forceinline__ void finishSM8(f32x16& p0, f32x16& p1, float alpha, float& l_reg, i32x8& P8) {
#pragma unroll
    for (int r = 0; r < 16; ++r) p1[r] = __builtin_amdgcn_exp2f(p1[r]);
    float ps = 0;
#pragma unroll
    for (int r = 0; r < 16; ++r) ps += p0[r];
#pragma unroll
    for (int r = 0; r < 16; ++r) ps += p1[r];
    { auto rr = __builtin_amdgcn_permlane32_swap(__float_as_uint(ps), __float_as_uint(ps), false, false);
      ps = __uint_as_float(rr[0]) + __uint_as_float(rr[1]); }
    l_reg = l_reg * alpha + ps;
#pragma unroll
    for (int i = 0; i < 4; ++i) { P8[i] = (int)pk4_fp8(p0[4 * i] * F8_SP, p0[4 * i + 1] * F8_SP, p0[4 * i + 2] * F8_SP, p0[4 * i + 3] * F8_SP); P8[4 + i] = (int)pk4_fp8(p1[4 * i] * F8_SP, p1[4 * i + 1] * F8_SP, p1[4 * i + 2] * F8_SP, p1[4 * i + 3] * F8_SP); }
}
template <int VOFF>
__device__ __forceinline__ void pv8(f32x16 (&o)[4], int vbA, int vbB, const i32x8& P8, int f8sc) {
    i32x8 vf[4];
#pragma unroll
    for (int d0 = 0; d0 < 4; ++d0) { const i32x4 a = *(const LAS i32x4*)(uintptr_t)(unsigned)(vbA + d0 * 2048 + VOFF), b = *(const LAS i32x4*)(uintptr_t)(unsigned)(vbB + d0 * 2048 + VOFF); vf[d0] = __builtin_shufflevector(a, b, 0, 1, 2, 3, 4, 5, 6, 7); }
    asm volatile("s_nop 4" ::: "memory");
#pragma unroll
    for (int d0 = 0; d0 < 4; ++d0) asm volatile("v_mfma_scale_f32_32x32x64_f8f6f4 %0, %1, %2, %0, %3, %3 op_sel_hi:[0,0,0]" : "+v"(o[d0]) : "v"(P8), "v"(vf[d0]), "v"(f8sc));
    asm volatile("s_nop 15\n\ts_nop 15" : "+v"(o[0]), "+v"(o[1]), "+v"(o[2]), "+v"(o[3]));
}
__device__ __forceinline__ void attn_unit88(const unsigned char* __restrict__ Qb, const unsigned char* __restrict__ Kh, const unsigned char* __restrict__ Vt, bf16_t* __restrict__ Ob, LAS unsigned char* lds) {
    const int tid = opaque((int)threadIdx.x), wid = tid >> 6, lane = tid & 63, r32 = lane & 31, hi = lane >> 5;
    LAS unsigned char* V_lds = lds; LAS unsigned char* K_lds = lds + 2 * SHM_V8;
    LAS float* wsf = (LAS float*)(lds + 2 * SHM_V8 + 2 * SHM_K8) + wid * 64; LAS float* li_l = wsf; LAS float* al_l = wsf + 32;
    float m_reg = -1e30f, l_reg = 0; f32x16 o[4] = {}; i32x8 q8[3]; const int f8sc = 0x7f7f7f7f;
    { const unsigned char* Qw = Qb + (size_t)(wid * QBLK + r32) * 1536 + 32 * hi;
#pragma unroll
      for (int i = 0; i < 3; ++i) { const i32x4 lo = *(const i32x4*)(Qw + 64 * i), hi4 = *(const i32x4*)(Qw + 64 * i + 16); q8[i] = __builtin_shufflevector(lo, hi4, 0, 1, 2, 3, 4, 5, 6, 7); } }
    const int vdv = tid >> 2, vc = tid & 3;
    int vwa[4];
#pragma unroll
    for (int g = 0; g < 4; ++g) { const int h = g & 1, slotbase = 16 * (vc >> 1) + 4 * (2 * (vc & 1) + (g >> 1)); const int chunk = 2 * h + (slotbase >> 4); vwa[g] = vdv * 64 + ((chunk ^ ((vdv >> 2) & 3)) << 4) + (slotbase & 15); }
    const int kr0 = tid / 12, kc0 = tid % 12, kr1 = (tid + 512) / 12, kc1 = (tid + 512) % 12; const bool k2 = tid < 256;
    i32x4 vs, ks0, ks1 = {0, 0, 0, 0};
#define SLOAD(k0) do { vs = *(const i32x4*)(Vt + (size_t)vdv * SEQ + (k0) + 16 * vc); \
    ks0 = *(const i32x4*)(Kh + (size_t)((k0) + kr0) * 192 + kc0 * 16); if (k2) ks1 = *(const i32x4*)(Kh + (size_t)((k0) + kr1) * 192 + kc1 * 16); } while (0)
#define SWRITE(b) do { _Pragma("unroll") for (int g = 0; g < 4; ++g) *(LAS int*)(V_lds + (b) * SHM_V8 + vwa[g]) = vs[g]; \
    *(LAS i32x4*)(K_lds + (b) * SHM_K8 + KSWZ8(kr0, kc0)) = ks0; if (k2) *(LAS i32x4*)(K_lds + (b) * SHM_K8 + KSWZ8(kr1, kc1)) = ks1; } while (0)
#define RESC(a) do { if (__any((a) < 1.f)) { if (hi == 0) al_l[r32] = (a); asm volatile("s_waitcnt lgkmcnt(0)" ::: "memory"); \
    _Pragma("unroll") for (int d = 0; d < 4; ++d) _Pragma("unroll") for (int r = 0; r < 16; ++r) o[d][r] *= al_l[crow(r, hi)]; } } while (0)
    const int xr = (r32 >> 2) & 3;
    const int kbA = lds_addr(K_lds) + r32 * 192 + (((2 * hi) ^ xr) << 4), kbB = lds_addr(K_lds) + r32 * 192 + (((2 * hi + 1) ^ xr) << 4);
    const int vbA = lds_addr(V_lds) + r32 * 64 + (((2 * hi) ^ xr) << 4), vbB = lds_addr(V_lds) + r32 * 64 + (((2 * hi + 1) ^ xr) << 4);
    f32x16 pA0, pA1, pB0, pB1; float mnA, mnB, alA, alB; i32x8 P8; constexpr int NTILES = SEQ / KVBLK;
    SLOAD(0); asm volatile("s_waitcnt vmcnt(0)" ::: "memory"); SWRITE(0); __syncthreads();
    qkt8<0>(pA0, pA1, kbA, kbB, q8, f8sc); partialSM<false>(pA0, pA1, m_reg, mnA, alA);
    SLOAD(KVBLK);
    asm volatile("s_waitcnt vmcnt(0)" ::: "memory"); SWRITE(1); __syncthreads();
    for (int j = 1; j + 1 < NTILES; j += 2) {
        SBAR(); qkt8<SHM_K8>(pB0, pB1, kbA, kbB, q8, f8sc);
        finishSM8(pA0, pA1, alA, l_reg, P8); SBAR();
        SLOAD((j + 1) * KVBLK); SBAR();
        pv8<0>(o, vbA, vbB, P8, f8sc); partialSM<false>(pB0, pB1, m_reg, mnB, alB);
        __syncthreads(); asm volatile("s_waitcnt vmcnt(0)" ::: "memory"); SWRITE(0);
        RESC(alB); __syncthreads();
        SBAR(); qkt8<0>(pA0, pA1, kbA, kbB, q8, f8sc);
        finishSM8(pB0, pB1, alB, l_reg, P8); SBAR();
        SLOAD((j + 2) * KVBLK); SBAR();
        pv8<SHM_V8>(o, vbA, vbB, P8, f8sc); partialSM<false>(pA0, pA1, m_reg, mnA, alA);
        __syncthreads(); asm volatile("s_waitcnt vmcnt(0)" ::: "memory"); SWRITE(1);
        RESC(alA); __syncthreads();
    }
    SBAR(); qkt8<SHM_K8>(pB0, pB1, kbA, kbB, q8, f8sc);
    finishSM8(pA0, pA1, alA, l_reg, P8); SBAR();
    pv8<0>(o, vbA, vbB, P8, f8sc); partialSM<false>(pB0, pB1, m_reg, mnB, alB);
    __syncthreads(); RESC(alB);
    finishSM8(pB0, pB1, alB, l_reg, P8); SBAR();
    pv8<SHM_V8>(o, vbA, vbB, P8, f8sc);
    if (hi == 0) li_l[r32] = l_reg; asm volatile("s_waitcnt lgkmcnt(0)" ::: "memory");
    float rli[16];
#pragma unroll
    for (int r = 0; r < 16; ++r) rli[r] = __builtin_amdgcn_rcpf(li_l[crow(r, hi)]) * (1.0f / (F8_SP * F8_SV));
    bf16_t* Ow = Ob + (long)(wid * QBLK) * LDO;
#pragma unroll
    for (int r = 0; r < 16; ++r) { const int orow = crow(r, hi);
#pragma unroll
        for (int d0 = 0; d0 < 4; ++d0) Ow[(long)orow * LDO + d0 * 32 + r32] = f2bf(o[d0][r] * rli[r]); }
    __syncthreads();
#undef SLOAD
#undef SWRITE
#undef RESC
}
}
#ifndef MK_SPLIT
#define MK_SPLIT 0
#endif
#ifndef PROBE_REPEAT
#define PROBE_REPEAT -1
#endif
constexpr int N_PHASES = 34;
struct Args { const void* in[N_IN]; float* out; unsigned char* ws; };

template <int LO, int HI>
__global__ void __launch_bounds__(512, 2) fwd_kernel(Args args) {
    extern __shared__ __attribute__((aligned(16))) unsigned char lds_raw[];
    Ctx C;
    C.lds = (LAS unsigned char*)lds_raw;
    C.tid = threadIdx.x; C.lane = C.tid & 63; C.wave = __builtin_amdgcn_readfirstlane(C.tid >> 6);
    C.G = gridDim.x; C.gw = blockIdx.x * 8 + C.wave; C.NGW = C.G * 8;
    C.in = args.in; C.out = args.out; C.ws = args.ws;
    volatile LAS unsigned* MISC = (volatile LAS unsigned*)(C.lds + LDS_MISC);
    if (C.tid < 64) MISC[C.tid] = 0u;
    __syncthreads();
    unsigned* barw = (unsigned*)(args.ws + WS_CTL) + CW_BAR;
    XcdBarrier bar; bar.bar = barw; bar.x = 0; bar.st = MISC + 8;
    if (HI - LO > 1) bar = xcd_barrier_post(barw, MISC + 8);
#define IN(k) (LO <= (k) && (k) < HI)
#define PH_BEGIN() do { C.tid = opaque((int)threadIdx.x); C.lane = C.tid & 63; ws = opaque_sptr(args.ws); C.ws = ws; C.out = (float*)opaque_sptr((unsigned char*)args.out); } while (0)
#define SEAM(k) do { if (IN(k) && IN((k) + 1)) xcd_barrier(bar); } while (0)

    unsigned char* ws = args.ws;
    const int bx = blockIdx.x;
#define XB ((bf16_t*)(ws + WS_XB))
#define Zb ((bf16_t*)(ws + WS_Z))
#define Hb ((bf16_t*)(ws + WS_H))
#define wm ((const char*)(ws + WS_WMIX))
#define gatesf ((float*)(ws + WS_SMALL + SM_GATES))
#define W1 ((bf16_t*)(ws + WS_WMOE))
#define W2 (W1 + (size_t)16 * 2048 * 1024)
#define UB ((bf16_t*)C.out)
#define YB ((bf16_t*)C.out + (size_t)NT * DM)

#define PHASE(k) if (IN(k)) for (int rep_ = 0; rep_ < ((k) == PROBE_REPEAT ? 2 : 1); ++rep_)
#define MOE_UP(eg) { pg8::GMoe g{XB, W1, 1024, 1024, 1024, (size_t)2048 * 1024 * 2, (const int*)(ws + WS_SMALL + SM_IDX)}; pg8::OffsetOrder S; S.init(128, 8, C.G, bx); S.pm_off = 128 * (eg); pg8::EpiSwiglu E{Hb}; \
        pg8::gemm_phase<true>(C.lds, g, S, E); }
#define MOE_DOWN(eg) { pg8::GMoeTA g{Hb, W2, 64, 1024, 1024, (size_t)1024 * 1024 * 2}; pg8::OffsetOrder S; S.init(128, 4, C.G, bx); S.pm_off = 128 * (eg); pg8::EpiBf16 E{Zb, 1024}; \
        pg8::gemm_phase(C.lds, g, S, E); }
#if MOE_FP8
#define MOE_PREP(l) prep_moe_weights8(C, l)
#define MOE_BLOCK(base, layer) \
    PHASE((base) + 0) { PH_BEGIN(); topk_select(C); } SEAM((base) + 0); \
    PHASE((base) + 1) { PH_BEGIN(); pg8::GMoe g{(const bf16_t*)(ws + WS_XB8), (const bf16_t*)(ws + WS_WMOE), 512, 512, 512, (size_t)2048 * 1024, (const int*)(ws + WS_SMALL + SM_IDX)}; pg8::EpiSwiglu8 E{(unsigned char*)Hb}; \
        for (int p0 = 0; p0 < 512; p0 += 2 * C.G) { pg8::OffsetOrder S; S.init((512 - p0) < 2 * C.G ? (512 - p0) : 2 * C.G, 8, C.G, bx); S.pm_off = p0; pg8::gemm_phase<true, true>(C.lds, g, S, E); }     \
        } SEAM((base) + 1); \
    PHASE((base) + 2) { PH_BEGIN(); pg8::GMoeTA8 g{(const unsigned char*)Hb, ws + WS_WMOE + (size_t)16 * 2048 * 1024, 64, 512, 512, (size_t)1024 * 1024}; pg8::StaticOrder S; S.init(512, 4, C.G, bx); pg8::EpiFp8S E{(unsigned char*)Zb, 1024, F8_SO / (F8_SH * F8_SW2)}; \
        pg8::gemm_phase<false, true>(C.lds, g, S, E); } SEAM((base) + 2); \
    PHASE((base) + 3) { PH_BEGIN(); moe_combine_ln2<(layer) == 3>(C, layer); if ((layer) < 3) MOE_PREP((layer) + 1); } SEAM((base) + 3);
#else
#define MOE_PREP(l) prep_moe_weights(C, l)
#define MOE_BLOCK(base, layer) \
    PHASE((base) + 0) { PH_BEGIN(); topk_select(C); } SEAM((base) + 0); \
    PHASE((base) + 1) { PH_BEGIN(); touch_region(C, XB, (size_t)NT * DM * 2); pg8::GMoe g{XB, W1, 1024, 1024, 1024, (size_t)2048 * 1024 * 2, (const int*)(ws + WS_SMALL + SM_IDX)}; pg8::StaticOrder S; S.init(512, 8, C.G, bx); pg8::EpiSwiglu E{Hb}; \
        pg8::gemm_phase<true>(C.lds, g, S, E); } SEAM((base) + 1); \
    PHASE((base) + 2) { PH_BEGIN(); touch_region(C, Hb, (size_t)NSEL * 1024 * 2 * 3 / 4); pg8::GMoeTA g{Hb, W2, 64, 1024, 1024, (size_t)1024 * 1024 * 2}; pg8::StaticOrder S; S.init(512, 4, C.G, bx); pg8::EpiBf16 E{Zb, 1024}; \
        pg8::gemm_phase(C.lds, g, S, E); } SEAM((base) + 2); \
    PHASE((base) + 3) { PH_BEGIN(); moe_combine_ln2<(layer) == 3>(C, layer); if ((layer) < 3) MOE_PREP((layer) + 1); } SEAM((base) + 3);

#endif

#define OUT_LN1(Aop, Wofs, layer) { pg8::GPlain g{Aop, (const bf16_t*)(wm + (Wofs)), 1024, 1024, 1024}; pg8::PanelOrder S; S.init(256, 4, C.G, bx); \
        pg8::EpiOutB E{XB, YB, 1.0f}; pg8::gemm_phase(C.lds, g, S, E); VM_WAIT(); __syncthreads(); \
        for (int pnl = bx; pnl < 256; pnl += C.G) ln1_router(C, layer, YB, pnl * 256 + C.wave, 8, 32); }
#define OUT_LN1_F8(Aop8, Wofs, layer) { pg8::GPlain g{(const bf16_t*)(Aop8), (const bf16_t*)(wm + (Wofs)), 512, 512, 512}; pg8::PanelOrder S; S.init(256, 4, C.G, bx); \
        pg8::EpiOutB E{XB, YB, 1.0f / (F8_SU * F8_SWO)}; pg8::gemm_phase<false, true>(C.lds, g, S, E); VM_WAIT(); __syncthreads(); \
        for (int pnl = bx; pnl < 256; pnl += C.G) ln1_router(C, layer, YB, pnl * 256 + C.wave, 8, 32); }
#if OUT_FP8
#define OUT_LN1_X(Aop, Wofs, layer) OUT_LN1_F8(Aop, Wofs, layer)
#else
#define OUT_LN1_X(Aop, Wofs, layer) OUT_LN1(Aop, Wofs, layer)
#endif

    PHASE(0) { PH_BEGIN(); prep_mixer_weights(C); prep_xb(C); prep_rope(C); MOE_PREP(0); }
    SEAM(0);

    PHASE(1) { PH_BEGIN(); pg8::StaticOrder S; S.init(256, 13, C.G, bx);
        if (INP_FP8) { pg8::GPlain g{(const bf16_t*)(ws + WS_XB8), (const bf16_t*)(wm + WM_ML_IN), 512, 512, 512}; pg8::EpiIn E{Zb, 3072, 12, 2, 0.08838834764831845f, 0, 0, gatesf, 16, IN_F(I_ML_GB), 1.0f / F8_SWI}; pg8::gemm_phase<false, true>(C.lds, g, S, E); }
        else { pg8::GPlain g{XB, (const bf16_t*)(wm + WM_ML_IN), 1024, 1024, 1024}; pg8::EpiIn E{Zb, 3072, 12, 2, 0.08838834764831845f, 0, 0, gatesf, 16, IN_F(I_ML_GB)}; pg8::gemm_phase(C.lds, g, S, E); } }
    SEAM(1);
    PHASE(2) { PH_BEGIN(); mlstm_chain(C); }
    SEAM(2);
    PHASE(3) { PH_BEGIN(); }
    PHASE(4) { PH_BEGIN();
        for (int pnl = bx; pnl < 256; pnl += C.G) headnorm_gate<0>(C, Zb + 2048, 3072, Hb, Hb + (size_t)NT * DM, IN_F(I_ML_NG), UB, pnl * 256 + C.wave, 8, 32);
        VM_WAIT(); __syncthreads(); OUT_LN1_X(UB, WM_ML_OUT, 0) }
    SEAM(4);
    MOE_BLOCK(5, 0)

    PHASE(9) { PH_BEGIN(); pg8::StaticOrder S; S.init(256, 13, C.G, bx);
        if (INP_FP8) { pg8::GPlain g{(const bf16_t*)(ws + WS_XB8), (const bf16_t*)(wm + WM_GL_IN), 512, 512, 512}; pg8::EpiIn E{Zb, 3072, 12, 2, 0.08838834764831845f, 0, 0, gatesf, 32, nullptr, 1.0f / F8_SWI}; pg8::gemm_phase<false, true>(C.lds, g, S, E); }
        else { pg8::GPlain g{XB, (const bf16_t*)(wm + WM_GL_IN), 1024, 1024, 1024}; pg8::EpiIn E{Zb, 3072, 12, 2, 0.08838834764831845f, 0, 0, gatesf, 32, nullptr}; pg8::gemm_phase(C.lds, g, S, E); } }
    SEAM(9);
    PHASE(10) { PH_BEGIN(); gla_chain(C); }
    SEAM(10);
    PHASE(11) { PH_BEGIN(); }
    PHASE(12) { PH_BEGIN();
        for (int pnl = bx; pnl < 256; pnl += C.G) headnorm_gate<1>(C, Zb + 2048, 3072, Hb, Hb + (size_t)NT * DM, IN_F(I_GL_NG), UB, pnl * 256 + C.wave, 8, 32);
        VM_WAIT(); __syncthreads(); OUT_LN1_X(UB, WM_GL_OUT, 1) }
    SEAM(12);
    MOE_BLOCK(13, 1)

#define GB Zb
#define UR (Zb + (size_t)NT * DM)
#define UC (Zb + (size_t)2 * NT * DM)
    PHASE(17) { PH_BEGIN(); pg8::GPlain g{XB, (const bf16_t*)(wm + WM_LR_IN), 1024, 1024, 1024}; pg8::StaticOrder S; S.init(256, 8, C.G, bx);
        pg8::EpiIn E{Zb, 1024, 8, 0, 1.f, 1024, (size_t)NT * DM, nullptr, 0, nullptr};
        pg8::gemm_phase(C.lds, g, S, E); }
    SEAM(17);
    PHASE(18) { PH_BEGIN(); lru_conv(C, UR, UC); }
    SEAM(18);
    PHASE(19) { PH_BEGIN(); pg8::GLruGate g{UC, (const bf16_t*)(wm + WM_LR_G), 1024, 256, 256}; pg8::StaticOrder S; S.init(256, 16, C.G, bx);
        pg8::EpiLruGate E{UC, IN_F(I_LR_GAB), IN_F(I_LR_GXB), IN_F(I_LR_LAM), Hb, Hb + (size_t)NT * DM, UB, UR};
        pg8::gemm_phase(C.lds, g, S, E); }
    SEAM(19);
    PHASE(20) { PH_BEGIN(); lru_scan(C, Hb, (const unsigned char*)(Hb + (size_t)NT * DM), UB, (const unsigned char*)UR, GB, UC); }
    SEAM(20);
    PHASE(21) { PH_BEGIN(); if (OUT_FP8) OUT_LN1_F8(UC, WM_LR_OUT, 2) else OUT_LN1(GB, WM_LR_OUT, 2) }
    SEAM(21);
    MOE_BLOCK(22, 2)

#define Zm (Hb + (size_t)NT * DM)
#define CQN UB
#define CKVN (UB + (size_t)NT * 384)
#define Qm Zb
#define Km (Zb + (size_t)NT * 1536)
#define Vm Hb
#define Om (Hb + (size_t)NT * DM)
    PHASE(26) { PH_BEGIN(); pg8::GPlain g{XB, (const bf16_t*)(wm + WM_MA_IN), 1024, 1024, 1024}; pg8::PanelOrder S; S.init(256, 3, C.G, bx);
        pg8::EpiIn E{Zm, 768, 3, 0, 1.f, 0, 0, nullptr, 0, nullptr};
        pg8::gemm_phase(C.lds, g, S, E); VM_WAIT(); __syncthreads();
        for (int pnl = bx; pnl < 256; pnl += C.G) mla_norm_rope(C, Zm, CQN, CKVN, Km, pnl * 256 + C.wave, 8, 32); }
    SEAM(26);
    PHASE(27) {  PH_BEGIN();
        { pg8::GPlain g{CQN, (const bf16_t*)(wm + WM_MA_UQ), 384, 384, 384}; pg8::StaticOrder S; S.init(256, 6, C.G, bx);
          pg8::EpiMlaQ E{Qm, (const float*)(ws + WS_ROPE), (const float*)(ws + WS_ROPE) + (size_t)NT * 32}; pg8::gemm_phase(C.lds, g, S, E); }
        { pg8::GPlain g{CKVN, (const bf16_t*)(wm + WM_MA_UKV), 256, 256, 256}; pg8::StaticOrder S; S.init(256, 8, C.G, bx);
          pg8::EpiMlaKV E{Km, Vm}; pg8::gemm_phase(C.lds, g, S, E); }
    }
    SEAM(27);
    PHASE(28) { PH_BEGIN();
        const bool xcdmap = (C.G & 7) == 0; const int xq = bx & 7, jq = bx >> 3, Jq = C.G >> 3;
        for (int up = xcdmap ? jq : bx; up < (xcdmap ? 256 : NB * 8 * 8); up += (xcdmap ? Jq : C.G)) { const int unit = xcdmap ? (xq * 32 + (up >> 3)) * 8 + (up & 7) : up; const int bh = unit >> 3, qb = unit & 7, b = bh >> 3, h = bh & 7;
            if (ATT_FP8 && ATT_PV8) attn::attn_unit88((const unsigned char*)Qm + ((size_t)(b * SEQ + qb * 256) * 8 + h) * 192, (const unsigned char*)Km + (size_t)bh * SEQ * 192, (const unsigned char*)Vm + (size_t)bh * 128 * SEQ, Om + (size_t)(b * SEQ + qb * 256) * DM + h * 128, C.lds);
            else if (ATT_FP8) attn::attn_unit8((const unsigned char*)Qm + ((size_t)(b * SEQ + qb * 256) * 8 + h) * 192, (const unsigned char*)Km + (size_t)bh * SEQ * 192, Vm + (size_t)bh * SEQ * 128, Om + (size_t)(b * SEQ + qb * 256) * DM + h * 128, C.lds);
            else attn::attn_unit(Qm + ((size_t)(b * SEQ + qb * 256) * 8 + h) * 192, Km + (size_t)bh * SEQ * 192, Vm + (size_t)bh * SEQ * 128, Om + (size_t)(b * SEQ + qb * 256) * DM + h * 128, C.lds); }
    }
    SEAM(28);
    PHASE(29) { PH_BEGIN(); OUT_LN1(Om, WM_MA_OUT, 3) }
    SEAM(29);
    MOE_BLOCK(30, 3)
#undef OUT_LN1
#undef OUT_LN1_F8
#undef OUT_LN1_X
#undef IN
#undef SEAM
#undef MOE_BLOCK
#undef MOE_UP
#undef MOE_DOWN
#undef PHASE
#undef XB
#undef Zb
#undef Hb
#undef wm
#undef gatesf
#undef W1
#undef W2
#undef UB
#undef YB
#undef GB
#undef UR
#undef UC
#undef Zm
#undef CQN
#undef CKVN
#undef Qm
#undef Km
#undef Vm
#undef Om
}

template <int P> struct SplitLaunch {
    static bool setup() { return hipFuncSetAttribute((const void*)fwd_kernel<P, P + 1>, hipFuncAttributeMaxDynamicSharedMemorySize, LDS_BYTES) == hipSuccess && SplitLaunch<P + 1>::setup(); }
    static void run(int grid, hipStream_t stream, const Args& a) { hipLaunchKernelGGL((fwd_kernel<P, P + 1>), dim3(grid), dim3(512), LDS_BYTES, stream, a); SplitLaunch<P + 1>::run(grid, stream, a); }
};
template <> struct SplitLaunch<N_PHASES> { static bool setup() { return true; } static void run(int, hipStream_t, const Args&) {} };

extern "C" void kernel_launch(void* const* d_in, const int* in_sizes, int n_in, void* d_out, int out_size, void* d_ws, size_t ws_size, hipStream_t stream) {
    static int grid = 0;
    if (grid == 0) {
        if (n_in != N_IN || out_size != NT * DM || ws_size < WS_END) { fprintf(stderr, "kernel_launch: unexpected shapes (n_in %d, out %d, ws %zu)\n", n_in, out_size, ws_size); grid = -1; return; }
        int dev = 0, cus = 0, per_cu = 0;
        if (hipGetDevice(&dev) != hipSuccess || hipDeviceGetAttribute(&cus, hipDeviceAttributeMultiprocessorCount, dev) != hipSuccess) { grid = -1; return; }
#if MK_SPLIT
        if (!SplitLaunch<0>::setup()) { fprintf(stderr, "kernel_launch: hipFuncSetAttribute failed\n"); grid = -1; return; }
#else
        if (hipFuncSetAttribute((const void*)fwd_kernel<0, N_PHASES>, hipFuncAttributeMaxDynamicSharedMemorySize, LDS_BYTES) != hipSuccess) { fprintf(stderr, "kernel_launch: hipFuncSetAttribute failed\n"); grid = -1; return; }
        if (hipOccupancyMaxActiveBlocksPerMultiprocessor(&per_cu, (const void*)fwd_kernel<0, N_PHASES>, 512, LDS_BYTES) != hipSuccess || per_cu < 1) { fprintf(stderr, "kernel_launch: occupancy query says %d\n", per_cu); }
#endif
        (void)hipGetLastError();
        grid = cus;
    }
    if (grid < 0) return;
    (void)hipMemsetAsync((char*)d_ws + WS_CTL, 0, CTL_BYTES, stream);
    Args a{};
    for (int i = 0; i < N_IN; ++i) a.in[i] = d_in[i];
    a.out = (float*)d_out; a.ws = (unsigned char*)d_ws;
#if MK_SPLIT
    SplitLaunch<0>::run(grid, stream, a);
#else
    hipLaunchKernelGGL((fwd_kernel<0, N_PHASES>), dim3(grid), dim3(512), LDS_BYTES, stream, a);
#endif
    const hipError_t le = hipPeekAtLastError();
    if (le != hipSuccess) fprintf(stderr, "kernel_launch: launch failed: %s\n", hipGetErrorName(le));
}
```
